# Optimizing an MI355X kernel written in HIP

```python
import jax
import jax.numpy as jnp
from jax import lax
import numpy as np

D_MODEL = 2048
BATCH = 4
SEQ = 4096
DEPTH = 2

CTX_LEN = 256
GRID_W = 64

ATT_HEADS = 8
ATT_KV_HEADS = 2
ATT_HEAD_DIM = 128
ATT_BLOCK = 128
ROPE_THETA = 10000.0

ML_HEADS = 4
ML_QK_DIM = 128
ML_V_DIM = 256
ML_CHUNK = 128

POOL_WINDOWS = (2, 4, 8, 16)
POOL_GROUP = 256

N_BRANCH = 3
D_FF = -(-(8 * D_MODEL) // (3 * 256)) * 256
EPS = 1e-6

ATT_Q_W = ATT_HEADS * ATT_HEAD_DIM
ATT_KV_W = ATT_KV_HEADS * ATT_HEAD_DIM
ML_QK_W = ML_HEADS * ML_QK_DIM
ML_V_W = ML_HEADS * ML_V_DIM
ML_GATE_W = 2 * ML_HEADS
POOL_W = len(POOL_WINDOWS) * POOL_GROUP
GATE_W = N_BRANCH * D_MODEL
PROJ_WIDTHS = (ATT_KV_W, ATT_KV_W, ML_QK_W, ML_V_W, ML_GATE_W, ML_GATE_W,
               ATT_Q_W, ML_QK_W, ML_V_W, POOL_W, GATE_W)
PROJ_SPLITS = tuple(int(s) for s in np.cumsum(PROJ_WIDTHS)[:-1])
CTX_SIDE_W = PROJ_SPLITS[5]
D_IN = int(sum(PROJ_WIDTHS))

kernel_name = 'hybrid_gqa_mlstm_pool_dit_block'


def _rmsnorm(x, g):
    xf = x.astype(jnp.float32)
    y = xf * lax.rsqrt(jnp.mean(xf * xf, axis=-1, keepdims=True) + EPS)
    return (y * g.astype(jnp.float32)).astype(x.dtype)


def _modulate(h, shift, scale):
    return h * (1 + scale) + shift


def _axial_rope_tables(n_tokens):
    rows_n = n_tokens // GRID_W
    row = jnp.repeat(jnp.arange(rows_n), GRID_W).astype(jnp.float32)
    col = jnp.tile(jnp.arange(GRID_W), rows_n).astype(jnp.float32)
    n_freq = ATT_HEAD_DIM // 4
    inv = ROPE_THETA ** (-jnp.arange(n_freq, dtype=jnp.float32) / n_freq)
    ang = jnp.stack([row[:, None] * inv, col[:, None] * inv], axis=1)
    return jnp.cos(ang), jnp.sin(ang)


def _apply_rope(t, cos, sin):
    B, S, H, hd = t.shape
    tr = t.astype(jnp.float32).reshape(B, S, H, 2, 2, hd // 4)
    a, b = tr[..., 0, :], tr[..., 1, :]
    cs, sn = cos[None, :, None], sin[None, :, None]
    out = jnp.stack([a * cs - b * sn, b * cs + a * sn], axis=-2)
    return out.reshape(B, S, H, hd).astype(t.dtype)


def _gqa_blocks(q, k, v):
    B, Sq, H, hd = q.shape
    G = H // ATT_KV_HEADS
    nb = Sq // ATT_BLOCK
    qb = jnp.moveaxis(q.reshape(B, nb, ATT_BLOCK, ATT_KV_HEADS, G, hd), 1, 0)
    scale = hd ** -0.5

    def one_block(qblk):
        s = jnp.einsum('bqkgd,bskd->bkgqs', qblk, k).astype(jnp.float32) * scale
        pr = jax.nn.softmax(s, axis=-1).astype(v.dtype)
        return jnp.einsum('bkgqs,bskd->bqkgd', pr, v)

    out = lax.map(one_block, qb)
    return jnp.moveaxis(out, 0, 1).reshape(B, Sq, H * hd)


def _chunk(a):
    return a.reshape(a.shape[0], a.shape[1] // ML_CHUNK, ML_CHUNK, *a.shape[2:])


def _zero_state(B):
    return (jnp.zeros((B, ML_HEADS, ML_V_DIM, ML_QK_DIM), jnp.float32),
            jnp.zeros((B, ML_HEADS, ML_QK_DIM), jnp.float32),
            jnp.zeros((B, ML_HEADS), jnp.float32))


def _mlstm_gates(i_raw, f_raw, gate_b):
    B, T, _ = i_raw.shape
    li = i_raw.reshape(B, T, 2, ML_HEADS).astype(jnp.float32) + gate_b[:, 0]
    lf = jax.nn.log_sigmoid(f_raw.reshape(B, T, 2, ML_HEADS).astype(jnp.float32) + gate_b[:, 1])
    return li, lf


def _mlstm_states(k, v, li, lf, state0):
    kc, vc, lic = _chunk(k), _chunk(v), _chunk(li)
    b = jnp.cumsum(_chunk(lf), axis=2)
    g = b[:, :, -1]
    w_end = g[:, :, None] - b + lic
    m_loc = jnp.max(w_end, axis=2)
    e = jnp.exp(w_end - m_loc[:, :, None])
    c_loc = jnp.einsum('bclh,bclhv,bclhk->bchvk', e, vc, kc)
    n_loc = jnp.einsum('bclh,bclhk->bchk', e, kc)

    def step(carry, inp):
        C, n, m = carry
        gc, mc, Cc, ncc = inp
        m_new = jnp.maximum(gc + m, mc)
        a = jnp.exp(gc + m - m_new)
        s = jnp.exp(mc - m_new)
        new = (a[..., None, None] * C + s[..., None, None] * Cc,
               a[..., None] * n + s[..., None] * ncc, m_new)
        return new, (C, n, m)

    seq = tuple(jnp.moveaxis(t, 1, 0) for t in (g, m_loc, c_loc, n_loc))
    final, entry = lax.scan(step, state0, seq)
    entry = tuple(jnp.moveaxis(t, 0, 1) for t in entry)
    return final, entry, b, lic


def _mlstm_outputs(q, k, v, b, lic, entry):
    B, T, H, _ = q.shape
    c_in, n_in, m_in = entry
    qc, kc, vc = _chunk(q), _chunk(k), _chunk(v)
    L = ML_CHUNK
    a_log = b + m_in[:, :, None]
    d_log = b[:, :, :, None] - b[:, :, None] + lic[:, :, None]
    lower = (jnp.arange(L)[:, None] >= jnp.arange(L)[None, :])[None, None, :, :, None]
    d_log = jnp.where(lower, d_log, -jnp.inf)
    m_j = jnp.maximum(a_log, jnp.max(d_log, axis=3))
    w = jnp.exp(d_log - m_j[:, :, :, None]) * jnp.einsum('bcjhd,bcshd->bcjsh', qc, kc)
    num = jnp.einsum('bcjsh,bcshv->bcjhv', w, vc)
    den = jnp.sum(w, axis=3)
    inter = jnp.exp(a_log - m_j)
    num = num + inter[..., None] * jnp.einsum('bchvk,bcjhk->bcjhv', c_in, qc)
    den = den + inter * jnp.einsum('bchk,bcjhk->bcjh', n_in, qc)
    h = num / jnp.maximum(jnp.abs(den), jnp.exp(-m_j))[..., None]
    return h.reshape(B, T, H, ML_V_DIM)


def _mlstm_direction(q, k, v, li, lf, state0, reverse, with_output):
    if reverse:
        k, v, li, lf = (jnp.flip(t, axis=1) for t in (k, v, li, lf))
    final, entry, b, lic = _mlstm_states(k, v, li, lf, state0)
    if not with_output:
        return None, final
    qd = jnp.flip(q, axis=1) if reverse else q
    h = _mlstm_outputs(qd, k, v, b, lic, entry)
    return (jnp.flip(h, axis=1) if reverse else h), final


def _mlstm_inputs(q_raw, k_raw, v_raw):
    B, T, _ = k_raw.shape
    k = k_raw.reshape(B, T, ML_HEADS, ML_QK_DIM).astype(jnp.float32) * (ML_QK_DIM ** -0.5)
    v = v_raw.reshape(B, T, ML_HEADS, ML_V_DIM).astype(jnp.float32)
    q = None if q_raw is None else q_raw.reshape(B, T, ML_HEADS, ML_QK_DIM).astype(jnp.float32)
    return q, k, v


def _pool_branch(u, pool_w, pool_scale):
    B, T, _ = u.shape
    uf = u.astype(jnp.float32)
    cs = jnp.concatenate([jnp.zeros((B, 1, POOL_W), jnp.float32), jnp.cumsum(uf, axis=1)], axis=1)
    t = jnp.arange(T)
    means = []
    for gi, w in enumerate(POOL_WINDOWS):
        lo = jnp.clip(t - w // 2, 0, T)
        hi = jnp.clip(t + w // 2, 0, T)
        seg = cs[:, :, gi * POOL_GROUP:(gi + 1) * POOL_GROUP]
        means.append((seg[:, hi] - seg[:, lo]) / (hi - lo).astype(jnp.float32)[None, :, None])
    mixed = (jnp.concatenate(means, axis=-1) - uf).astype(u.dtype)
    mixed = jnp.einsum('btgc,gcd->btgd', mixed.reshape(B, T, len(POOL_WINDOWS), POOL_GROUP), pool_w)
    return mixed.reshape(B, T, POOL_W) * pool_scale


def _merge(att, h_ml, o_raw, pool_raw, gate_raw, ml_head_g, pool_w, pool_scale,
           w_up_att, w_up_ml, w_up_pool, w_out):
    B, T, _ = o_raw.shape
    ml = _rmsnorm(h_ml, ml_head_g.reshape(ML_HEADS, ML_V_DIM)).reshape(B, T, ML_V_W).astype(o_raw.dtype)
    ml = ml * jax.nn.sigmoid(o_raw)
    pool = _pool_branch(pool_raw, pool_w, pool_scale)
    gts = jax.nn.sigmoid(gate_raw).reshape(B, T, N_BRANCH, D_MODEL)
    y = (gts[:, :, 0] * (att @ w_up_att) + gts[:, :, 1] * (ml @ w_up_ml)
         + gts[:, :, 2] * (pool @ w_up_pool))
    return y @ w_out


def _token_mixers(h, hc, cos, sin, w_in, ml_gate_b, qk_norm_g, ml_head_g, pool_w, pool_scale,
                  w_up_att, w_up_ml, w_up_pool, w_out, ctx_out):
    B, S, _ = h.shape
    Sc = hc.shape[1]
    p = jnp.split(h @ w_in, PROJ_SPLITS, axis=-1)
    if ctx_out:
        pc = jnp.split(hc @ w_in, PROJ_SPLITS, axis=-1)
    else:
        pc = jnp.split(hc @ w_in[:, :CTX_SIDE_W], PROJ_SPLITS[:5], axis=-1)

    att_kc = _rmsnorm(pc[0].reshape(B, Sc, ATT_KV_HEADS, ATT_HEAD_DIM), qk_norm_g[1])
    att_vc = pc[1].reshape(B, Sc, ATT_KV_HEADS, ATT_HEAD_DIM)
    ml_qc, ml_kc, ml_vc = _mlstm_inputs(pc[7] if ctx_out else None, pc[2], pc[3])
    li_c, lf_c = _mlstm_gates(pc[4], pc[5], ml_gate_b)
    ctx_h, ctx_final = [], []
    for d in range(2):
        hd_, fin = _mlstm_direction(ml_qc, ml_kc, ml_vc, li_c[:, :, d], lf_c[:, :, d],
                                    _zero_state(B), d == 1, ctx_out)
        ctx_h.append(hd_)
        ctx_final.append(fin)

    att_q = _apply_rope(_rmsnorm(p[6].reshape(B, S, ATT_HEADS, ATT_HEAD_DIM), qk_norm_g[0]), cos, sin)
    att_k = _apply_rope(_rmsnorm(p[0].reshape(B, S, ATT_KV_HEADS, ATT_HEAD_DIM), qk_norm_g[1]), cos, sin)
    att_v = p[1].reshape(B, S, ATT_KV_HEADS, ATT_HEAD_DIM)
    att = _gqa_blocks(att_q, jnp.concatenate([att_k, att_kc], axis=1),
                      jnp.concatenate([att_v, att_vc], axis=1))
    ml_q, ml_k, ml_v = _mlstm_inputs(p[7], p[2], p[3])
    li, lf = _mlstm_gates(p[4], p[5], ml_gate_b)
    h_f, _ = _mlstm_direction(ml_q, ml_k, ml_v, li[:, :, 0], lf[:, :, 0], ctx_final[0], False, True)
    h_b, _ = _mlstm_direction(ml_q, ml_k, ml_v, li[:, :, 1], lf[:, :, 1], ctx_final[1], True, True)
    y = _merge(att, h_f + h_b, p[8], p[9], p[10], ml_head_g, pool_w, pool_scale,
               w_up_att, w_up_ml, w_up_pool, w_out)
    if not ctx_out:
        return y, None

    att_qc = _rmsnorm(pc[6].reshape(B, Sc, ATT_HEADS, ATT_HEAD_DIM), qk_norm_g[0])
    att_ctx = _gqa_blocks(att_qc, att_kc, att_vc)
    yc = _merge(att_ctx, ctx_h[0] + ctx_h[1], pc[8], pc[9], pc[10], ml_head_g, pool_w, pool_scale,
                w_up_att, w_up_ml, w_up_pool, w_out)
    return y, yc


def _swiglu(h, w_in, w_out):
    gt, up = jnp.split(h @ w_in, 2, axis=-1)
    return (jax.nn.silu(gt) * up) @ w_out


def setup_inputs(seed: int = 0) -> dict:
    key = jax.random.key(seed)
    ks = jax.random.split(key, 20)
    f32 = jnp.float32
    D = D_MODEL

    def nrm(k, shape, scale):
        return jax.random.normal(k, shape, f32) * scale

    head_frac = jnp.arange(ML_HEADS, dtype=f32) / max(ML_HEADS - 1, 1)
    i_b = nrm(ks[8], (DEPTH, 2, ML_HEADS), 0.1)
    f_b = 3.0 + 3.0 * head_frac + nrm(ks[9], (DEPTH, 2, ML_HEADS), 0.1)
    return {
        'x': nrm(ks[0], (BATCH, SEQ, D), 1.0),
        'c': nrm(ks[1], (BATCH, D), 1.0),
        'ctx': nrm(ks[2], (BATCH, CTX_LEN, D), 1.0),
        'c_ctx': nrm(ks[3], (D,), 1.0),
        'w_mod': nrm(ks[4], (DEPTH, D, 6 * D), 0.5 * D ** -0.5),
        'b_mod': nrm(ks[5], (DEPTH, 6 * D), 0.02),
        'norm_g': 1.0 + nrm(ks[6], (DEPTH, 4, D), 0.05),
        'w_in': nrm(ks[7], (DEPTH, D, D_IN), D ** -0.5),
        'ml_gate_b': jnp.stack([i_b, f_b], axis=2),
        'qk_norm_g': 1.0 + nrm(ks[10], (DEPTH, 2, ATT_HEAD_DIM), 0.05),
        'ml_head_g': 1.0 + nrm(ks[11], (DEPTH, ML_V_W), 0.05),
        'pool_w': nrm(ks[12], (DEPTH, len(POOL_WINDOWS), POOL_GROUP, POOL_GROUP), POOL_GROUP ** -0.5),
        'pool_scale': 1.0 + nrm(ks[13], (DEPTH, POOL_W), 0.1),
        'w_up_att': nrm(ks[14], (DEPTH, ATT_Q_W, D), ATT_Q_W ** -0.5),
        'w_up_ml': nrm(ks[15], (DEPTH, ML_V_W, D), ML_V_W ** -0.5),
        'w_up_pool': nrm(ks[16], (DEPTH, POOL_W, D), POOL_W ** -0.5),
        'w_out': nrm(ks[17], (DEPTH, D, D), D ** -0.5),
        'w_ffn_in': nrm(ks[18], (DEPTH, D, 2 * D_FF), D ** -0.5),
        'w_ffn_out': nrm(ks[19], (DEPTH, D_FF, D), D_FF ** -0.5),
    }


def reference(x, c, ctx, c_ctx, w_mod, b_mod, norm_g, w_in, ml_gate_b, qk_norm_g, ml_head_g,
              pool_w, pool_scale, w_up_att, w_up_ml, w_up_pool, w_out, w_ffn_in, w_ffn_out):
    cos, sin = _axial_rope_tables(x.shape[1])
    xc = ctx
    silu_c = jax.nn.silu(c)
    silu_cc = jax.nn.silu(c_ctx)
    for l in range(DEPTH):
        last = l == DEPTH - 1
        mod = (silu_c @ w_mod[l] + b_mod[l])[:, None]
        mod_c = (silu_cc @ w_mod[l] + b_mod[l])[None, None]
        sh_m, sc_m, gt_m, sh_f, sc_f, gt_f = jnp.split(mod, 6, axis=-1)
        csh_m, csc_m, cgt_m, csh_f, csc_f, cgt_f = jnp.split(mod_c, 6, axis=-1)

        h = _modulate(_rmsnorm(x, norm_g[l, 0]), sh_m, sc_m)
        hc = _modulate(_rmsnorm(xc, norm_g[l, 0]), csh_m, csc_m)
        y, yc = _token_mixers(h, hc, cos, sin, w_in[l], ml_gate_b[l], qk_norm_g[l], ml_head_g[l],
                              pool_w[l], pool_scale[l], w_up_att[l], w_up_ml[l], w_up_pool[l],
                              w_out[l], not last)
        x = x + gt_m * _rmsnorm(y, norm_g[l, 1])
        h = _modulate(_rmsnorm(x, norm_g[l, 2]), sh_f, sc_f)
        x = x + gt_f * _rmsnorm(_swiglu(h, w_ffn_in[l], w_ffn_out[l]), norm_g[l, 3])
        if not last:
            xc = xc + cgt_m * _rmsnorm(yc, norm_g[l, 1])
            hc = _modulate(_rmsnorm(xc, norm_g[l, 2]), csh_f, csc_f)
            xc = xc + cgt_f * _rmsnorm(_swiglu(hc, w_ffn_in[l], w_ffn_out[l]), norm_g[l, 3])
    return x
```

```cpp
#include <hip/hip_runtime.h>
#include <hip/hip_cooperative_groups.h>
#include <cstdio>
#include <cstdint>
namespace cg = cooperative_groups;

#define LAS __attribute__((address_space(3)))
typedef unsigned short bf16_t;
typedef short bf16x8 __attribute__((ext_vector_type(8)));
typedef short s16x4 __attribute__((ext_vector_type(4)));
typedef float f32x4 __attribute__((ext_vector_type(4)));
typedef float f32x16 __attribute__((ext_vector_type(16)));
typedef unsigned u32x4 __attribute__((ext_vector_type(4)));
typedef unsigned u32x2 __attribute__((ext_vector_type(2)));

constexpr int D = 2048, NB = 4, SEQ = 4096, CTXL = 256;
constexpr int ML = NB * SEQ, MC = NB * CTXL, MT = ML + MC;
constexpr int DIN = 11792, NP = 5888, NWIN = 12032, NG = 6144, DFF = 5632;
constexpr int C_AK = 0, C_AV = 256, C_MK = 512, C_MV = 1024, C_GI = 2048, C_GF = 2056, C_AQ = 2064, C_MQ = 3088, C_O = 3600, C_PL = 4624, C_GRAW = 5648;
constexpr float EPS = 1e-6f;
constexpr int NSLOT = 34, NUNIT = NB * 4 * 2 * NSLOT;
constexpr float QK_SCALE = 0.08838834764831845f;

constexpr size_t MiB = 1u << 20;
constexpr size_t WS_MOD = 1 * MiB;
constexpr size_t WS_LI = 2 * MiB;
constexpr size_t WS_LF = 3 * MiB;
constexpr size_t WS_GT = 4 * MiB;
constexpr size_t WS_NST = 5 * MiB;
constexpr size_t WS_WIN = 6 * MiB;
constexpr size_t WS_WFI = 54 * MiB;
constexpr size_t WS_WFO = 98 * MiB;
constexpr size_t WS_WUP = 120 * MiB;
constexpr size_t WS_WOUT = 132 * MiB;
constexpr size_t WS_WPL = 140 * MiB;
constexpr size_t WS_XC = 141 * MiB;
constexpr size_t WS_H = 149 * MiB;
constexpr size_t WS_P = 217 * MiB;
constexpr size_t WS_MIX = 617 * MiB;
constexpr size_t WS_CST = 651 * MiB;
constexpr size_t WS_XB = 719 * MiB;
constexpr size_t WS_END = 783 * MiB;
constexpr size_t WS_YO = WS_P;
constexpr size_t WS_G8 = WS_P + 196 * MiB;
constexpr size_t WS_HID = WS_P + 160 * MiB;

constexpr int LDS_BYTES = 147456;

__device__ __forceinline__ float bf2f(bf16_t v) { return __uint_as_float((unsigned)v << 16); }
__device__ __forceinline__ float bfs2f(short v) { return __uint_as_float(((unsigned)(unsigned short)v) << 16); }
typedef float f32x2_t __attribute__((ext_vector_type(2))); typedef __bf16 bf16x2_t __attribute__((ext_vector_type(2)));
__device__ __forceinline__ unsigned pk2(float lo, float hi) { const f32x2_t v = {lo, hi}; const bf16x2_t b = __builtin_convertvector(v, bf16x2_t); return __builtin_bit_cast(unsigned, b); }
__device__ __forceinline__ unsigned f2bf(float f) { return pk2(f, 0.f) & 0xffffu; }
__device__ __forceinline__ float wave_sum(float v) {
#pragma unroll
    for (int o = 1; o < 64; o <<= 1) v += __shfl_xor(v, o);
    return v;
}
__device__ __forceinline__ float sigmoidf_(float x) { return __builtin_amdgcn_rcpf(1.f + __expf(-x)); }

struct Args { const float* in[19]; float* out; unsigned char* ws; };
enum { I_X = 0, I_C, I_CTX, I_CCTX, I_WMOD, I_BMOD, I_NORMG, I_WIN, I_GATEB, I_QKG, I_MLHG, I_POOLW, I_POOLS, I_UPA, I_UPM, I_UPP, I_WOUT, I_FFI, I_FFO };

namespace pg8 {
constexpr int BM = 256, BK = 64, HALF = 128, HTB = HALF * BK * 2, STAGE_BYTES = 8 * HTB, NXCD = 8, WGM = 8;
__host__ __device__ __forceinline__ int lds_byte(int r, int c) { const int st = (r >> 4) * 2 + (c >> 5), rr = r & 15, cc = c & 31, ob = rr * 64 + cc * 2; return st * 1024 + (ob ^ (((ob >> 9) & 1) << 5)); }
__host__ __device__ __forceinline__ void stage_rc(int b, int& R, int& C) { const int st = b / 1024, sb = b % 1024, swz = sb ^ (((sb >> 9) & 1) << 5); R = (st >> 1) * 16 + swz / 64; C = (st & 1) * 32 + (swz % 64) / 2; }
__host__ __device__ __forceinline__ int perm32(int rho) { const int n = rho >> 4, i = rho & 15; return 8 * (i >> 2) + 4 * n + (i & 3); }

struct Unit { int pm, pn, br; };
struct Gemm { const bf16_t* A0; const bf16_t* A1; const bf16_t* A2; const bf16_t* B0; const bf16_t* B1; const bf16_t* B2; int lda; int K; int apn; };

struct Sched {
    int nM, nN, nBr, G, c, nT1, pm2, nM2, nT;
    __device__ void init(int nM_, int nN_, int nBr_, int G_, int c_, int pm2_ = 0, int nM2_ = 0, int nN2_ = 0) {
        nM = nM_; nN = nN_; nBr = nBr_; G = G_; c = c_; nT1 = nM * nN; pm2 = pm2_; nM2 = nM2_; nT = nT1 + nM2_ * nN2_; }
    __device__ bool next(int i, Unit& u) const {
        const int it = i / nBr; u.br = i - it * nBr;
        const long L = (long)it * G + c; if (L >= nT) return false;
        if (L < nT1) {
            int wgid = (int)L; { const int q = nT1 / NXCD, r = nT1 % NXCD, xcd = wgid % NXCD, off = wgid / NXCD; wgid = (xcd < r ? xcd * (q + 1) : r * (q + 1) + (xcd - r) * q) + off; }
            const int nig = WGM * nN, gid = wgid / nig, fm = gid * WGM, gsz = (nM - fm) < WGM ? (nM - fm) : WGM;
            u.pm = fm + ((wgid % nig) % gsz); u.pn = (wgid % nig) / gsz;
        } else { const int r = (int)L - nT1; u.pm = pm2 + r % nM2; u.pn = r / nM2; }
        return true;
    }
};

__device__ __forceinline__ unsigned cvt_pk_bf16(float lo, float hi) { unsigned r; asm volatile("v_cvt_pk_bf16_f32 %0, %1, %2" : "=v"(r) : "v"(lo), "v"(hi)); return r; }

struct EpiBf16 {
    static constexpr bool PERM = true;
    bf16_t* O; int ldc;
    __device__ __forceinline__ bool operator()(f32x4 (&acc)[2][2][4][2], const Unit& u, int wr, int wc, int fr, int fq) const {
        const int row0 = u.pm * BM + wr * 64 + fr, col0 = u.pn * BM + wc * 32 + 8 * fq;
#pragma unroll
        for (int ai = 0; ai < 2; ++ai)
#pragma unroll
            for (int m = 0; m < 4; ++m) { bf16_t* rowp = O + (size_t)(row0 + ai * HALF + m * 16) * ldc + col0;
#pragma unroll
                for (int bj = 0; bj < 2; ++bj) { const f32x4 v0 = acc[ai][bj][m][0], v1 = acc[ai][bj][m][1];
                    u32x4 w; w.x = cvt_pk_bf16(v0[0], v0[1]); w.y = cvt_pk_bf16(v0[2], v0[3]); w.z = cvt_pk_bf16(v1[0], v1[1]); w.w = cvt_pk_bf16(v1[2], v1[3]);
                    *(u32x4*)(rowp + bj * HALF) = w; } }
        return false;
    }
};
struct EpiWin {
    static constexpr bool PERM = true;
    bf16_t* O; unsigned char* G8;
    __device__ __forceinline__ bool operator()(f32x4 (&acc)[2][2][4][2], const Unit& u, int wr, int wc, int fr, int fq) const {
        const int row0 = u.pm * BM + wr * 64 + fr;
        if (u.pn < 23) {
            const int col0 = u.pn * BM + wc * 32 + 8 * fq;
#pragma unroll
            for (int ai = 0; ai < 2; ++ai)
#pragma unroll
                for (int m = 0; m < 4; ++m) { bf16_t* rowp = O + (size_t)(row0 + ai * HALF + m * 16) * NP + col0;
#pragma unroll
                    for (int bj = 0; bj < 2; ++bj) { const f32x4 v0 = acc[ai][bj][m][0], v1 = acc[ai][bj][m][1];
                        u32x4 w; w.x = cvt_pk_bf16(v0[0], v0[1]); w.y = cvt_pk_bf16(v0[2], v0[3]); w.z = cvt_pk_bf16(v1[0], v1[1]); w.w = cvt_pk_bf16(v1[2], v1[3]);
                        *(u32x4*)(rowp + bj * HALF) = w; } }
        } else {
            const int col0 = (u.pn - 23) * BM + wc * 32 + 8 * fq;
#pragma unroll
            for (int ai = 0; ai < 2; ++ai)
#pragma unroll
                for (int m = 0; m < 4; ++m) { unsigned char* rowp = G8 + (size_t)(row0 + ai * HALF + m * 16) * NG + col0;
#pragma unroll
                    for (int bj = 0; bj < 2; ++bj) { unsigned q[8];
#pragma unroll
                        for (int n = 0; n < 2; ++n)
#pragma unroll
                            for (int e = 0; e < 4; ++e) { const float sg = 256.f * __builtin_amdgcn_rcpf(1.f + __expf(-acc[ai][bj][m][n][e])); q[4 * n + e] = (unsigned)fminf(sg, 255.f); }
                        u32x2 w; w.x = q[0] | (q[1] << 8) | (q[2] << 16) | (q[3] << 24); w.y = q[4] | (q[5] << 8) | (q[6] << 16) | (q[7] << 24);
                        *(u32x2*)(rowp + bj * HALF) = w; } }
        }
        return false;
    }
};
struct EpiF32 {
    static constexpr bool PERM = false;
    float* C; int ldc;
    __device__ __forceinline__ bool operator()(f32x4 (&acc)[2][2][4][2], const Unit& u, int wr, int wc, int fr, int fq) const {
        const int row0 = u.pm * BM + wr * 64 + fr, col0 = u.pn * BM + wc * 32 + 4 * fq;
#pragma unroll
        for (int ai = 0; ai < 2; ++ai)
#pragma unroll
            for (int m = 0; m < 4; ++m) { float* rowp = C + (size_t)(row0 + ai * HALF + m * 16) * ldc + col0;
#pragma unroll
                for (int bj = 0; bj < 2; ++bj)
#pragma unroll
                    for (int n = 0; n < 2; ++n) *(f32x4*)(rowp + bj * HALF + n * 16) = acc[ai][bj][m][n]; }
        return false;
    }
};
struct EpiSwiglu {
    static constexpr bool PERM = true;
    bf16_t* O;
    __device__ __forceinline__ bool operator()(f32x4 (&acc)[2][2][4][2], const Unit& u, int wr, int wc, int fr, int fq) const {
        const int row0 = u.pm * BM + wr * 64 + fr, col0 = u.pn * HALF + wc * 32 + 8 * fq;
#pragma unroll
        for (int ai = 0; ai < 2; ++ai)
#pragma unroll
            for (int m = 0; m < 4; ++m) { bf16_t* rowp = O + (size_t)(row0 + ai * HALF + m * 16) * DFF + col0;
                float r[8];
#pragma unroll
                for (int n = 0; n < 2; ++n)
#pragma unroll
                    for (int e = 0; e < 4; ++e) { const float g = acc[ai][0][m][n][e], up = acc[ai][1][m][n][e]; r[4 * n + e] = g * up * __builtin_amdgcn_rcpf(1.f + __expf(-g)); }
                u32x4 w; w.x = cvt_pk_bf16(r[0], r[1]); w.y = cvt_pk_bf16(r[2], r[3]); w.z = cvt_pk_bf16(r[4], r[5]); w.w = cvt_pk_bf16(r[6], r[7]);
                *(u32x4*)rowp = w; }
        return false;
    }
};
struct EpiGate {
    static constexpr bool PERM = true;
    const unsigned char* G8; bf16_t* Y;
    __device__ __forceinline__ bool operator()(f32x4 (&acc)[2][2][4][2], const Unit& u, int wr, int wc, int fr, int fq) const {
        const int row0 = u.pm * BM + wr * 64 + fr, col0 = u.pn * BM + wc * 32 + 8 * fq;
#pragma unroll
        for (int ai = 0; ai < 2; ++ai)
#pragma unroll
            for (int m = 0; m < 4; ++m) { const size_t row = (size_t)(row0 + ai * HALF + m * 16);
#pragma unroll
                for (int bj = 0; bj < 2; ++bj) { const int col = col0 + bj * HALF;
                    const u32x2 ga = *(const u32x2*)(G8 + row * NG + u.br * D + col);
                    if (u.br < 2) {
                        const u32x2 gb = *(const u32x2*)(G8 + row * NG + (u.br + 1) * D + col);
#pragma unroll
                        for (int n = 0; n < 2; ++n)
#pragma unroll
                            for (int e = 0; e < 4; ++e) { const float sa = (float)(((n ? ga.y : ga.x) >> (8 * e)) & 255u) + 0.5f, sb = (float)(((n ? gb.y : gb.x) >> (8 * e)) & 255u) + 0.5f;
                                acc[ai][bj][m][n][e] *= sa * __builtin_amdgcn_rcpf(sb); }
                    } else {
                        float r[8];
#pragma unroll
                        for (int n = 0; n < 2; ++n)
#pragma unroll
                            for (int e = 0; e < 4; ++e) r[4 * n + e] = acc[ai][bj][m][n][e] * (((float)(((n ? ga.y : ga.x) >> (8 * e)) & 255u) + 0.5f) * (1.f / 256.f));
                        u32x4 w; w.x = cvt_pk_bf16(r[0], r[1]); w.y = cvt_pk_bf16(r[2], r[3]); w.z = cvt_pk_bf16(r[4], r[5]); w.w = cvt_pk_bf16(r[6], r[7]);
                        *(u32x4*)(Y + row * D + col) = w;
                    } } }
        return u.br < 2;
    }
};

template <class Epi>
__device__ __forceinline__ void gemm_phase(LAS unsigned char* lds, const Gemm g, const Sched& S, const Epi& E, const int tid) {
    const int wid = __builtin_amdgcn_readfirstlane(tid >> 6), lane = tid & 63, wr = wid >> 2, wc = wid & 3, fr = lane & 15, fq = lane >> 4;
    const int K = g.K, nt = K / BK, lda = g.lda;
    unsigned voffA[2], voffB[2];
#pragma unroll
    for (int i = 0; i < 2; ++i) { int R, C; stage_rc(tid * 16 + i * 8192, R, C); const int Rb = Epi::PERM ? ((R & ~31) + perm32(R & 31)) : R;
        voffA[i] = (unsigned)(R * lda + C) * 2u; voffB[i] = (unsigned)(Rb * K + C) * 2u; }
    const size_t kstep = (size_t)(BK * 2);
    const size_t hstepA = (size_t)HALF * lda * 2, hstepB = (size_t)HALF * K * 2;
    const size_t tstepA = 2 * hstepA, tstepB = 2 * hstepB;
    const unsigned ldsw = (unsigned)wid * 1024u;
    const int aoff = lds_byte(wr * 64 + fr, fq * 8), boff = lds_byte(wc * 32 + fr, fq * 8);
#define PG8_UA(u) ((const char*)((u).br == 0 ? g.A0 : ((u).br == 1 ? g.A1 : g.A2)) + (size_t)(u).pm * tstepA + (size_t)((u).pn * g.apn))
#define PG8_UB(u) ((const char*)((u).br == 0 ? g.B0 : ((u).br == 1 ? g.B1 : g.B2)) + (size_t)(u).pn * tstepB)
#define PG8_SA(b, h) (((b) * 2 + (h)) * HTB)
#define PG8_SB(b, h) ((4 + (b) * 2 + (h)) * HTB)
#define PG8_STAGE(bufoff, gbase, voff) do { _Pragma("unroll") for (int _i = 0; _i < 2; ++_i) \
        __builtin_amdgcn_global_load_lds((const unsigned*)((const char*)(gbase) + (voff)[_i]), (LAS unsigned*)(lds + (bufoff) + ldsw + _i * 8192), 16, 0, 0); } while (0)
#define PG8_LDA(dst, b, h) do { _Pragma("unroll") for (int m = 0; m < 4; ++m) _Pragma("unroll") for (int k = 0; k < 2; ++k) dst[m][k] = *(const LAS bf16x8*)(lds + PG8_SA(b, h) + aoff + m * 2048 + k * 1024); } while (0)
#define PG8_LDB(dst, b, h) do { _Pragma("unroll") for (int n = 0; n < 2; ++n) _Pragma("unroll") for (int k = 0; k < 2; ++k) dst[n][k] = *(const LAS bf16x8*)(lds + PG8_SB(b, h) + boff + n * 2048 + k * 1024); } while (0)
#define PG8_MMA(ai, bj, At, Bt) do { __builtin_amdgcn_s_setprio(1); _Pragma("unroll") for (int m = 0; m < 4; ++m) _Pragma("unroll") for (int n = 0; n < 2; ++n) _Pragma("unroll") for (int k = 0; k < 2; ++k) \
        acc[ai][bj][m][n] = __builtin_amdgcn_mfma_f32_16x16x32_bf16(Bt[n][k], At[m][k], acc[ai][bj][m][n], 0, 0, 0); __builtin_amdgcn_s_setprio(0); } while (0)
#define PG8_WAIT_V(n) asm volatile("s_waitcnt vmcnt(" #n ")" ::: "memory")
#define PG8_WAIT_L(n) asm volatile("s_waitcnt lgkmcnt(" #n ")" ::: "memory")
#define PG8_BAR __builtin_amdgcn_s_barrier()
#define PG8_SCHED __builtin_amdgcn_sched_barrier(0)
    Unit cur, nxt; int ui = 0;
    if (!S.next(0, cur)) return;
    f32x4 acc[2][2][4][2];
#pragma unroll
    for (int a = 0; a < 2; ++a)
#pragma unroll
        for (int b = 0; b < 2; ++b)
#pragma unroll
            for (int m = 0; m < 4; ++m)
#pragma unroll
                for (int n = 0; n < 2; ++n) acc[a][b][m][n] = (f32x4){0.f, 0.f, 0.f, 0.f};
    bf16x8 At[4][2], B0[2][2], B1[2][2];
    const char* cA = PG8_UA(cur); const char* cB = PG8_UB(cur);
    PG8_STAGE(PG8_SB(0, 0), cB, voffB); PG8_STAGE(PG8_SB(0, 1), cB + hstepB, voffB); PG8_STAGE(PG8_SA(0, 0), cA, voffA); PG8_STAGE(PG8_SA(0, 1), cA + hstepA, voffA);
    if (wr == 1) PG8_BAR;
    PG8_WAIT_V(2); PG8_BAR;
    PG8_STAGE(PG8_SB(1, 0), cB + kstep, voffB); PG8_STAGE(PG8_SA(1, 0), cA + kstep, voffA); PG8_STAGE(PG8_SB(1, 1), cB + hstepB + kstep, voffB);
    PG8_WAIT_V(6); PG8_BAR;
    for (;;) {
        const bool has_next = S.next(ui + 1, nxt);
        const char* nA = has_next ? PG8_UA(nxt) : cA; const char* nB = has_next ? PG8_UB(nxt) : cB;
#pragma unroll 1
        for (int t = 0; t < nt; t += 2) {
            const bool last = (t == nt - 2);
            const char* a1 = cA + (size_t)(t + 1) * kstep;
            const char* a2 = last ? nA : cA + (size_t)(t + 2) * kstep; const char* b2 = last ? nB : cB + (size_t)(t + 2) * kstep;
            const char* a3 = a2 + kstep; const char* b3 = b2 + kstep;
            PG8_LDB(B0, 0, 0); PG8_LDB(B1, 0, 1); PG8_SCHED; PG8_LDA(At, 0, 0); PG8_STAGE(PG8_SA(1, 1), a1 + hstepA, voffA);
            PG8_WAIT_V(8); PG8_WAIT_L(0); PG8_BAR; PG8_MMA(0, 0, At, B0); PG8_MMA(0, 1, At, B1); PG8_BAR; PG8_SCHED;
            PG8_LDA(At, 0, 1); PG8_STAGE(PG8_SB(0, 0), b2, voffB); PG8_STAGE(PG8_SB(0, 1), b2 + hstepB, voffB); PG8_STAGE(PG8_SA(0, 0), a2, voffA);
            PG8_WAIT_V(8); PG8_WAIT_L(0); PG8_BAR; PG8_MMA(1, 0, At, B0); PG8_MMA(1, 1, At, B1); PG8_BAR; PG8_SCHED;
            PG8_LDB(B0, 1, 0); PG8_LDB(B1, 1, 1); PG8_SCHED; PG8_LDA(At, 1, 0); PG8_STAGE(PG8_SA(0, 1), a2 + hstepA, voffA);
            PG8_WAIT_V(8); PG8_WAIT_L(0); PG8_BAR; PG8_MMA(0, 0, At, B0); PG8_MMA(0, 1, At, B1); PG8_BAR; PG8_SCHED;
            PG8_LDA(At, 1, 1); PG8_STAGE(PG8_SB(1, 0), b3, voffB); PG8_STAGE(PG8_SB(1, 1), b3 + hstepB, voffB); PG8_STAGE(PG8_SA(1, 0), a3, voffA);
            PG8_WAIT_V(8); PG8_WAIT_L(0); PG8_BAR; PG8_MMA(1, 0, At, B0); PG8_MMA(1, 1, At, B1); PG8_BAR; PG8_SCHED;
        }
        if (wr == 0) PG8_BAR;
        const bool keep = E(acc, cur, wr, wc, fr, fq);
        if (!has_next) break;
        if (!keep) {
#pragma unroll
            for (int a = 0; a < 2; ++a)
#pragma unroll
                for (int b = 0; b < 2; ++b)
#pragma unroll
                    for (int m = 0; m < 4; ++m)
#pragma unroll
                        for (int n = 0; n < 2; ++n) acc[a][b][m][n] = (f32x4){0.f, 0.f, 0.f, 0.f};
        }
        cur = nxt; cA = nA; cB = nB; ++ui;
        if (wr == 1) PG8_BAR;
    }
    PG8_WAIT_V(0);
    PG8_BAR;
#undef PG8_UA
#undef PG8_UB
#undef PG8_SA
#undef PG8_SB
#undef PG8_STAGE
#undef PG8_LDA
#undef PG8_LDB
#undef PG8_MMA
#undef PG8_WAIT_V
#undef PG8_WAIT_L
#undef PG8_BAR
#undef PG8_SCHED
}
}

namespace att {
constexpr int NW = 8, QBLK = 32, KVBLK = 64;
constexpr float SCALE = 0.088388347648318440f;
constexpr float THR = 8.f;
constexpr size_t SHM_V = KVBLK * 128 * 2, SHM_K = KVBLK * 128 * 2, SHM_ATTN = 2 * SHM_V + 2 * SHM_K + NW * 64 * 4;
#define KSWZ(row, colB) ((row) * 256 + ((colB) ^ (((row) & 7) << 4)))
#define SBAR() __builtin_amdgcn_sched_barrier(0)
__device__ __forceinline__ int crow(int r, int hi) { return (r & 3) + 8 * (r >> 2) + 4 * hi; }
__device__ __forceinline__ unsigned cvtpk(float lo, float hi) { unsigned r; asm volatile("v_cvt_pk_bf16_f32 %0, %1, %2" : "=v"(r) : "v"(lo), "v"(hi)); return r; }
__device__ __forceinline__ void partialSM(f32x16& p0, f32x16& p1, float& m_reg, float& mn, float& alpha) {
  constexpr float C = SCALE * 1.4426950408889634f;
  float pmax = p0[0];
#pragma unroll
  for (int r = 1; r < 16; ++r) pmax = fmaxf(pmax, p0[r]);
#pragma unroll
  for (int r = 0; r < 16; ++r) pmax = fmaxf(pmax, p1[r]);
  { auto rr = __builtin_amdgcn_permlane32_swap(__float_as_uint(pmax), __float_as_uint(pmax), false, false);
    pmax = fmaxf(__uint_as_float(rr[0]), __uint_as_float(rr[1])); }
  if (__builtin_expect(__all(pmax - m_reg <= THR / SCALE), 1)) { mn = m_reg; alpha = 1.f; }
  else { mn = fmaxf(m_reg, pmax); alpha = __builtin_amdgcn_exp2f((m_reg - mn) * C); m_reg = mn; }
  float mnC = -mn * C;
#pragma unroll
  for (int r = 0; r < 16; ++r) p0[r] = fmaf(p0[r], C, mnC);
#pragma unroll
  for (int r = 0; r < 16; ++r) p1[r] = fmaf(p1[r], C, mnC);
#pragma unroll
  for (int r = 0; r < 16; ++r) p0[r] = __builtin_amdgcn_exp2f(p0[r]);
}
__device__ __forceinline__ void finishSM(f32x16& p0, f32x16& p1, float alpha, float& l_reg, bf16x8& pa0, bf16x8& pa1, bf16x8& pa2, bf16x8& pa3) {
#pragma unroll
  for (int r = 0; r < 16; ++r) p1[r] = __builtin_amdgcn_exp2f(p1[r]);
  float ps = 0;
#pragma unroll
  for (int r = 0; r < 16; ++r) ps += p0[r];
#pragma unroll
  for (int r = 0; r < 16; ++r) ps += p1[r];
  { auto rr = __builtin_amdgcn_permlane32_swap(__float_as_uint(ps), __float_as_uint(ps), false, false);
    ps = __uint_as_float(rr[0]) + __uint_as_float(rr[1]); }
  l_reg = l_reg * alpha + ps;
#define PK4(P, BASE, OUT) do { unsigned a0 = cvtpk(P[BASE + 0], P[BASE + 1]), a1 = cvtpk(P[BASE + 2], P[BASE + 3]);   \
    unsigned b0 = cvtpk(P[BASE + 4], P[BASE + 5]), b1 = cvtpk(P[BASE + 6], P[BASE + 7]);                              \
    auto r0 = __builtin_amdgcn_permlane32_swap(a0, b0, false, false); auto r1 = __builtin_amdgcn_permlane32_swap(a1, b1, false, false); \
    u32x4 w = {r0[0], r1[0], r0[1], r1[1]}; OUT = *reinterpret_cast<bf16x8*>(&w); } while (0)
  PK4(p0, 0, pa0); PK4(p0, 8, pa1); PK4(p1, 0, pa2); PK4(p1, 8, pa3);
#undef PK4
}
__device__ __forceinline__ void qkt(f32x16& p0, f32x16& p1, const bf16_t* Ks, const bf16x8* qr, int r32, int hi) {
  p0 = f32x16{}; p1 = f32x16{};
#pragma unroll
  for (int d0 = 0; d0 < 8; ++d0) { int cb = (d0 * 16 + hi * 8) * 2;
    bf16x8 b0 = *reinterpret_cast<const bf16x8*>((const char*)Ks + KSWZ(r32, cb));
    bf16x8 b1 = *reinterpret_cast<const bf16x8*>((const char*)Ks + KSWZ(32 + r32, cb));
    p0 = __builtin_amdgcn_mfma_f32_32x32x16_bf16(b0, qr[d0], p0, 0, 0, 0);
    p1 = __builtin_amdgcn_mfma_f32_32x32x16_bf16(b1, qr[d0], p1, 0, 0, 0); }
}
__device__ __forceinline__ int v_st(int k, int c) { const int kk = (k & ~0xC) | ((k & 4) << 1) | ((k & 8) >> 1); return ((kk >> 3) * 4 + (c >> 5)) * 512 + ((kk & 7) * 32 + (c & 31)) * 2; }
__device__ __forceinline__ int v_rd_base(int lane) { return ((lane & 3) << 3) | (((lane >> 2) & 3) << 6) | (((lane >> 4) & 1) << 5) | (((lane >> 5) & 1) << 8); }
constexpr int v_rd_off(int d0, int ks, int half) { return d0 * 512 + ks * 4096 + half * 2048; }
template <int OFF> __device__ __forceinline__ s16x4 tr_read(int vb) {
  s16x4 r; asm volatile("ds_read_b64_tr_b16 %0, %1 offset:%2" : "=&v"(r) : "v"(vb), "i"(OFF) : "memory"); return r;
}
template <int D0> __device__ __forceinline__ void pv_one(f32x16& od, int vb, bf16x8 pa0, bf16x8 pa1, bf16x8 pa2, bf16x8 pa3) {
  const s16x4 l0 = tr_read<v_rd_off(D0, 0, 0)>(vb), h0 = tr_read<v_rd_off(D0, 0, 1)>(vb), l1 = tr_read<v_rd_off(D0, 1, 0)>(vb), h1 = tr_read<v_rd_off(D0, 1, 1)>(vb);
  const s16x4 l2 = tr_read<v_rd_off(D0, 2, 0)>(vb), h2 = tr_read<v_rd_off(D0, 2, 1)>(vb), l3 = tr_read<v_rd_off(D0, 3, 0)>(vb), h3 = tr_read<v_rd_off(D0, 3, 1)>(vb);
  asm volatile("s_waitcnt lgkmcnt(0)" ::: "memory"); SBAR();
#define PK(L, H) (bf16x8){L[0], L[1], L[2], L[3], H[0], H[1], H[2], H[3]}
  od = __builtin_amdgcn_mfma_f32_32x32x16_bf16(pa0, PK(l0, h0), od, 0, 0, 0);
  od = __builtin_amdgcn_mfma_f32_32x32x16_bf16(pa1, PK(l1, h1), od, 0, 0, 0);
  od = __builtin_amdgcn_mfma_f32_32x32x16_bf16(pa2, PK(l2, h2), od, 0, 0, 0);
  od = __builtin_amdgcn_mfma_f32_32x32x16_bf16(pa3, PK(l3, h3), od, 0, 0, 0);
#undef PK
}
__device__ __forceinline__ void pv_d0(f32x16* o, int vb, bf16x8 pa0, bf16x8 pa1, bf16x8 pa2, bf16x8 pa3) {
  pv_one<0>(o[0], vb, pa0, pa1, pa2, pa3); pv_one<1>(o[1], vb, pa0, pa1, pa2, pa3); pv_one<2>(o[2], vb, pa0, pa1, pa2, pa3); pv_one<3>(o[3], vb, pa0, pa1, pa2, pa3);
}
__device__ __forceinline__ void attn_dense_body(const bf16_t* Qb, const bf16_t* __restrict__ KL, const bf16_t* __restrict__ KC,
                                                int ntl, bf16_t* Ob, int NT, char* lds, const int tid, const bool dost = true) {
  constexpr int LDQ = NP, LDK = NP, LDO = NP;
  const int wid = tid >> 6, lane = tid & 63, r32 = lane & 31, hi = lane >> 5;
  bf16_t* V_lds = (bf16_t*)lds; bf16_t* K_lds = (bf16_t*)(lds + 2 * SHM_V);
  float* ws = (float*)(lds + 2 * SHM_V + 2 * SHM_K) + wid * 64; float* li_l = ws; float* al_l = ws + 32;
  float m_reg = -1e30f, l_reg = 0; f32x16 o[4] = {}; bf16x8 qr[8];
  const bf16_t* Qw = Qb + (long)(wid * QBLK + r32) * LDQ + hi * 8;
#pragma unroll
  for (int d0 = 0; d0 < 8; ++d0) qr[d0] = *reinterpret_cast<const bf16x8*>(Qw + d0 * 16);
  const int sr = tid >> 4, sc = (tid & 15) * 8, vst0 = v_st(sr, sc), vst1 = v_st(32 + sr, sc);
  const int vb0 = (int)(uintptr_t)V_lds + v_rd_base(lane);
  struct { bf16x8 vs0, vs1, ks0, ks1; } sr_[1];
  const int loff0 = sr * LDK + sc, loff1 = (32 + sr) * LDK + sc;
  const bf16_t* knext = (ntl > 0) ? KL : KC; int tl_ = 0;
#define SLOAD(i, t) do { const bf16_t* kt_ = knext; ++tl_; knext = (tl_ == ntl) ? KC : knext + (long)KVBLK * LDK; \
    sr_[i].vs0 = *reinterpret_cast<const bf16x8*>(kt_ + loff0 + (C_AV - C_AK)); sr_[i].vs1 = *reinterpret_cast<const bf16x8*>(kt_ + loff1 + (C_AV - C_AK)); \
    sr_[i].ks0 = *reinterpret_cast<const bf16x8*>(kt_ + loff0); sr_[i].ks1 = *reinterpret_cast<const bf16x8*>(kt_ + loff1); } while (0)
#define SWRITE(b, i) do { *(bf16x8*)((char*)V_lds + (b) * SHM_V + vst0) = sr_[i].vs0;          \
    *(bf16x8*)((char*)V_lds + (b) * SHM_V + vst1) = sr_[i].vs1; int kc = sc * 2;               \
    *(bf16x8*)((char*)K_lds + (b) * SHM_K + KSWZ(sr, kc)) = sr_[i].ks0;                       \
    *(bf16x8*)((char*)K_lds + (b) * SHM_K + KSWZ(32 + sr, kc)) = sr_[i].ks1; } while (0)
#define SWAIT() asm volatile("s_waitcnt vmcnt(0)" ::: "memory")
#define RESC(a) do { if (__any((a) < 1.f)) { if (hi == 0) al_l[r32] = (a); asm volatile("s_waitcnt lgkmcnt(0)" ::: "memory"); \
    _Pragma("unroll") for (int d = 0; d < 4; ++d) _Pragma("unroll") for (int r = 0; r < 16; ++r) o[d][r] *= al_l[crow(r, hi)]; } } while (0)
  f32x16 pA0, pA1, pB0, pB1; float mnA, mnB, alA, alB; bf16x8 pa0, pa1, pa2, pa3;
  constexpr int SE = 0, SO = 0;
  SLOAD(SE, 0); asm volatile("s_waitcnt vmcnt(0)" ::: "memory"); SWRITE(0, SE); __syncthreads();
  qkt(pA0, pA1, K_lds, qr, r32, hi); partialSM(pA0, pA1, m_reg, mnA, alA);
  SLOAD(SO, 1);
  SWAIT(); SWRITE(1, SO); __syncthreads();
  for (int j = 1; j + 1 < NT; j += 2) {
    SBAR(); qkt(pB0, pB1, (bf16_t*)((char*)K_lds + SHM_K), qr, r32, hi);
    finishSM(pA0, pA1, alA, l_reg, pa0, pa1, pa2, pa3); SBAR();
    SLOAD(SO, j + 1); SBAR();
    pv_d0(o, vb0, pa0, pa1, pa2, pa3); partialSM(pB0, pB1, m_reg, mnB, alB);
    __syncthreads(); SWAIT(); SWRITE(0, SE);
    RESC(alB); __syncthreads();
    SBAR(); qkt(pA0, pA1, K_lds, qr, r32, hi);
    finishSM(pB0, pB1, alB, l_reg, pa0, pa1, pa2, pa3); SBAR();
    SLOAD(SE, j + 2); SBAR();
    pv_d0(o, vb0 + (int)SHM_V, pa0, pa1, pa2, pa3); partialSM(pA0, pA1, m_reg, mnA, alA);
    __syncthreads(); SWAIT(); SWRITE(1, SO);
    RESC(alA); __syncthreads();
  }
  SBAR(); qkt(pB0, pB1, (bf16_t*)((char*)K_lds + SHM_K), qr, r32, hi);
  finishSM(pA0, pA1, alA, l_reg, pa0, pa1, pa2, pa3); SBAR();
  pv_d0(o, vb0, pa0, pa1, pa2, pa3); partialSM(pB0, pB1, m_reg, mnB, alB);
  __syncthreads(); RESC(alB);
  finishSM(pB0, pB1, alB, l_reg, pa0, pa1, pa2, pa3); SBAR();
  pv_d0(o, vb0 + (int)SHM_V, pa0, pa1, pa2, pa3);
  if (hi == 0) li_l[r32] = l_reg; asm volatile("s_waitcnt lgkmcnt(0)" ::: "memory");
  float rli[16];
#pragma unroll
  for (int r = 0; r < 16; ++r) rli[r] = __builtin_amdgcn_rcpf(li_l[crow(r, hi)]);
  bf16_t* Ow = Ob + (long)(wid * QBLK) * LDO;
#pragma unroll
  for (int r = 0; r < 16; ++r) { int orow = crow(r, hi);
#pragma unroll
    for (int d0 = 0; d0 < 4; ++d0) if (dost) Ow[(long)orow * LDO + d0 * 32 + r32] = (bf16_t)f2bf(o[d0][r] * rli[r]); }
  __syncthreads();
#undef SLOAD
#undef SWRITE
#undef SWAIT
#undef RESC
}
#undef KSWZ
#undef SBAR
}


#define XB_TMO      128
#define XB_XCNT(j)  (256  + 64 * (j))
#define XB_XSUB(j)  (1280 + 64 * (j))
#define XB_XGEN(j)  (2304 + 64 * (j))
#define XB_TOP      3328
#define XB_TOPGEN   3392
#define XCD_BAR_WORDS 3456
#define XB_SPIN_CAP (1u << 18)
__device__ __forceinline__ unsigned xb_ld(unsigned* p)              { return __hip_atomic_load(p, __ATOMIC_RELAXED, __HIP_MEMORY_SCOPE_AGENT); }
__device__ __forceinline__ unsigned xb_add(unsigned* p, unsigned v) { return __hip_atomic_fetch_add(p, v, __ATOMIC_RELAXED, __HIP_MEMORY_SCOPE_AGENT); }
__device__ __forceinline__ unsigned xb_xcc_id() { return (unsigned)__builtin_amdgcn_s_getreg((3 << 11) | 20) & 0xFu; }
#define XB_SPIN(cond, bar) do { unsigned _sp = 0; while (cond) { __builtin_amdgcn_s_sleep(1); \
    if ((++_sp & 255u) == 0u) { if (xb_ld(&(bar)[XB_TMO])) break; if (_sp > XB_SPIN_CAP) { atomicAdd(&(bar)[XB_TMO], 1u); break; } } } } while (0)
struct XcdBarrier { unsigned* bar; unsigned x; volatile LAS unsigned* st; };
__device__ __forceinline__ XcdBarrier xcd_barrier_post(unsigned* bar, volatile LAS unsigned* st) {
    XcdBarrier b; b.bar = bar; b.x = xb_xcc_id(); b.st = st;
    if (threadIdx.x == 0) (void)xb_add(&bar[XB_XCNT(b.x)], 1u);
    return b;
}
__device__ __forceinline__ void xcd_barrier_complete(unsigned* bar, unsigned x, unsigned& nloc, unsigned& nx) {
    const unsigned G = gridDim.x * gridDim.y * gridDim.z;
    unsigned sum, cnt, mine, sp = 0u;
    for (;;) {
        sum = 0u; cnt = 0u; mine = 0u;
#pragma unroll
        for (unsigned j = 0; j < 16; ++j) { const unsigned c = xb_ld(&bar[XB_XCNT(j)]); sum += c; cnt += (c > 0u) ? 1u : 0u; mine = (j == x) ? c : mine; }
        if (sum == G) break;
        __builtin_amdgcn_s_sleep(1);
        if ((++sp & 255u) == 0u) { if (xb_ld(&bar[XB_TMO])) break; if (sp > XB_SPIN_CAP) { atomicAdd(&bar[XB_TMO], 1u); break; } }
    }
    nloc = mine > 0u ? mine : 1u; nx = cnt > 0u ? cnt : 1u;
}
__device__ __forceinline__ void xcd_barrier(const XcdBarrier& b) {
    asm volatile("s_waitcnt vmcnt(0)" ::: "memory");
    __syncthreads();
    if (threadIdx.x == 0) {
        unsigned* bar = b.bar;
        __builtin_amdgcn_s_waitcnt(0);
        unsigned nloc = b.st[0], nx = b.st[1];
        if (nloc == 0u) { xcd_barrier_complete(bar, b.x, nloc, nx); b.st[0] = nloc; b.st[1] = nx; }
        const unsigned old = xb_add(&bar[XB_XSUB(b.x)], 1u);
        const unsigned gen = old / nloc;
        if (old + 1u == (gen + 1u) * nloc) {
            __builtin_amdgcn_fence(__ATOMIC_RELEASE, "agent");
            asm volatile("s_waitcnt vmcnt(0)" ::: "memory");
            const unsigned og = xb_add(&bar[XB_TOP], 1u);
            const unsigned tg = og / nx;
            if (og + 1u == (tg + 1u) * nx) xb_add(&bar[XB_TOPGEN], 1u);
            else XB_SPIN(xb_ld(&bar[XB_TOPGEN]) == tg, bar);
            __builtin_amdgcn_fence(__ATOMIC_ACQUIRE, "agent");
            xb_add(&bar[XB_XGEN(b.x)], 1u);
            asm volatile("s_waitcnt vmcnt(0)" ::: "memory");
        } else {
            XB_SPIN(xb_ld(&bar[XB_XGEN(b.x)]) == gen, bar);
            __builtin_amdgcn_fence(__ATOMIC_ACQUIRE, "agent");
            asm volatile("s_waitcnt vmcnt(0)" ::: "memory");
        }
    }
    __syncthreads();
}

typedef const __attribute__((address_space(4))) Args* ArgsP;
struct Fr {
    char* lds; LAS unsigned char* lds3; int tid, lane, wave, G, vcu, gw, NGW, bx;
    ArgsP ap;
};
#define WSB (F.ap->ws)
#define F_P ((bf16_t*)(WSB + WS_P))
#define F_H ((bf16_t*)(WSB + WS_H))
#define F_MIX ((bf16_t*)(WSB + WS_MIX))
#define F_CST ((bf16_t*)(WSB + WS_CST))
#define F_MOD ((float*)(WSB + WS_MOD))
#define F_LI ((float*)(WSB + WS_LI))
#define F_LF ((float*)(WSB + WS_LF))
#define F_GT ((float*)(WSB + WS_GT))
#define F_MLOC ((float*)(WSB + WS_GT) + 2048)
#define F_MIN ((float*)(WSB + WS_GT) + 4096)
#define F_NST ((float*)(WSB + WS_NST))
#define F_XC ((float*)(WSB + WS_XC))


__device__ __forceinline__ void tr_item(const float* W, int N, int k0, int n0, bf16_t* WT, int ldt, int drow0, const float* rscale, float* scr, int lane, int split = 1 << 30, int shift = 0) {
    const int cq = lane & 15, rq = lane >> 4, dn = n0 + 4 * cq, nn = dn < split ? dn : dn - shift; const bool ok = (nn < N) && (dn < split || dn >= split + shift);
    f32x4 v[16];
#pragma unroll
    for (int i = 0; i < 16; ++i) v[i] = ok ? __builtin_nontemporal_load((const f32x4*)(W + (size_t)(k0 + 4 * i + rq) * N + nn)) : (f32x4){0.f, 0.f, 0.f, 0.f};
#pragma unroll
    for (int i = 0; i < 16; ++i) { float* d = scr + (4 * i + rq) * 65 + 4 * cq; d[0] = v[i][0]; d[1] = v[i][1]; d[2] = v[i][2]; d[3] = v[i][3]; }
    asm volatile("s_waitcnt lgkmcnt(0)" ::: "memory");
    const int c = lane & 7;
#pragma unroll
    for (int j = 0; j < 8; ++j) { const int n = (lane >> 3) + 8 * j; const float* sp = scr + (8 * c) * 65 + n;
        const float sc = rscale ? rscale[n0 + n] : 1.f;
        u32x4 o; o.x = pk2(sp[0 * 65] * sc, sp[1 * 65] * sc); o.y = pk2(sp[2 * 65] * sc, sp[3 * 65] * sc); o.z = pk2(sp[4 * 65] * sc, sp[5 * 65] * sc); o.w = pk2(sp[6 * 65] * sc, sp[7 * 65] * sc);
        *(u32x4*)(WT + (size_t)(drow0 + n) * ldt + k0 + 8 * c) = o; }
    asm volatile("s_waitcnt lgkmcnt(0)" ::: "memory");
}
__device__ __forceinline__ void convert_weights(Fr& F, int l) {
    float* scr = (float*)(F.lds + F.wave * 16640);
    constexpr int I_IN = 32 * 188, I_FI = 32 * 176, I_FO = 88 * 32, I_UP = 16 * 32, I_OUT = 32 * 32, I_PL = 64;
    constexpr int NIT = I_IN + I_FI + I_FO + 3 * I_UP + I_OUT + I_PL;
    for (int it = F.gw; it < NIT; it += F.NGW) {
        int r = it;
        if (r < I_IN) { const int kb = r / 188, nb = r % 188; tr_item(F.ap->in[I_WIN] + (size_t)l * D * DIN, DIN, kb * 64, nb * 64, (bf16_t*)(WSB + WS_WIN), D, nb * 64, nullptr, scr, F.lane, C_GRAW, NP - C_GRAW); continue; } r -= I_IN;
        if (r < I_FI) { const int kb = r / 176, nb = r % 176, n0 = nb * 64, bj = n0 / DFF, jj0 = n0 % DFF;
            tr_item(F.ap->in[I_FFI] + (size_t)l * D * 2 * DFF, 2 * DFF, kb * 64, n0, (bf16_t*)(WSB + WS_WFI), D, (jj0 / 128) * 256 + bj * 128 + (jj0 % 128), nullptr, scr, F.lane); continue; } r -= I_FI;
        if (r < I_FO) { const int kb = r / 32, nb = r % 32; tr_item(F.ap->in[I_FFO] + (size_t)l * DFF * D, D, kb * 64, nb * 64, (bf16_t*)(WSB + WS_WFO), DFF, nb * 64, nullptr, scr, F.lane); continue; } r -= I_FO;
#define UPCASE(BR, IDX) if (r < I_UP) { const int kb = r / 32, nb = r % 32; \
            tr_item(F.ap->in[IDX] + (size_t)l * 1024 * D, D, kb * 64, nb * 64, (bf16_t*)(WSB + WS_WUP) + (size_t)(BR) * D * 1024, 1024, nb * 64, nullptr, scr, F.lane); continue; } r -= I_UP;
        UPCASE(0, I_UPA) UPCASE(1, I_UPM) UPCASE(2, I_UPP)
#undef UPCASE
        if (r < I_OUT) { const int kb = r / 32, nb = r % 32; tr_item(F.ap->in[I_WOUT] + (size_t)l * D * D, D, kb * 64, nb * 64, (bf16_t*)(WSB + WS_WOUT), D, nb * 64, nullptr, scr, F.lane); continue; } r -= I_OUT;
        { const int g = r / 16, q = r % 16, kb = q / 4, nb = q % 4;
          tr_item(F.ap->in[I_POOLW] + ((size_t)l * 4 + g) * 65536, 256, kb * 64, nb * 64, (bf16_t*)(WSB + WS_WPL) + (size_t)g * 65536, 256, nb * 64, F.ap->in[I_POOLS] + l * 1024 + g * 256, scr, F.lane); }
    }
}

__device__ __forceinline__ void mod_gemv(Fr& F) {
    float* sc = (float*)F.lds;
    float* red = (float*)(F.lds + 5 * 2048 * 4);
    for (int i = F.tid; i < 5 * 2048; i += 512) { const int m = i >> 11, k = i & 2047; const float v = m < 4 ? F.ap->in[I_C][m * 2048 + k] : F.ap->in[I_CCTX][k]; sc[i] = v / (1.f + __expf(-v)); }
    __syncthreads();
    const int kpar = F.lane >> 5, cl = F.lane & 31;
    for (int it = F.bx; it < 768; it += F.G) {
        const int l = it / 384, col = (it % 384) * 32 + cl;
        const float* w = F.ap->in[I_WMOD] + (size_t)l * D * 12288 + col;
        float a0 = 0, a1 = 0, a2 = 0, a3 = 0, a4 = 0;
        const int kbase = F.wave * 256 + kpar;
#pragma unroll 32
        for (int kk = 0; kk < 128; ++kk) { const int k = kbase + 2 * kk; const float wv = __builtin_nontemporal_load(w + (size_t)k * 12288);
            a0 += sc[k] * wv; a1 += sc[2048 + k] * wv; a2 += sc[4096 + k] * wv; a3 += sc[6144 + k] * wv; a4 += sc[8192 + k] * wv; }
        a0 += __shfl_xor(a0, 32); a1 += __shfl_xor(a1, 32); a2 += __shfl_xor(a2, 32); a3 += __shfl_xor(a3, 32); a4 += __shfl_xor(a4, 32);
        if (kpar == 0) { float* rp = red + F.wave * 160 + cl; rp[0] = a0; rp[32] = a1; rp[64] = a2; rp[96] = a3; rp[128] = a4; }
        __syncthreads();
        if (F.tid < 160) { float s = 0;
#pragma unroll
            for (int w8 = 0; w8 < 8; ++w8) s += red[w8 * 160 + F.tid];
            const int m = F.tid >> 5, c = (it % 384) * 32 + (F.tid & 31);
            F_MOD[((size_t)l * 5 + m) * 12288 + c] = s + F.ap->in[I_BMOD][l * 12288 + c]; }
        __syncthreads();
    }
}

__device__ __forceinline__ void ld_row(const float* p, int lane, f32x4 (&v)[8]) {
#pragma unroll
    for (int j = 0; j < 8; ++j) v[j] = __builtin_nontemporal_load((const f32x4*)p + lane + 64 * j);
}
__device__ __forceinline__ float row_rinv(const f32x4 (&v)[8]) {
    float s = 0.f;
#pragma unroll
    for (int j = 0; j < 8; ++j) s += (v[j].x * v[j].x + v[j].y * v[j].y) + (v[j].z * v[j].z + v[j].w * v[j].w);
    return 1.f / sqrtf(wave_sum(s) * (1.f / D) + EPS);
}
__device__ __forceinline__ void norm_mod_store(const f32x4 (&x)[8], const float* g, const float* sh, const float* sc, bf16_t* orow, int lane) {
    const float rinv = row_rinv(x);
#pragma unroll
    for (int j = 0; j < 8; ++j) { const int i = lane + 64 * j; const f32x4 gg = ((const f32x4*)g)[i], s1 = ((const f32x4*)sc)[i], s0 = ((const f32x4*)sh)[i];
        const f32x4 h = (x[j] * rinv * gg) * (1.f + s1) + s0;
        u32x2 w; w.x = pk2(h.x, h.y); w.y = pk2(h.z, h.w); ((u32x2*)orow)[i] = w; }
}
__device__ __forceinline__ int mod_row(int r) { return r < ML ? (r >> 12) : 4; }
__device__ __forceinline__ void phase_norm1(Fr& F, int l, const float* xlat, const float* xctx) {
    const float* g = F.ap->in[I_NORMG] + (size_t)l * 4 * D;
    for (int r = F.gw; r < MT; r += F.NGW) {
        const float* src = r < ML ? xlat + (size_t)r * D : xctx + (size_t)(r - ML) * D;
        const float* mod = F_MOD + ((size_t)l * 5 + mod_row(r)) * 12288;
        f32x4 x[8]; ld_row(src, F.lane, x);
        norm_mod_store(x, g, mod, mod + D, F_H + (size_t)r * D, F.lane);
    }
}
__device__ __forceinline__ void phase_resid(Fr& F, int l, int which, int nrows, const float* xlat_src, const float* xctx_src, bool nextnorm, const bool srcbf, const bool dstbf, const bool dost = true) {
    const float* ng = F.ap->in[I_NORMG] + (size_t)l * 4 * D;
    const bf16_t* Y = (const bf16_t*)(WSB + WS_YO);
    for (int r = F.gw; r < nrows; r += F.NGW) {
        const float* src = r < ML ? xlat_src + (size_t)r * D : xctx_src + (size_t)(r - ML) * D;
        float* dst = r < ML ? F.ap->out + (size_t)r * D : F_XC + (size_t)(r - ML) * D;
        const float* mod = F_MOD + ((size_t)l * 5 + mod_row(r)) * 12288;
        const float* gate = mod + (which == 0 ? 2 : 5) * D; const float* gy = ng + (which == 0 ? 1 : 3) * D;
        f32x4 y[8], x[8];
#pragma unroll
        for (int j = 0; j < 8; ++j) { const u32x2 w = __builtin_nontemporal_load((const u32x2*)(Y + (size_t)r * D) + F.lane + 64 * j);
            y[j] = (f32x4){__uint_as_float(w.x << 16), __uint_as_float(w.x & 0xffff0000u), __uint_as_float(w.y << 16), __uint_as_float(w.y & 0xffff0000u)}; }
        bf16_t* xb = (bf16_t*)(WSB + WS_XB) + (size_t)(r < ML ? r : 0) * D;
        if (r < ML && srcbf) {
#pragma unroll
            for (int j = 0; j < 8; ++j) { const u32x2 w = __builtin_nontemporal_load((const u32x2*)xb + F.lane + 64 * j);
                x[j] = (f32x4){__uint_as_float(w.x << 16), __uint_as_float(w.x & 0xffff0000u), __uint_as_float(w.y << 16), __uint_as_float(w.y & 0xffff0000u)}; }
        } else ld_row(src, F.lane, x);
        const float ry = row_rinv(y);
#pragma unroll
        for (int j = 0; j < 8; ++j) { const int i = F.lane + 64 * j; const f32x4 gt = ((const f32x4*)gate)[i], gg = ((const f32x4*)gy)[i];
            x[j] = x[j] + gt * (y[j] * ry * gg);
            if (dost) { if (r < ML && dstbf) { u32x2 w; w.x = pk2(x[j].x, x[j].y); w.y = pk2(x[j].z, x[j].w); ((u32x2*)xb)[i] = w; } else ((f32x4*)dst)[i] = x[j]; } }
        if (which == 0) norm_mod_store(x, ng + 2 * D, mod + 3 * D, mod + 4 * D, F_H + (size_t)r * D, F.lane);
        else if (nextnorm) { const float* mod2 = F_MOD + ((size_t)(l + 1) * 5 + mod_row(r)) * 12288;
            norm_mod_store(x, F.ap->in[I_NORMG] + (size_t)(l + 1) * 4 * D, mod2, mod2 + D, F_H + (size_t)r * D, F.lane); }
    }
}

__device__ __forceinline__ void phase_prep(Fr& F, int l, const bool dost = true) {
    const float* qkg = F.ap->in[I_QKG] + l * 256;
    const float* gb = F.ap->in[I_GATEB] + l * 16;
    const int lane = F.lane, i32 = lane & 31, sub = lane >> 5;
    float gq[4], gk[4];
#pragma unroll
    for (int e = 0; e < 4; ++e) { gq[e] = qkg[32 * e + i32]; gk[e] = qkg[128 + 32 * e + i32]; }
    const float inv = __builtin_amdgcn_exp2f(-(float)i32 * (13.287712379549449f / 32.f));
    for (int rp = F.gw; rp < MT / 2; rp += F.NGW) {
        const int r = 2 * rp + sub;
        bf16_t* prow = F_P + (size_t)r * NP;
        const bool lat = r < ML;
        const int nh = (lat || l == 0) ? 10 : 2;
        float cs0 = 1.f, sn0 = 0.f, cs1 = 1.f, sn1 = 0.f;
        if (lat) { const int t = r & 4095;
            float rev0 = (float)(t >> 6) * inv * 0.15915494309189535f, rev1 = (float)(t & 63) * inv * 0.15915494309189535f;
            rev0 -= rintf(rev0); rev1 -= rintf(rev1);
            sn0 = __builtin_amdgcn_sinf(rev0); cs0 = __builtin_amdgcn_cosf(rev0); sn1 = __builtin_amdgcn_sinf(rev1); cs1 = __builtin_amdgcn_cosf(rev1); }
        float x[10][4];
#pragma unroll
        for (int h = 0; h < 10; ++h) if (h < nh) { const int c0 = h < 2 ? C_AK + h * 128 : C_AQ + (h - 2) * 128;
#pragma unroll
            for (int e = 0; e < 4; ++e) x[h][e] = bf2f(prow[c0 + 32 * e + i32]); }
#pragma unroll
        for (int h = 0; h < 10; ++h) if (h < nh) {
            const int c0 = h < 2 ? C_AK + h * 128 : C_AQ + (h - 2) * 128;
            float ss = (x[h][0] * x[h][0] + x[h][1] * x[h][1]) + (x[h][2] * x[h][2] + x[h][3] * x[h][3]);
#pragma unroll
            for (int o = 1; o < 32; o <<= 1) ss += __shfl_xor(ss, o);
            const float rinv = __builtin_amdgcn_rsqf(ss * (1.f / 128.f) + EPS);
            const float a0 = x[h][0] * rinv * (h < 2 ? gk[0] : gq[0]), b0 = x[h][1] * rinv * (h < 2 ? gk[1] : gq[1]);
            const float a1 = x[h][2] * rinv * (h < 2 ? gk[2] : gq[2]), b1 = x[h][3] * rinv * (h < 2 ? gk[3] : gq[3]);
            if (dost) { prow[c0 + i32] = (bf16_t)f2bf(a0 * cs0 - b0 * sn0); prow[c0 + 32 + i32] = (bf16_t)f2bf(b0 * cs0 + a0 * sn0);
                        prow[c0 + 64 + i32] = (bf16_t)f2bf(a1 * cs1 - b1 * sn1); prow[c0 + 96 + i32] = (bf16_t)f2bf(b1 * cs1 + a1 * sn1); } }
        if (i32 < 16) { const int q = i32 & 7, d = q >> 2, hh = q & 3;
            const float raw = bf2f(prow[(i32 < 8 ? C_GI : C_GF) + q]);
            if (i32 < 8) F_LI[(size_t)r * 8 + q] = raw + gb[d * 8 + hh];
            else { const float xx = raw + gb[d * 8 + 4 + hh]; F_LF[(size_t)r * 8 + q] = fminf(xx, 0.f) - __logf(1.f + __expf(-fabsf(xx))); } }
    }
    const int nrows = (l == 0) ? MT : ML;
    const long total = (long)nrows * 128, nth = (long)F.G * 512;
    for (long it = (long)F.bx * 512 + F.tid; it < total; it += nth) {
        const int gi = (int)((it >> 6) & 3), c8 = (int)(it & 31) | (gi << 5), r = (int)((it >> 8) << 1) | (int)((it >> 5) & 1);
        const int T = r < ML ? SEQ : CTXL, t = r < ML ? (r & 4095) : ((r - ML) & 255);
        const bf16_t* base = F_P + (size_t)(r - t) * NP + C_PL + c8 * 8;
        float s[8] = {0, 0, 0, 0, 0, 0, 0, 0}; int cnt = 0, nwin = 0;
#define POOLW(HW) { bf16x8 v[2 * HW]; \
            _Pragma("unroll") for (int k = 0; k < 2 * HW; ++k) { const int u = t - HW + k; const bool ok = (u >= 0) && (u < T); const int uc = ok ? u : t; v[k] = *(const bf16x8*)(base + (size_t)uc * NP); cnt += ok ? 1 : 0; } \
            _Pragma("unroll") for (int k = 0; k < 2 * HW; ++k) { \
                _Pragma("unroll") for (int i = 0; i < 8; ++i) s[i] += bfs2f(v[k][i]); } nwin = 2 * HW; }
        if (gi == 0) POOLW(1) else if (gi == 1) POOLW(2) else if (gi == 2) POOLW(4) else POOLW(8)
#undef POOLW
        const bf16x8 self = *(const bf16x8*)(base + (size_t)t * NP); const float rc = __builtin_amdgcn_rcpf((float)cnt); const float ninv = (float)(nwin - cnt);
#pragma unroll
        for (int i = 0; i < 8; ++i) s[i] -= ninv * bfs2f(self[i]);
        u32x4 w; w.x = pk2(s[0] * rc - bfs2f(self[0]), s[1] * rc - bfs2f(self[1])); w.y = pk2(s[2] * rc - bfs2f(self[2]), s[3] * rc - bfs2f(self[3]));
        w.z = pk2(s[4] * rc - bfs2f(self[4]), s[5] * rc - bfs2f(self[5])); w.w = pk2(s[6] * rc - bfs2f(self[6]), s[7] * rc - bfs2f(self[7]));
        *(u32x4*)(F_MIX + (size_t)r * 1024 + c8 * 8) = w;
    }
}

__device__ __forceinline__ void chunk_bs(int cidx, int& b, int& slot) { if (cidx < 128) { b = cidx >> 5; slot = 2 + (cidx & 31); } else { b = (cidx - 128) >> 1; slot = (cidx - 128) & 1; } }
__device__ __forceinline__ int unit_idx(int b, int hh, int d, int slot) { return ((b * 4 + hh) * 2 + d) * NSLOT + slot; }
constexpr int VS = 136;
constexpr int LDS_VT = 0, LDS_KT = 256 * VS * 2, LDS_FS = LDS_KT + 128 * VS * 2, LDS_CH = LDS_FS + 5120;

__device__ __forceinline__ void stage_vt(Fr& F, bf16_t* VT, size_t R0, int hh) {
    for (int idx = F.tid; idx < 1024; idx += 512) { const int l4 = idx & 31, c8 = idx >> 5;
        const bf16_t* src = F_P + (R0 + 4 * l4) * NP + C_MV + hh * 256 + c8 * 8;
        const bf16x8 r0 = *(const bf16x8*)(src), r1 = *(const bf16x8*)(src + NP), r2 = *(const bf16x8*)(src + 2 * NP), r3 = *(const bf16x8*)(src + 3 * NP);
#pragma unroll
        for (int i = 0; i < 8; ++i) { u32x2 w; w.x = (unsigned)(unsigned short)r0[i] | ((unsigned)(unsigned short)r1[i] << 16); w.y = (unsigned)(unsigned short)r2[i] | ((unsigned)(unsigned short)r3[i] << 16);
            *(u32x2*)(VT + (c8 * 8 + i) * VS + 4 * l4) = w; } }
}
__device__ __forceinline__ void mls_cloc_unit(Fr& F, int cidx, int hh, int d, int l) {
    bf16_t* VT = (bf16_t*)(F.lds + LDS_VT); bf16_t* KT = (bf16_t*)(F.lds + LDS_KT); float* fs = (float*)(F.lds + LDS_FS);
    const int tid = F.tid, lane = F.lane, w = F.wave, fr = lane & 15, fq = lane >> 4;
    const size_t R0 = (size_t)cidx * 128; int b, slot; chunk_bs(cidx, b, slot); const int uidx = unit_idx(b, hh, d, slot);
    if (tid < 128) { const float* gb = F.ap->in[I_GATEB] + l * 16; const bf16_t* prow = F_P + (R0 + tid) * NP;
        const float xx = bf2f(prow[C_GF + d * 4 + hh]) + gb[d * 8 + 4 + hh];
        fs[tid] = fminf(xx, 0.f) - __logf(1.f + __expf(-fabsf(xx))); fs[128 + tid] = bf2f(prow[C_GI + d * 4 + hh]) + gb[d * 8 + hh]; }
    __syncthreads();
    float wend = 0.f, gtot = 0.f;
    {
        float lfv = tid < 128 ? fs[tid] : 0.f, p = lfv;
#pragma unroll
        for (int o = 1; o < 64; o <<= 1) { const float t = __shfl_up(p, o); if (lane >= o) p += t; }
        if (tid < 128 && lane == 63) fs[512 + w] = p;
        __syncthreads();
        const float tot0 = fs[512], tot1 = fs[513]; gtot = tot0 + tot1;
        const float bf_ = p + (w == 1 ? tot0 : 0.f);
        const float bsum = d == 0 ? bf_ : gtot - bf_ + lfv;
        wend = tid < 128 ? gtot - bsum + fs[128 + tid] : -3.0e38f;
        float mx = wend;
#pragma unroll
        for (int o = 1; o < 64; o <<= 1) mx = fmaxf(mx, __shfl_xor(mx, o));
        if (tid < 128 && lane == 0) fs[514 + w] = mx;
        __syncthreads();
        const float m = fmaxf(fs[514], fs[515]);
        if (tid < 128) { fs[384 + tid] = __expf(wend - m) * QK_SCALE;
            if (tid == 0) { F_GT[uidx] = gtot; F_MLOC[uidx] = m; } }
    }
    stage_vt(F, VT, R0, hh);
    __syncthreads();
    { const int l4 = tid & 31, c8 = tid >> 5;
        const bf16_t* src = F_P + (R0 + 4 * l4) * NP + C_MK + hh * 128 + c8 * 8;
        const bf16x8 r0 = *(const bf16x8*)(src), r1 = *(const bf16x8*)(src + NP), r2 = *(const bf16x8*)(src + 2 * NP), r3 = *(const bf16x8*)(src + 3 * NP);
        const float e0 = fs[384 + 4 * l4], e1 = fs[385 + 4 * l4], e2 = fs[386 + 4 * l4], e3 = fs[387 + 4 * l4];
#pragma unroll
        for (int i = 0; i < 8; ++i) { u32x2 w; w.x = pk2(bfs2f(r0[i]) * e0, bfs2f(r1[i]) * e1); w.y = pk2(bfs2f(r2[i]) * e2, bfs2f(r3[i]) * e3);
            *(u32x2*)(KT + (c8 * 8 + i) * VS + 4 * l4) = w; } }
    __syncthreads();
    f32x4 acc[2][8];
#pragma unroll
    for (int vi = 0; vi < 2; ++vi)
#pragma unroll
        for (int kb = 0; kb < 8; ++kb) acc[vi][kb] = (f32x4){0.f, 0.f, 0.f, 0.f};
#pragma unroll
    for (int lb = 0; lb < 4; ++lb) {
        bf16x8 xf[2];
#pragma unroll
        for (int vi = 0; vi < 2; ++vi) xf[vi] = *(const bf16x8*)(VT + (32 * w + 16 * vi + fr) * VS + lb * 32 + 8 * fq);
#pragma unroll
        for (int kb = 0; kb < 8; ++kb) { const bf16x8 yf = *(const bf16x8*)(KT + (16 * kb + fr) * VS + lb * 32 + 8 * fq);
#pragma unroll
            for (int vi = 0; vi < 2; ++vi) acc[vi][kb] = __builtin_amdgcn_mfma_f32_16x16x32_bf16(yf, xf[vi], acc[vi][kb], 0, 0, 0); }
    }
    bf16_t* Cst = F_CST + (size_t)uidx * 32768;
    __syncthreads();
#pragma unroll
    for (int vi = 0; vi < 2; ++vi)
#pragma unroll
        for (int kb = 0; kb < 8; ++kb)
        { u32x2 pk; pk.x = pk2(acc[vi][kb][0], acc[vi][kb][1]); pk.y = pk2(acc[vi][kb][2], acc[vi][kb][3]); *(u32x2*)(VT + (32 * w + 16 * vi + fr) * VS + 16 * kb + 4 * fq) = pk; }
    __syncthreads();
#pragma unroll
    for (int i = 0; i < 8; ++i) { const int idx = tid + 512 * i; *(u32x4*)(Cst + (idx >> 4) * 128 + (idx & 15) * 8) = *(const u32x4*)(VT + (idx >> 4) * VS + (idx & 15) * 8); }
    { const int k = tid >> 2, part = tid & 3; float sacc = 0.f;
#pragma unroll
        for (int q = 0; q < 4; ++q) { const bf16x8 t8 = *(const bf16x8*)(KT + k * VS + part * 32 + q * 8);
#pragma unroll
            for (int i = 0; i < 8; ++i) sacc += bfs2f(t8[i]); }
        sacc += __shfl_xor(sacc, 1); sacc += __shfl_xor(sacc, 2);
        if (part == 0) F_NST[(size_t)uidx * 128 + k] = sacc; }
    __syncthreads();
}
__device__ __forceinline__ int scan_slot(int d, int step) { return d == 0 ? step : (step == 0 ? 1 : (step == 1 ? 0 : 35 - step)); }
__device__ __forceinline__ void phase_scan(Fr& F, const bool dost = true) {
    const long nth = (long)F.G * 512;
    for (long gid = (long)F.bx * 512 + F.tid; gid < 32 * 4096; gid += nth) {
        const int seq = (int)(gid >> 12), vec = (int)(gid & 4095), d = seq & 1;
        bf16_t* base = F_CST + (size_t)seq * NSLOT * 32768 + vec * 8;
        float* nbase = F_NST + (size_t)seq * NSLOT * 128 + (vec & 15) * 8;
        const bool hasn = vec < 16;
        float z0 = 0.f; asm volatile("" : "+v"(z0));
        float st[8] = {z0, z0, z0, z0, z0, z0, z0, z0}, sn[8] = {z0, z0, z0, z0, z0, z0, z0, z0}; float m = 0.f;
        int slot = scan_slot(d, 0), slot1 = scan_slot(d, 1);
        bf16x8 cl = *(const bf16x8*)(base + (size_t)slot * 32768), cl1 = *(const bf16x8*)(base + (size_t)slot1 * 32768);
        f32x4 n0 = {0.f, 0.f, 0.f, 0.f}, n1 = {0.f, 0.f, 0.f, 0.f}, p0 = n0, p1 = n0;
        if (hasn) { n0 = *(const f32x4*)(nbase + slot * 128); n1 = *(const f32x4*)(nbase + slot * 128 + 4); p0 = *(const f32x4*)(nbase + slot1 * 128); p1 = *(const f32x4*)(nbase + slot1 * 128 + 4); }
        float g = F_GT[seq * NSLOT + slot], mc = F_MLOC[seq * NSLOT + slot], g1 = F_GT[seq * NSLOT + slot1], mc1 = F_MLOC[seq * NSLOT + slot1];
#pragma unroll 1
        for (int step = 0; step < NSLOT; ++step) {
            const int slot2 = scan_slot(d, step + 2 < NSLOT ? step + 2 : NSLOT - 1);
            const bool ld2 = step + 2 < NSLOT;
            bf16x8 cl2 = cl1; f32x4 q0 = p0, q1 = p1; float g2 = g1, mc2 = mc1;
            if (ld2) { cl2 = *(const bf16x8*)(base + (size_t)slot2 * 32768);
                if (hasn) { q0 = *(const f32x4*)(nbase + slot2 * 128); q1 = *(const f32x4*)(nbase + slot2 * 128 + 4); }
                g2 = F_GT[seq * NSLOT + slot2]; mc2 = F_MLOC[seq * NSLOT + slot2]; }
            asm volatile("" ::: "memory");
            if (dost) { u32x4 o; o.x = pk2(st[0], st[1]); o.y = pk2(st[2], st[3]); o.z = pk2(st[4], st[5]); o.w = pk2(st[6], st[7]);
                *(u32x4*)(base + (size_t)slot * 32768) = o;
                if (hasn) { *(f32x4*)(nbase + slot * 128) = (f32x4){sn[0], sn[1], sn[2], sn[3]}; *(f32x4*)(nbase + slot * 128 + 4) = (f32x4){sn[4], sn[5], sn[6], sn[7]}; } }
            if (vec == 0) F_MIN[seq * NSLOT + slot] = m;
            const float mn = fmaxf(g + m, mc), a = __expf(g + m - mn), s = __expf(mc - mn);
#pragma unroll
            for (int i = 0; i < 8; ++i) st[i] = a * st[i] + s * bfs2f(cl[i]);
#pragma unroll
            for (int i = 0; i < 4; ++i) { sn[i] = a * sn[i] + s * n0[i]; sn[4 + i] = a * sn[4 + i] + s * n1[i]; }
            m = mn; cl = cl1; n0 = p0; n1 = p1; g = g1; mc = mc1; slot = slot1;
            cl1 = cl2; p0 = q0; p1 = q1; g1 = g2; mc1 = mc2; slot1 = slot2; }
    }
}
__device__ __forceinline__ void mls_out_unit(Fr& F, int cidx, int hh, int l, const bool dost = true) {
    bf16_t* VT = (bf16_t*)(F.lds + LDS_VT); bf16_t* Kc = (bf16_t*)(F.lds + LDS_KT); float* fs = (float*)(F.lds + LDS_FS);
    float* lf_s = fs; float* li_s = fs + 256; float* csrc = fs + 512; float* mm = fs + 768; float* bj = fs + 1024;
    bf16_t* Ch = (bf16_t*)(F.lds + LDS_CH);
    const int tid = F.tid, lane = F.lane, w = F.wave, fr = lane & 15, fq = lane >> 4;
    const size_t R0 = (size_t)cidx * 128; int b, slot; chunk_bs(cidx, b, slot);
    if (tid < 256) { const int dd = tid >> 7, t = tid & 127; lf_s[tid] = F_LF[(R0 + t) * 8 + dd * 4 + hh]; li_s[tid] = F_LI[(R0 + t) * 8 + dd * 4 + hh]; }
    stage_vt(F, VT, R0, hh);
    for (int idx = tid; idx < 2048; idx += 512) { const int l2 = idx >> 4, c8 = idx & 15;
        *(bf16x8*)(Kc + l2 * VS + c8 * 8) = *(const bf16x8*)(F_P + (R0 + l2) * NP + C_MK + hh * 128 + c8 * 8); }
    __syncthreads();
    {
        float* tmp = (float*)(F.lds + LDS_CH);
        const bool act = tid < 256; const int dd = (tid >> 7) & 1, wp = w & 1;
        const float lfv = act ? lf_s[tid] : 0.f; float p = lfv;
#pragma unroll
        for (int o = 1; o < 64; o <<= 1) { const float t = __shfl_up(p, o); if (lane >= o) p += t; }
        if (act && lane == 63) tmp[w] = p;
        __syncthreads();
        const float t0 = tmp[2 * dd], t1 = tmp[2 * dd + 1], gt_ = t0 + t1;
        const float bfwd = p + (wp ? t0 : 0.f);
        const float bsum = dd == 0 ? bfwd : gt_ - bfwd + lfv;
        const float cs = act ? li_s[tid] - bsum : -3.0e38f;
        float pmx = cs, smx = cs;
#pragma unroll
        for (int o = 1; o < 64; o <<= 1) { const float a = __shfl_up(pmx, o), c = __shfl_down(smx, o); if (lane >= o) pmx = fmaxf(pmx, a); if (lane + o < 64) smx = fmaxf(smx, c); }
        if (act && lane == 63) tmp[4 + w] = pmx;
        __syncthreads();
        if (act) { const float other = tmp[4 + (w ^ 1)];
            float cm = dd == 0 ? (wp ? fmaxf(pmx, other) : pmx) : (wp ? smx : fmaxf(smx, other));
            cm = fmaxf(cm, F_MIN[unit_idx(b, hh, dd, slot)]);
            bj[tid] = bsum; csrc[tid] = cs; mm[tid] = cm; }
    }
    __syncthreads();
    const int j = 16 * w + fr;
    const bf16_t* prow = F_P + (R0 + j) * NP;
    f32x4 acc[16];
#pragma unroll
    for (int vb = 0; vb < 16; ++vb) acc[vb] = (f32x4){0.f, 0.f, 0.f, 0.f};
#pragma unroll 1
    for (int dd = 0; dd < 2; ++dd) {
        int jj = j; asm volatile("" : "+v"(jj));
        bf16x8 Yq[4];
#pragma unroll
        for (int kb = 0; kb < 4; ++kb) Yq[kb] = *(const bf16x8*)(F_P + (R0 + jj) * NP + C_MQ + hh * 128 + kb * 32 + 8 * fq);
        const int sgn = dd == 0 ? 1 : -1; const int bs = (4 * fq - jj) * sgn;
        const int uidx = unit_idx(b, hh, dd, slot);
        const bf16_t* Cin = F_CST + (size_t)uidx * 32768;
        const float m_in = F_MIN[uidx], mmj = mm[dd * 128 + j], bjj = bj[dd * 128 + j];
        f32x4 Sa[8];
#pragma unroll
        for (int sb = 0; sb < 8; ++sb) { Sa[sb] = (f32x4){0.f, 0.f, 0.f, 0.f};
#pragma unroll
            for (int kb = 0; kb < 4; ++kb) { const bf16x8 kf = *(const bf16x8*)(Kc + (16 * sb + fr) * VS + kb * 32 + 8 * fq);
                Sa[sb] = __builtin_amdgcn_mfma_f32_16x16x32_bf16(kf, Yq[kb], Sa[sb], 0, 0, 0); }
            __builtin_amdgcn_sched_barrier(0); }
        float dsum = 0.f;
#pragma unroll
        for (int sb = 0; sb < 8; ++sb)
#pragma unroll
            for (int e = 0; e < 4; ++e) { const int s = 16 * sb + 4 * fq + e; const bool valid = (bs + sgn * (16 * sb + e)) <= 0;
                const float wv = valid ? __expf(csrc[dd * 128 + s] - mmj) * Sa[sb][e] * QK_SCALE : 0.f; Sa[sb][e] = wv; dsum += wv; }
        dsum += __shfl_xor(dsum, 16); dsum += __shfl_xor(dsum, 32);
        float nq = 0.f; const float* nst = F_NST + (size_t)uidx * 128;
#pragma unroll
        for (int kb = 0; kb < 4; ++kb) { const f32x4 n0 = *(const f32x4*)(nst + kb * 32 + 8 * fq), n1 = *(const f32x4*)(nst + kb * 32 + 8 * fq + 4);
            nq += bfs2f(Yq[kb][0]) * n0[0] + bfs2f(Yq[kb][1]) * n0[1] + bfs2f(Yq[kb][2]) * n0[2] + bfs2f(Yq[kb][3]) * n0[3]
                + bfs2f(Yq[kb][4]) * n1[0] + bfs2f(Yq[kb][5]) * n1[1] + bfs2f(Yq[kb][6]) * n1[2] + bfs2f(Yq[kb][7]) * n1[3]; }
        nq += __shfl_xor(nq, 16); nq += __shfl_xor(nq, 32);
        const float inter = __expf(m_in - mmj);
        const float den = dsum + inter * nq;
        const float rden = 1.f / fmaxf(fabsf(den), __expf(-(bjj + mmj)));
        bf16x8 Wf[4], Yqs[4]; const float qsc = inter * rden;
#pragma unroll
        for (int kb = 0; kb < 4; ++kb) {
            u32x4 t; t.x = pk2(Sa[2 * kb][0] * rden, Sa[2 * kb][1] * rden); t.y = pk2(Sa[2 * kb][2] * rden, Sa[2 * kb][3] * rden);
            t.z = pk2(Sa[2 * kb + 1][0] * rden, Sa[2 * kb + 1][1] * rden); t.w = pk2(Sa[2 * kb + 1][2] * rden, Sa[2 * kb + 1][3] * rden);
            Wf[kb] = *reinterpret_cast<bf16x8*>(&t);
            u32x4 q; q.x = pk2(bfs2f(Yq[kb][0]) * qsc, bfs2f(Yq[kb][1]) * qsc); q.y = pk2(bfs2f(Yq[kb][2]) * qsc, bfs2f(Yq[kb][3]) * qsc);
            q.z = pk2(bfs2f(Yq[kb][4]) * qsc, bfs2f(Yq[kb][5]) * qsc); q.w = pk2(bfs2f(Yq[kb][6]) * qsc, bfs2f(Yq[kb][7]) * qsc);
            Yqs[kb] = *reinterpret_cast<bf16x8*>(&q); }
        bf16x8 pr[4];
#pragma unroll
        for (int i = 0; i < 4; ++i) { const int idx = tid + 512 * i; pr[i] = *(const bf16x8*)(Cin + (idx >> 4) * 128 + (idx & 15) * 8); }
#pragma unroll
        for (int h = 0; h < 2; ++h) {
            __syncthreads();
#pragma unroll
            for (int i = 0; i < 4; ++i) { const int idx = tid + 512 * i; *(bf16x8*)(Ch + (idx >> 4) * VS + (idx & 15) * 8) = pr[i]; }
            if (h == 0) {
#pragma unroll
                for (int i = 0; i < 4; ++i) { const int idx = tid + 512 * i; pr[i] = *(const bf16x8*)(Cin + (128 + (idx >> 4)) * 128 + (idx & 15) * 8); } }
            __syncthreads();
#pragma unroll
            for (int v8 = 0; v8 < 8; ++v8) { const int vb = 8 * h + v8;
#pragma unroll
                for (int kb = 0; kb < 4; ++kb) { const bf16x8 cf = *(const bf16x8*)(Ch + (16 * v8 + fr) * VS + kb * 32 + 8 * fq);
                    acc[vb] = __builtin_amdgcn_mfma_f32_16x16x32_bf16(cf, Yqs[kb], acc[vb], 0, 0, 0); }
#pragma unroll
                for (int kb = 0; kb < 4; ++kb) {
                    const u32x2 lo = *(const u32x2*)(VT + (16 * vb + fr) * VS + 32 * kb + 4 * fq), hi2 = *(const u32x2*)(VT + (16 * vb + fr) * VS + 32 * kb + 16 + 4 * fq);
                    u32x4 t; t.x = lo.x; t.y = lo.y; t.z = hi2.x; t.w = hi2.y;
                    acc[vb] = __builtin_amdgcn_mfma_f32_16x16x32_bf16(*reinterpret_cast<bf16x8*>(&t), Wf[kb], acc[vb], 0, 0, 0); }
                __builtin_amdgcn_sched_barrier(0);
            }
        }
    }
    float ss = 0.f;
#pragma unroll
    for (int vb = 0; vb < 16; ++vb) ss += (acc[vb][0] * acc[vb][0] + acc[vb][1] * acc[vb][1]) + (acc[vb][2] * acc[vb][2] + acc[vb][3] * acc[vb][3]);
    ss += __shfl_xor(ss, 16); ss += __shfl_xor(ss, 32);
    const float rinv = 1.f / sqrtf(ss * (1.f / 256.f) + EPS);
    const float* hg = F.ap->in[I_MLHG] + l * 1024 + hh * 256;
    bf16_t* orow = F_P + (R0 + j) * NP + C_O + hh * 256;
#pragma unroll
    for (int vb = 0; vb < 16; ++vb) { const int v0 = 16 * vb + 4 * fq;
        const u32x2 oraw = *(const u32x2*)(orow + v0); const f32x4 g4 = *(const f32x4*)(hg + v0);
        const float o0 = __uint_as_float(oraw.x << 16), o1 = __uint_as_float(oraw.x & 0xffff0000u), o2 = __uint_as_float(oraw.y << 16), o3 = __uint_as_float(oraw.y & 0xffff0000u);
        u32x2 wv; wv.x = pk2(acc[vb][0] * rinv * g4[0] * sigmoidf_(o0), acc[vb][1] * rinv * g4[1] * sigmoidf_(o1));
        wv.y = pk2(acc[vb][2] * rinv * g4[2] * sigmoidf_(o2), acc[vb][3] * rinv * g4[3] * sigmoidf_(o3));
        if (dost) *(u32x2*)(orow + v0) = wv; }
    __syncthreads();
}

#ifndef PHM
#define PHM 0xFFFF
#endif
#ifndef DUPM
#define DUPM 0
#endif
#define DOST (rep_ == ((DUPM >> RB_) & 1))
#define REP(bit) for (int rep_ = 0, RB_ = (bit); rep_ < ((DUPM >> (bit)) & 1) + 1; ++rep_)
#define GSYNC() do { ArgsP sa_ = (ArgsP)__builtin_amdgcn_kernarg_segment_ptr(); asm volatile("" : "+s"(sa_)); \
    XcdBarrier xb_; xb_.bar = (unsigned*)sa_->ws; xb_.x = xb_xcc_id(); xb_.st = misc; xcd_barrier(xb_); if (DUPM & 0x8000) xcd_barrier(xb_); } while (0)
__global__ void __launch_bounds__(512, 2) fwd_megakernel(Args args) {
    extern __shared__ __attribute__((aligned(16))) unsigned char lds_raw[];
    cg::grid_group grid = cg::this_grid();
    Fr F;
    F.lds = (char*)lds_raw; F.tid = threadIdx.x; F.lane = F.tid & 63; F.wave = __builtin_amdgcn_readfirstlane(F.tid >> 6);
    F.G = gridDim.x; F.bx = blockIdx.x; { const int bx = blockIdx.x; F.vcu = (F.G % 8 == 0) ? (bx % 8) * (F.G / 8) + bx / 8 : bx; }
    F.gw = F.bx * 8 + F.wave; F.NGW = F.G * 8;
    F.ap = (ArgsP)__builtin_amdgcn_kernarg_segment_ptr();
    LAS unsigned char* lds3 = (LAS unsigned char*)lds_raw;
#define PHB() do { int t_ = threadIdx.x; asm volatile("" : "+v"(t_)); F.tid = t_; F.lane = t_ & 63; F.wave = __builtin_amdgcn_readfirstlane(t_ >> 6); \
    ArgsP a_ = (ArgsP)__builtin_amdgcn_kernarg_segment_ptr(); asm volatile("" : "+s"(a_)); F.ap = a_; \
    unsigned lo_ = 0u; asm volatile("" : "+s"(lo_)); F.lds3 = lds3 + lo_; F.lds = (char*)F.lds3; \
    int bx_ = blockIdx.x, g_ = gridDim.x; asm volatile("" : "+s"(bx_), "+s"(g_)); F.bx = bx_; F.G = g_; F.vcu = (g_ % 8 == 0) ? (bx_ % 8) * (g_ / 8) + bx_ / 8 : bx_; F.gw = bx_ * 8 + F.wave; F.NGW = g_ * 8; } while (0)

#if PHM & (1<<0)
    volatile LAS unsigned* misc = (volatile LAS unsigned*)(lds3 + LDS_BYTES - 256);
    if (threadIdx.x < 2) misc[threadIdx.x] = 0u;
    if (blockIdx.x == 0) { unsigned* bw = (unsigned*)WSB; for (int i = threadIdx.x; i < XCD_BAR_WORDS; i += 512) __hip_atomic_store(bw + i, 0u, __ATOMIC_RELAXED, __HIP_MEMORY_SCOPE_AGENT); }
    __syncthreads();
    REP(0) { PHB();
    mod_gemv(F);
    convert_weights(F, 0); }
#endif
    __threadfence(); grid.sync();
    (void)xcd_barrier_post((unsigned*)WSB, misc);
#if PHM & (1<<1)
    REP(1) { PHB();
    phase_norm1(F, 0, F.ap->in[I_X], F.ap->in[I_CTX]); }
#endif
    GSYNC();

    for (int l = 0; l < 2; ++l) {
        const bool last = (l == 1);
        const int nMall = last ? 64 : 68;
#if PHM & (1<<2)
        PHB();
        REP(2)
        { PHB(); pg8::Gemm g{F_H, F_H, F_H, (const bf16_t*)(WSB + WS_WIN), (const bf16_t*)(WSB + WS_WIN), (const bf16_t*)(WSB + WS_WIN), D, D, 0};
          pg8::Sched S; if (!last) S.init(68, 47, 1, F.G, F.bx); else S.init(64, 47, 1, F.G, F.bx, 64, 4, 9);
          pg8::EpiWin E{F_P, (unsigned char*)(WSB + WS_G8)};
          pg8::gemm_phase<pg8::EpiWin>(F.lds3, g, S, E, F.tid); }
#endif
        GSYNC();
#if PHM & (1<<3)
        REP(3) { PHB();
        phase_prep(F, l, DOST); }
#endif
        __syncthreads();
#if PHM & (1<<5)
        REP(5) { PHB();
        for (int u = F.G - 1 - F.bx; u < 136 * 8; u += F.G) { const int cidx = u >> 3, hh = (u >> 1) & 3, d = u & 1; mls_cloc_unit(F, cidx, hh, d, l); } }
#endif
        GSYNC();
#if PHM & (1<<4)
        REP(4)
        { PHB(); const bf16_t* wp = (const bf16_t*)(WSB + WS_WPL);
          pg8::Gemm g{F_MIX, F_MIX, F_MIX, wp, wp, wp, 1024, 256, 512};
          pg8::Sched S; S.init(nMall, 4, 1, F.G, F.G - 1 - F.bx);
          pg8::EpiBf16 E{F_P + C_PL, NP};
          pg8::gemm_phase<pg8::EpiBf16>(F.lds3, g, S, E, F.tid); }
#endif
        __syncthreads();
#if PHM & (1<<6)
        REP(6) { PHB();
        phase_scan(F, DOST); }
#endif
        GSYNC();
        { const int nchunk = last ? 128 : 136;
#if PHM & (1<<7)
          REP(7) { PHB();
          for (int u = F.bx; u < nchunk * 4; u += F.G) mls_out_unit(F, u >> 2, u & 3, l, DOST); }
#endif
#if PHM & (1<<8)
          REP(8) { PHB();
          const int nun = last ? 512 : 544;
          for (int u = F.vcu; u < nun; u += F.G) {
              if (u < 512) { const int qb = u & 15, hq = (u >> 4) & 3, kvh = (u >> 6) & 1, b = u >> 7, h = kvh * 4 + hq;
                  const size_t rq = (size_t)b * SEQ + qb * 256, rk = (size_t)b * SEQ, rc = (size_t)ML + b * CTXL;
                  att::attn_dense_body(F_P + rq * NP + C_AQ + h * 128, F_P + rk * NP + C_AK + kvh * 128,
                                       F_P + rc * NP + C_AK + kvh * 128, 64, F_P + rq * NP + C_AQ + h * 128, 68, F.lds, F.tid, DOST);
              } else { const int v = u - 512, b = v >> 3, h = v & 7, kvh = h >> 2; const size_t rc = (size_t)ML + b * CTXL;
                  att::attn_dense_body(F_P + rc * NP + C_AQ + h * 128, F_P + rc * NP + C_AK + kvh * 128,
                                       F_P + rc * NP + C_AK + kvh * 128, 4, F_P + rc * NP + C_AQ + h * 128, 4, F.lds, F.tid, DOST); }
          } }
#endif
        }
        GSYNC();
#if PHM & (1<<9)
        PHB();
        REP(9)
        { PHB(); const bf16_t* wu = (const bf16_t*)(WSB + WS_WUP);
          pg8::Gemm g{F_P + C_AQ, F_P + C_O, F_P + C_PL, wu, wu + (size_t)D * 1024, wu + (size_t)2 * D * 1024, NP, 1024, 0};
          pg8::Sched S; S.init(nMall, 8, 3, F.G, F.bx);
          pg8::EpiGate E{(const unsigned char*)(WSB + WS_G8), F_H};
          pg8::gemm_phase<pg8::EpiGate>(F.lds3, g, S, E, F.tid); }
#endif
        GSYNC();
#if PHM & (1<<10)
        PHB();
        REP(10)
        { PHB(); const bf16_t* wo = (const bf16_t*)(WSB + WS_WOUT);
          pg8::Gemm g{F_H, F_H, F_H, wo, wo, wo, D, D, 0};
          pg8::Sched S; S.init(nMall, 8, 1, F.G, F.bx);
          pg8::EpiBf16 E{(bf16_t*)(WSB + WS_YO), D};
          pg8::gemm_phase<pg8::EpiBf16>(F.lds3, g, S, E, F.tid); }
#endif
        GSYNC();
#if PHM & (1<<11)
        REP(11) { PHB();
        phase_resid(F, l, 0, nMall * 256, F.ap->in[I_X], l == 0 ? F.ap->in[I_CTX] : F_XC, false, l != 0, true, DOST); }
#endif
        GSYNC();
#if PHM & (1<<12)
        PHB();
        REP(12)
        { PHB(); const bf16_t* wf = (const bf16_t*)(WSB + WS_WFI);
          pg8::Gemm g{F_H, F_H, F_H, wf, wf, wf, D, D, 0};
          pg8::Sched S; S.init(nMall, 44, 1, F.G, F.bx);
          pg8::EpiSwiglu E{(bf16_t*)(WSB + WS_HID)};
          pg8::gemm_phase<pg8::EpiSwiglu>(F.lds3, g, S, E, F.tid); }
#endif
        GSYNC();
#if PHM & (1<<13)
        PHB();
        REP(13)
        { PHB(); const bf16_t* wf = (const bf16_t*)(WSB + WS_WFO); const bf16_t* hid = (const bf16_t*)(WSB + WS_HID);
          pg8::Gemm g{hid, hid, hid, wf, wf, wf, DFF, DFF, 0};
          pg8::Sched S; S.init(nMall, 8, 1, F.G, F.bx);
          pg8::EpiBf16 E{(bf16_t*)(WSB + WS_YO), D};
          pg8::gemm_phase<pg8::EpiBf16>(F.lds3, g, S, E, F.tid); }
#endif
        GSYNC();
#if PHM & (1<<14)
        REP(14) { PHB();
        phase_resid(F, l, 1, nMall * 256, F.ap->in[I_X], F_XC, !last, true, !last, DOST);
        if (!last) { __syncthreads(); convert_weights(F, 1); } }
#endif
        GSYNC();
    }
}

extern "C" void kernel_launch(void* const* d_in, const int* in_sizes, int n_in, void* d_out, int out_size, void* d_ws, size_t ws_size, hipStream_t stream) {
    static int grid = 0;
    if (grid == 0) {
        if (n_in != 19 || out_size != ML * D || ws_size < WS_END) { fprintf(stderr, "kernel_launch: unexpected shapes n_in %d out %d ws %zu (need %zu)\n", n_in, out_size, ws_size, (size_t)WS_END); grid = -1; return; }
        int dev = 0, cus = 0, per_cu = 0;
        hipGetDevice(&dev); hipDeviceGetAttribute(&cus, hipDeviceAttributeMultiprocessorCount, dev);
        if (hipFuncSetAttribute((const void*)fwd_megakernel, hipFuncAttributeMaxDynamicSharedMemorySize, LDS_BYTES) != hipSuccess) { fprintf(stderr, "kernel_launch: hipFuncSetAttribute failed\n"); grid = -1; return; }
        if (hipOccupancyMaxActiveBlocksPerMultiprocessor(&per_cu, (const void*)fwd_megakernel, 512, LDS_BYTES) != hipSuccess || per_cu < 1) { fprintf(stderr, "kernel_launch: occupancy query gave %d\n", per_cu); per_cu = 1; }
        (void)hipGetLastError();
        grid = cus * 1;
        fprintf(stderr, "kernel_launch: cus %d per_cu %d grid %d\n", cus, per_cu, grid);
    }
    if (grid < 0) return;
    Args a{};
    for (int i = 0; i < 19; ++i) a.in[i] = (const float*)d_in[i];
    a.out = (float*)d_out; a.ws = (unsigned char*)d_ws;
    void* kargs[] = {&a};
    hipError_t e = hipLaunchCooperativeKernel((const void*)fwd_megakernel, dim3(grid), dim3(512), kargs, LDS_BYTES, stream);
    if (e != hipSuccess) fprintf(stderr, "cooperative launch failed: %s (grid %d)\n", hipGetErrorString(e), grid);
}
```

```cpp
#include <hip/hip_runtime.h>
#include <hip/hip_cooperative_groups.h>
#include <cstdio>
#include <cstdint>
namespace cg = cooperative_groups;

#define LAS __attribute__((address_space(3)))
typedef unsigned short bf16_t;
typedef short bf16x8 __attribute__((ext_vector_type(8)));
typedef short s16x4 __attribute__((ext_vector_type(4)));
typedef float f32x4 __attribute__((ext_vector_type(4)));
typedef float f32x16 __attribute__((ext_vector_type(16)));
typedef unsigned u32x4 __attribute__((ext_vector_type(4)));
typedef unsigned u32x2 __attribute__((ext_vector_type(2)));

constexpr int D = 2048, NB = 4, SEQ = 4096, CTXL = 256;
constexpr int ML = NB * SEQ, MC = NB * CTXL, MT = ML + MC;
constexpr int DIN = 11792, NP = 5888, NWIN = 12032, NG = 6144, DFF = 5632;
constexpr int C_AK = 0, C_AV = 256, C_MK = 512, C_MV = 1024, C_GI = 2048, C_GF = 2056, C_AQ = 2064, C_MQ = 3088, C_O = 3600, C_PL = 4624, C_GRAW = 5648;
constexpr float EPS = 1e-6f;
constexpr int NSLOT = 34, NUNIT = NB * 4 * 2 * NSLOT;
constexpr float QK_SCALE = 0.08838834764831845f;

constexpr size_t MiB = 1u << 20;
constexpr size_t WS_MOD = 1 * MiB;
constexpr size_t WS_LI = 2 * MiB;
constexpr size_t WS_LF = 3 * MiB;
constexpr size_t WS_GT = 4 * MiB;
constexpr size_t WS_NST = 5 * MiB;
constexpr size_t WS_WIN = 6 * MiB;
constexpr size_t WS_WFI = 54 * MiB;
constexpr size_t WS_WFO = 98 * MiB;
constexpr size_t WS_WUP = 120 * MiB;
constexpr size_t WS_WOUT = 132 * MiB;
constexpr size_t WS_WPL = 140 * MiB;
constexpr size_t WS_XC = 141 * MiB;
constexpr size_t WS_H = 149 * MiB;
constexpr size_t WS_P = 217 * MiB;
constexpr size_t WS_MIX = 617 * MiB;
constexpr size_t WS_CST = 651 * MiB;
constexpr size_t WS_XB = 719 * MiB;
constexpr size_t WS_END = 783 * MiB;
constexpr size_t WS_YO = WS_P;
constexpr size_t WS_G8 = WS_P + 196 * MiB;
constexpr size_t WS_HID = WS_P + 160 * MiB;

constexpr int LDS_BYTES = 147456;

__device__ __forceinline__ float bf2f(bf16_t v) { return __uint_as_float((unsigned)v << 16); }
__device__ __forceinline__ float bfs2f(short v) { return __uint_as_float(((unsigned)(unsigned short)v) << 16); }
typedef float f32x2_t __attribute__((ext_vector_type(2))); typedef __bf16 bf16x2_t __attribute__((ext_vector_type(2)));
__device__ __forceinline__ unsigned pk2(float lo, float hi) { const f32x2_t v = {lo, hi}; const bf16x2_t b = __builtin_convertvector(v, bf16x2_t); return __builtin_bit_cast(unsigned, b); }
__device__ __forceinline__ unsigned f2bf(float f) { return pk2(f, 0.f) & 0xffffu; }
__device__ __forceinline__ float wave_sum(float v) {
#pragma unroll
    for (int o = 1; o < 64; o <<= 1) v += __shfl_xor(v, o);
    return v;
}
__device__ __forceinline__ float sigmoidf_(float x) { return __builtin_amdgcn_rcpf(1.f + __expf(-x)); }

struct Args { const float* in[19]; float* out; unsigned char* ws; };
enum { I_X = 0, I_C, I_CTX, I_CCTX, I_WMOD, I_BMOD, I_NORMG, I_WIN, I_GATEB, I_QKG, I_MLHG, I_POOLW, I_POOLS, I_UPA, I_UPM, I_UPP, I_WOUT, I_FFI, I_FFO };

namespace pg8 {
constexpr int BM = 256, BK = 64, HALF = 128, HTB = HALF * BK * 2, STAGE_BYTES = 8 * HTB, NXCD = 8, WGM = 8;
__host__ __device__ __forceinline__ int lds_byte(int r, int c) { const int st = (r >> 4) * 2 + (c >> 5), rr = r & 15, cc = c & 31, ob = rr * 64 + cc * 2; return st * 1024 + (ob ^ (((ob >> 9) & 1) << 5)); }
__host__ __device__ __forceinline__ void stage_rc(int b, int& R, int& C) { const int st = b / 1024, sb = b % 1024, swz = sb ^ (((sb >> 9) & 1) << 5); R = (st >> 1) * 16 + swz / 64; C = (st & 1) * 32 + (swz % 64) / 2; }
__host__ __device__ __forceinline__ int perm32(int rho) { const int n = rho >> 4, i = rho & 15; return 8 * (i >> 2) + 4 * n + (i & 3); }

struct Unit { int pm, pn, br; };
struct Gemm { const bf16_t* A0; const bf16_t* A1; const bf16_t* A2; const bf16_t* B0; const bf16_t* B1; const bf16_t* B2; int lda; int K; int apn; };

struct Sched {
    int nM, nN, nBr, G, c, nT1, pm2, nM2, nT;
    __device__ void init(int nM_, int nN_, int nBr_, int G_, int c_, int pm2_ = 0, int nM2_ = 0, int nN2_ = 0) {
        nM = nM_; nN = nN_; nBr = nBr_; G = G_; c = c_; nT1 = nM * nN; pm2 = pm2_; nM2 = nM2_; nT = nT1 + nM2_ * nN2_; }
    __device__ bool next(int i, Unit& u) const {
        const int it = i / nBr; u.br = i - it * nBr;
        const long L = (long)it * G + c; if (L >= nT) return false;
        if (L < nT1) {
            int wgid = (int)L; { const int q = nT1 / NXCD, r = nT1 % NXCD, xcd = wgid % NXCD, off = wgid / NXCD; wgid = (xcd < r ? xcd * (q + 1) : r * (q + 1) + (xcd - r) * q) + off; }
            const int nig = WGM * nN, gid = wgid / nig, fm = gid * WGM, gsz = (nM - fm) < WGM ? (nM - fm) : WGM;
            u.pm = fm + ((wgid % nig) % gsz); u.pn = (wgid % nig) / gsz;
        } else { const int r = (int)L - nT1; u.pm = pm2 + r % nM2; u.pn = r / nM2; }
        return true;
    }
};

__device__ __forceinline__ unsigned cvt_pk_bf16(float lo, float hi) { unsigned r; asm volatile("v_cvt_pk_bf16_f32 %0, %1, %2" : "=v"(r) : "v"(lo), "v"(hi)); return r; }

struct EpiBf16 {
    static constexpr bool PERM = true;
    bf16_t* O; int ldc;
    __device__ __forceinline__ bool operator()(f32x4 (&acc)[2][2][4][2], const Unit& u, int wr, int wc, int fr, int fq) const {
        const int row0 = u.pm * BM + wr * 64 + fr, col0 = u.pn * BM + wc * 32 + 8 * fq;
#pragma unroll
        for (int ai = 0; ai < 2; ++ai)
#pragma unroll
            for (int m = 0; m < 4; ++m) { bf16_t* rowp = O + (size_t)(row0 + ai * HALF + m * 16) * ldc + col0;
#pragma unroll
                for (int bj = 0; bj < 2; ++bj) { const f32x4 v0 = acc[ai][bj][m][0], v1 = acc[ai][bj][m][1];
                    u32x4 w; w.x = cvt_pk_bf16(v0[0], v0[1]); w.y = cvt_pk_bf16(v0[2], v0[3]); w.z = cvt_pk_bf16(v1[0], v1[1]); w.w = cvt_pk_bf16(v1[2], v1[3]);
                    *(u32x4*)(rowp + bj * HALF) = w; } }
        return false;
    }
};
struct EpiWin {
    static constexpr bool PERM = true;
    bf16_t* O; unsigned char* G8;
    __device__ __forceinline__ bool operator()(f32x4 (&acc)[2][2][4][2], const Unit& u, int wr, int wc, int fr, int fq) const {
        const int row0 = u.pm * BM + wr * 64 + fr;
        if (u.pn < 23) {
            const int col0 = u.pn * BM + wc * 32 + 8 * fq;
#pragma unroll
            for (int ai = 0; ai < 2; ++ai)
#pragma unroll
                for (int m = 0; m < 4; ++m) { bf16_t* rowp = O + (size_t)(row0 + ai * HALF + m * 16) * NP + col0;
#pragma unroll
                    for (int bj = 0; bj < 2; ++bj) { const f32x4 v0 = acc[ai][bj][m][0], v1 = acc[ai][bj][m][1];
                        u32x4 w; w.x = cvt_pk_bf16(v0[0], v0[1]); w.y = cvt_pk_bf16(v0[2], v0[3]); w.z = cvt_pk_bf16(v1[0], v1[1]); w.w = cvt_pk_bf16(v1[2], v1[3]);
                        *(u32x4*)(rowp + bj * HALF) = w; } }
        } else {
            const int col0 = (u.pn - 23) * BM + wc * 32 + 8 * fq;
#pragma unroll
            for (int ai = 0; ai < 2; ++ai)
#pragma unroll
                for (int m = 0; m < 4; ++m) { unsigned char* rowp = G8 + (size_t)(row0 + ai * HALF + m * 16) * NG + col0;
#pragma unroll
                    for (int bj = 0; bj < 2; ++bj) { unsigned q[8];
#pragma unroll
                        for (int n = 0; n < 2; ++n)
#pragma unroll
                            for (int e = 0; e < 4; ++e) { const float sg = 256.f * __builtin_amdgcn_rcpf(1.f + __expf(-acc[ai][bj][m][n][e])); q[4 * n + e] = (unsigned)fminf(sg, 255.f); }
                        u32x2 w; w.x = q[0] | (q[1] << 8) | (q[2] << 16) | (q[3] << 24); w.y = q[4] | (q[5] << 8) | (q[6] << 16) | (q[7] << 24);
                        *(u32x2*)(rowp + bj * HALF) = w; } }
        }
        return false;
    }
};
struct EpiF32 {
    static constexpr bool PERM = false;
    float* C; int ldc;
    __device__ __forceinline__ bool operator()(f32x4 (&acc)[2][2][4][2], const Unit& u, int wr, int wc, int fr, int fq) const {
        const int row0 = u.pm * BM + wr * 64 + fr, col0 = u.pn * BM + wc * 32 + 4 * fq;
#pragma unroll
        for (int ai = 0; ai < 2; ++ai)
#pragma unroll
            for (int m = 0; m < 4; ++m) { float* rowp = C + (size_t)(row0 + ai * HALF + m * 16) * ldc + col0;
#pragma unroll
                for (int bj = 0; bj < 2; ++bj)
#pragma unroll
                    for (int n = 0; n < 2; ++n) *(f32x4*)(rowp + bj * HALF + n * 16) = acc[ai][bj][m][n]; }
        return false;
    }
};
struct EpiSwiglu {
    static constexpr bool PERM = true;
    bf16_t* O;
    __device__ __forceinline__ bool operator()(f32x4 (&acc)[2][2][4][2], const Unit& u, int wr, int wc, int fr, int fq) const {
        const int row0 = u.pm * BM + wr * 64 + fr, col0 = u.pn * HALF + wc * 32 + 8 * fq;
#pragma unroll
        for (int ai = 0; ai < 2; ++ai)
#pragma unroll
            for (int m = 0; m < 4; ++m) { bf16_t* rowp = O + (size_t)(row0 + ai * HALF + m * 16) * DFF + col0;
                float r[8];
#pragma unroll
                for (int n = 0; n < 2; ++n)
#pragma unroll
                    for (int e = 0; e < 4; ++e) { const float g = acc[ai][0][m][n][e], up = acc[ai][1][m][n][e]; r[4 * n + e] = g * up * __builtin_amdgcn_rcpf(1.f + __expf(-g)); }
                u32x4 w; w.x = cvt_pk_bf16(r[0], r[1]); w.y = cvt_pk_bf16(r[2], r[3]); w.z = cvt_pk_bf16(r[4], r[5]); w.w = cvt_pk_bf16(r[6], r[7]);
                *(u32x4*)rowp = w; }
        return false;
    }
};
struct EpiGate {
    static constexpr bool PERM = true;
    const unsigned char* G8; bf16_t* Y;
    __device__ __forceinline__ bool operator()(f32x4 (&acc)[2][2][4][2], const Unit& u, int wr, int wc, int fr, int fq) const {
        const int row0 = u.pm * BM + wr * 64 + fr, col0 = u.pn * BM + wc * 32 + 8 * fq;
#pragma unroll
        for (int ai = 0; ai < 2; ++ai)
#pragma unroll
            for (int m = 0; m < 4; ++m) { const size_t row = (size_t)(row0 + ai * HALF + m * 16);
#pragma unroll
                for (int bj = 0; bj < 2; ++bj) { const int col = col0 + bj * HALF;
                    const u32x2 ga = *(const u32x2*)(G8 + row * NG + u.br * D + col);
                    if (u.br < 2) {
                        const u32x2 gb = *(const u32x2*)(G8 + row * NG + (u.br + 1) * D + col);
#pragma unroll
                        for (int n = 0; n < 2; ++n)
#pragma unroll
                            for (int e = 0; e < 4; ++e) { const float sa = (float)(((n ? ga.y : ga.x) >> (8 * e)) & 255u) + 0.5f, sb = (float)(((n ? gb.y : gb.x) >> (8 * e)) & 255u) + 0.5f;
                                acc[ai][bj][m][n][e] *= sa * __builtin_amdgcn_rcpf(sb); }
                    } else {
                        float r[8];
#pragma unroll
                        for (int n = 0; n < 2; ++n)
#pragma unroll
                            for (int e = 0; e < 4; ++e) r[4 * n + e] = acc[ai][bj][m][n][e] * (((float)(((n ? ga.y : ga.x) >> (8 * e)) & 255u) + 0.5f) * (1.f / 256.f));
                        u32x4 w; w.x = cvt_pk_bf16(r[0], r[1]); w.y = cvt_pk_bf16(r[2], r[3]); w.z = cvt_pk_bf16(r[4], r[5]); w.w = cvt_pk_bf16(r[6], r[7]);
                        *(u32x4*)(Y + row * D + col) = w;
                    } } }
        return u.br < 2;
    }
};

template <class Epi>
__device__ __forceinline__ void gemm_phase(LAS unsigned char* lds, const Gemm g, const Sched& S, const Epi& E, const int tid) {
    const int wid = __builtin_amdgcn_readfirstlane(tid >> 6), lane = tid & 63, wr = wid >> 2, wc = wid & 3, fr = lane & 15, fq = lane >> 4;
    const int K = g.K, nt = K / BK, lda = g.lda;
    unsigned voffA[2], voffB[2];
#pragma unroll
    for (int i = 0; i < 2; ++i) { int R, C; stage_rc(tid * 16 + i * 8192, R, C); const int Rb = Epi::PERM ? ((R & ~31) + perm32(R & 31)) : R;
        voffA[i] = (unsigned)(R * lda + C) * 2u; voffB[i] = (unsigned)(Rb * K + C) * 2u; }
    const size_t kstep = (size_t)(BK * 2);
    const size_t hstepA = (size_t)HALF * lda * 2, hstepB = (size_t)HALF * K * 2;
    const size_t tstepA = 2 * hstepA, tstepB = 2 * hstepB;
    const unsigned ldsw = (unsigned)wid * 1024u;
    const int aoff = lds_byte(wr * 64 + fr, fq * 8), boff = lds_byte(wc * 32 + fr, fq * 8);
#define PG8_UA(u) ((const char*)((u).br == 0 ? g.A0 : ((u).br == 1 ? g.A1 : g.A2)) + (size_t)(u).pm * tstepA + (size_t)((u).pn * g.apn))
#define PG8_UB(u) ((const char*)((u).br == 0 ? g.B0 : ((u).br == 1 ? g.B1 : g.B2)) + (size_t)(u).pn * tstepB)
#define PG8_SA(b, h) (((b) * 2 + (h)) * HTB)
#define PG8_SB(b, h) ((4 + (b) * 2 + (h)) * HTB)
#define PG8_STAGE(bufoff, gbase, voff) do { _Pragma("unroll") for (int _i = 0; _i < 2; ++_i) \
        __builtin_amdgcn_global_load_lds((const unsigned*)((const char*)(gbase) + (voff)[_i]), (LAS unsigned*)(lds + (bufoff) + ldsw + _i * 8192), 16, 0, 0); } while (0)
#define PG8_LDA(dst, b, h) do { _Pragma("unroll") for (int m = 0; m < 4; ++m) _Pragma("unroll") for (int k = 0; k < 2; ++k) dst[m][k] = *(const LAS bf16x8*)(lds + PG8_SA(b, h) + aoff + m * 2048 + k * 1024); } while (0)
#define PG8_LDB(dst, b, h) do { _Pragma("unroll") for (int n = 0; n < 2; ++n) _Pragma("unroll") for (int k = 0; k < 2; ++k) dst[n][k] = *(const LAS bf16x8*)(lds + PG8_SB(b, h) + boff + n * 2048 + k * 1024); } while (0)
#define PG8_MMA(ai, bj, At, Bt) do { __builtin_amdgcn_s_setprio(1); _Pragma("unroll") for (int m = 0; m < 4; ++m) _Pragma("unroll") for (int n = 0; n < 2; ++n) _Pragma("unroll") for (int k = 0; k < 2; ++k) \
        acc[ai][bj][m][n] = __builtin_amdgcn_mfma_f32_16x16x32_bf16(Bt[n][k], At[m][k], acc[ai][bj][m][n], 0, 0, 0); __builtin_amdgcn_s_setprio(0); } while (0)
#define PG8_WAIT_V(n) asm volatile("s_waitcnt vmcnt(" #n ")" ::: "memory")
#define PG8_WAIT_L(n) asm volatile("s_waitcnt lgkmcnt(" #n ")" ::: "memory")
#define PG8_BAR __builtin_amdgcn_s_barrier()
#define PG8_SCHED __builtin_amdgcn_sched_barrier(0)
    Unit cur, nxt; int ui = 0;
    if (!S.next(0, cur)) return;
    f32x4 acc[2][2][4][2];
#pragma unroll
    for (int a = 0; a < 2; ++a)
#pragma unroll
        for (int b = 0; b < 2; ++b)
#pragma unroll
            for (int m = 0; m < 4; ++m)
#pragma unroll
                for (int n = 0; n < 2; ++n) acc[a][b][m][n] = (f32x4){0.f, 0.f, 0.f, 0.f};
    bf16x8 At[4][2], B0[2][2], B1[2][2];
    const char* cA = PG8_UA(cur); const char* cB = PG8_UB(cur);
    PG8_STAGE(PG8_SB(0, 0), cB, voffB); PG8_STAGE(PG8_SB(0, 1), cB + hstepB, voffB); PG8_STAGE(PG8_SA(0, 0), cA, voffA); PG8_STAGE(PG8_SA(0, 1), cA + hstepA, voffA);
    if (wr == 1) PG8_BAR;
    PG8_WAIT_V(2); PG8_BAR;
    PG8_STAGE(PG8_SB(1, 0), cB + kstep, voffB); PG8_STAGE(PG8_SA(1, 0), cA + kstep, voffA); PG8_STAGE(PG8_SB(1, 1), cB + hstepB + kstep, voffB);
    PG8_WAIT_V(6); PG8_BAR;
    for (;;) {
        const bool has_next = S.next(ui + 1, nxt);
        const char* nA = has_next ? PG8_UA(nxt) : cA; const char* nB = has_next ? PG8_UB(nxt) : cB;
#pragma unroll 1
        for (int t = 0; t < nt; t += 2) {
            const bool last = (t == nt - 2);
            const char* a1 = cA + (size_t)(t + 1) * kstep;
            const char* a2 = last ? nA : cA + (size_t)(t + 2) * kstep; const char* b2 = last ? nB : cB + (size_t)(t + 2) * kstep;
            const char* a3 = a2 + kstep; const char* b3 = b2 + kstep;
            PG8_LDB(B0, 0, 0); PG8_LDB(B1, 0, 1); PG8_SCHED; PG8_LDA(At, 0, 0); PG8_STAGE(PG8_SA(1, 1), a1 + hstepA, voffA);
            PG8_WAIT_V(8); PG8_WAIT_L(0); PG8_BAR; PG8_MMA(0, 0, At, B0); PG8_MMA(0, 1, At, B1); PG8_BAR; PG8_SCHED;
            PG8_LDA(At, 0, 1); PG8_STAGE(PG8_SB(0, 0), b2, voffB); PG8_STAGE(PG8_SB(0, 1), b2 + hstepB, voffB); PG8_STAGE(PG8_SA(0, 0), a2, voffA);
            PG8_WAIT_V(8); PG8_WAIT_L(0); PG8_BAR; PG8_MMA(1, 0, At, B0); PG8_MMA(1, 1, At, B1); PG8_BAR; PG8_SCHED;
            PG8_LDB(B0, 1, 0); PG8_LDB(B1, 1, 1); PG8_SCHED; PG8_LDA(At, 1, 0); PG8_STAGE(PG8_SA(0, 1), a2 + hstepA, voffA);
            PG8_WAIT_V(8); PG8_WAIT_L(0); PG8_BAR; PG8_MMA(0, 0, At, B0); PG8_MMA(0, 1, At, B1); PG8_BAR; PG8_SCHED;
            PG8_LDA(At, 1, 1); PG8_STAGE(PG8_SB(1, 0), b3, voffB); PG8_STAGE(PG8_SB(1, 1), b3 + hstepB, voffB); PG8_STAGE(PG8_SA(1, 0), a3, voffA);
            PG8_WAIT_V(8); PG8_WAIT_L(0); PG8_BAR; PG8_MMA(1, 0, At, B0); PG8_MMA(1, 1, At, B1); PG8_BAR; PG8_SCHED;
        }
        if (wr == 0) PG8_BAR;
        const bool keep = E(acc, cur, wr, wc, fr, fq);
        if (!has_next) break;
        if (!keep) {
#pragma unroll
            for (int a = 0; a < 2; ++a)
#pragma unroll
                for (int b = 0; b < 2; ++b)
#pragma unroll
                    for (int m = 0; m < 4; ++m)
#pragma unroll
                        for (int n = 0; n < 2; ++n) acc[a][b][m][n] = (f32x4){0.f, 0.f, 0.f, 0.f};
        }
        cur = nxt; cA = nA; cB = nB; ++ui;
        if (wr == 1) PG8_BAR;
    }
    PG8_WAIT_V(0);
    PG8_BAR;
#undef PG8_UA
#undef PG8_UB
#undef PG8_SA
#undef PG8_SB
#undef PG8_STAGE
#undef PG8_LDA
#undef PG8_LDB
#undef PG8_MMA
#undef PG8_WAIT_V
#undef PG8_WAIT_L
#undef PG8_BAR
#undef PG8_SCHED
}
}

namespace att {
constexpr int NW = 8, QBLK = 32, KVBLK = 64;
constexpr float SCALE = 0.088388347648318440f;
constexpr float THR = 8.f;
constexpr size_t SHM_V = KVBLK * 128 * 2, SHM_K = KVBLK * 128 * 2, SHM_ATTN = 2 * SHM_V + 2 * SHM_K + NW * 64 * 4;
#define KSWZ(row, colB) ((row) * 256 + ((colB) ^ (((row) & 7) << 4)))
#define SBAR() __builtin_amdgcn_sched_barrier(0)
__device__ __forceinline__ int crow(int r, int hi) { return (r & 3) + 8 * (r >> 2) + 4 * hi; }
__device__ __forceinline__ unsigned cvtpk(float lo, float hi) { unsigned r; asm volatile("v_cvt_pk_bf16_f32 %0, %1, %2" : "=v"(r) : "v"(lo), "v"(hi)); return r; }
__device__ __forceinline__ void partialSM(f32x16& p0, f32x16& p1, float& m_reg, float& mn, float& alpha) {
  constexpr float C = SCALE * 1.4426950408889634f;
  float pmax = p0[0];
#pragma unroll
  for (int r = 1; r < 16; ++r) pmax = fmaxf(pmax, p0[r]);
#pragma unroll
  for (int r = 0; r < 16; ++r) pmax = fmaxf(pmax, p1[r]);
  { auto rr = __builtin_amdgcn_permlane32_swap(__float_as_uint(pmax), __float_as_uint(pmax), false, false);
    pmax = fmaxf(__uint_as_float(rr[0]), __uint_as_float(rr[1])); }
  if (__builtin_expect(__all(pmax - m_reg <= THR / SCALE), 1)) { mn = m_reg; alpha = 1.f; }
  else { mn = fmaxf(m_reg, pmax); alpha = __builtin_amdgcn_exp2f((m_reg - mn) * C); m_reg = mn; }
  float mnC = -mn * C;
#pragma unroll
  for (int r = 0; r < 16; ++r) p0[r] = fmaf(p0[r], C, mnC);
#pragma unroll
  for (int r = 0; r < 16; ++r) p1[r] = fmaf(p1[r], C, mnC);
#pragma unroll
  for (int r = 0; r < 16; ++r) p0[r] = __builtin_amdgcn_exp2f(p0[r]);
}
__device__ __forceinline__ void finishSM(f32x16& p0, f32x16& p1, float alpha, float& l_reg, bf16x8& pa0, bf16x8& pa1, bf16x8& pa2, bf16x8& pa3) {
#pragma unroll
  for (int r = 0; r < 16; ++r) p1[r] = __builtin_amdgcn_exp2f(p1[r]);
  float ps = 0;
#pragma unroll
  for (int r = 0; r < 16; ++r) ps += p0[r];
#pragma unroll
  for (int r = 0; r < 16; ++r) ps += p1[r];
  { auto rr = __builtin_amdgcn_permlane32_swap(__float_as_uint(ps), __float_as_uint(ps), false, false);
    ps = __uint_as_float(rr[0]) + __uint_as_float(rr[1]); }
  l_reg = l_reg * alpha + ps;
#define PK4(P, BASE, OUT) do { unsigned a0 = cvtpk(P[BASE + 0], P[BASE + 1]), a1 = cvtpk(P[BASE + 2], P[BASE + 3]);   \
    unsigned b0 = cvtpk(P[BASE + 4], P[BASE + 5]), b1 = cvtpk(P[BASE + 6], P[BASE + 7]);                              \
    auto r0 = __builtin_amdgcn_permlane32_swap(a0, b0, false, false); auto r1 = __builtin_amdgcn_permlane32_swap(a1, b1, false, false); \
    u32x4 w = {r0[0], r1[0], r0[1], r1[1]}; OUT = *reinterpret_cast<bf16x8*>(&w); } while (0)
  PK4(p0, 0, pa0); PK4(p0, 8, pa1); PK4(p1, 0, pa2); PK4(p1, 8, pa3);
#undef PK4
}
__device__ __forceinline__ void qkt(f32x16& p0, f32x16& p1, const bf16_t* Ks, const bf16x8* qr, int r32, int hi) {
  p0 = f32x16{}; p1 = f32x16{};
#pragma unroll
  for (int d0 = 0; d0 < 8; ++d0) { int cb = (d0 * 16 + hi * 8) * 2;
    bf16x8 b0 = *reinterpret_cast<const bf16x8*>((const char*)Ks + KSWZ(r32, cb));
    bf16x8 b1 = *reinterpret_cast<const bf16x8*>((const char*)Ks + KSWZ(32 + r32, cb));
    p0 = __builtin_amdgcn_mfma_f32_32x32x16_bf16(b0, qr[d0], p0, 0, 0, 0);
    p1 = __builtin_amdgcn_mfma_f32_32x32x16_bf16(b1, qr[d0], p1, 0, 0, 0); }
}
__device__ __forceinline__ int v_st(int k, int c) { const int kk = (k & ~0xC) | ((k & 4) << 1) | ((k & 8) >> 1); return ((kk >> 3) * 4 + (c >> 5)) * 512 + ((kk & 7) * 32 + (c & 31)) * 2; }
__device__ __forceinline__ int v_rd_base(int lane) { return ((lane & 3) << 3) | (((lane >> 2) & 3) << 6) | (((lane >> 4) & 1) << 5) | (((lane >> 5) & 1) << 8); }
constexpr int v_rd_off(int d0, int ks, int half) { return d0 * 512 + ks * 4096 + half * 2048; }
template <int OFF> __device__ __forceinline__ s16x4 tr_read(int vb) {
  s16x4 r; asm volatile("ds_read_b64_tr_b16 %0, %1 offset:%2" : "=&v"(r) : "v"(vb), "i"(OFF) : "memory"); return r;
}
template <int D0> __device__ __forceinline__ void pv_one(f32x16& od, int vb, bf16x8 pa0, bf16x8 pa1, bf16x8 pa2, bf16x8 pa3) {
  const s16x4 l0 = tr_read<v_rd_off(D0, 0, 0)>(vb), h0 = tr_read<v_rd_off(D0, 0, 1)>(vb), l1 = tr_read<v_rd_off(D0, 1, 0)>(vb), h1 = tr_read<v_rd_off(D0, 1, 1)>(vb);
  const s16x4 l2 = tr_read<v_rd_off(D0, 2, 0)>(vb), h2 = tr_read<v_rd_off(D0, 2, 1)>(vb), l3 = tr_read<v_rd_off(D0, 3, 0)>(vb), h3 = tr_read<v_rd_off(D0, 3, 1)>(vb);
  asm volatile("s_waitcnt lgkmcnt(0)" ::: "memory"); SBAR();
#define PK(L, H) (bf16x8){L[0], L[1], L[2], L[3], H[0], H[1], H[2], H[3]}
  od = __builtin_amdgcn_mfma_f32_32x32x16_bf16(pa0, PK(l0, h0), od, 0, 0, 0);
  od = __builtin_amdgcn_mfma_f32_32x32x16_bf16(pa1, PK(l1, h1), od, 0, 0, 0);
  od = __builtin_amdgcn_mfma_f32_32x32x16_bf16(pa2, PK(l2, h2), od, 0, 0, 0);
  od = __builtin_amdgcn_mfma_f32_32x32x16_bf16(pa3, PK(l3, h3), od, 0, 0, 0);
#undef PK
}
__device__ __forceinline__ void pv_d0(f32x16* o, int vb, bf16x8 pa0, bf16x8 pa1, bf16x8 pa2, bf16x8 pa3) {
  pv_one<0>(o[0], vb, pa0, pa1, pa2, pa3); pv_one<1>(o[1], vb, pa0, pa1, pa2, pa3); pv_one<2>(o[2], vb, pa0, pa1, pa2, pa3); pv_one<3>(o[3], vb, pa0, pa1, pa2, pa3);
}
__device__ __forceinline__ void attn_dense_body(const bf16_t* Qb, const bf16_t* __restrict__ KL, const bf16_t* __restrict__ KC,
                                                int ntl, bf16_t* Ob, int NT, char* lds, const int tid, const bool dost = true) {
  constexpr int LDQ = NP, LDK = NP, LDO = NP;
  const int wid = tid >> 6, lane = tid & 63, r32 = lane & 31, hi = lane >> 5;
  bf16_t* V_lds = (bf16_t*)lds; bf16_t* K_lds = (bf16_t*)(lds + 2 * SHM_V);
  float* ws = (float*)(lds + 2 * SHM_V + 2 * SHM_K) + wid * 64; float* li_l = ws; float* al_l = ws + 32;
  float m_reg = -1e30f, l_reg = 0; f32x16 o[4] = {}; bf16x8 qr[8];
  const bf16_t* Qw = Qb + (long)(wid * QBLK + r32) * LDQ + hi * 8;
#pragma unroll
  for (int d0 = 0; d0 < 8; ++d0) qr[d0] = *reinterpret_cast<const bf16x8*>(Qw + d0 * 16);
  const int sr = tid >> 4, sc = (tid & 15) * 8, vst0 = v_st(sr, sc), vst1 = v_st(32 + sr, sc);
  const int vb0 = (int)(uintptr_t)V_lds + v_rd_base(lane);
  struct { bf16x8 vs0, vs1, ks0, ks1; } sr_[1];
  const int loff0 = sr * LDK + sc, loff1 = (32 + sr) * LDK + sc;
  const bf16_t* knext = (ntl > 0) ? KL : KC; int tl_ = 0;
#define SLOAD(i, t) do { const bf16_t* kt_ = knext; ++tl_; knext = (tl_ == ntl) ? KC : knext + (long)KVBLK * LDK; \
    sr_[i].vs0 = *reinterpret_cast<const bf16x8*>(kt_ + loff0 + (C_AV - C_AK)); sr_[i].vs1 = *reinterpret_cast<const bf16x8*>(kt_ + loff1 + (C_AV - C_AK)); \
    sr_[i].ks0 = *reinterpret_cast<const bf16x8*>(kt_ + loff0); sr_[i].ks1 = *reinterpret_cast<const bf16x8*>(kt_ + loff1); } while (0)
#define SWRITE(b, i) do { *(bf16x8*)((char*)V_lds + (b) * SHM_V + vst0) = sr_[i].vs0;          \
    *(bf16x8*)((char*)V_lds + (b) * SHM_V + vst1) = sr_[i].vs1; int kc = sc * 2;               \
    *(bf16x8*)((char*)K_lds + (b) * SHM_K + KSWZ(sr, kc)) = sr_[i].ks0;                       \
    *(bf16x8*)((char*)K_lds + (b) * SHM_K + KSWZ(32 + sr, kc)) = sr_[i].ks1; } while (0)
#define SWAIT() asm volatile("s_waitcnt vmcnt(0)" ::: "memory")
#define RESC(a) do { if (__any((a) < 1.f)) { if (hi == 0) al_l[r32] = (a); asm volatile("s_waitcnt lgkmcnt(0)" ::: "memory"); \
    _Pragma("unroll") for (int d = 0; d < 4; ++d) _Pragma("unroll") for (int r = 0; r < 16; ++r) o[d][r] *= al_l[crow(r, hi)]; } } while (0)
  f32x16 pA0, pA1, pB0, pB1; float mnA, mnB, alA, alB; bf16x8 pa0, pa1, pa2, pa3;
  constexpr int SE = 0, SO = 0;
  SLOAD(SE, 0); asm volatile("s_waitcnt vmcnt(0)" ::: "memory"); SWRITE(0, SE); __syncthreads();
  qkt(pA0, pA1, K_lds, qr, r32, hi); partialSM(pA0, pA1, m_reg, mnA, alA);
  SLOAD(SO, 1);
  SWAIT(); SWRITE(1, SO); __syncthreads();
  for (int j = 1; j + 1 < NT; j += 2) {
    SBAR(); qkt(pB0, pB1, (bf16_t*)((char*)K_lds + SHM_K), qr, r32, hi);
    finishSM(pA0, pA1, alA, l_reg, pa0, pa1, pa2, pa3); SBAR();
    SLOAD(SO, j + 1); SBAR();
    pv_d0(o, vb0, pa0, pa1, pa2, pa3); partialSM(pB0, pB1, m_reg, mnB, alB);
    __syncthreads(); SWAIT(); SWRITE(0, SE);
    RESC(alB); __syncthreads();
    SBAR(); qkt(pA0, pA1, K_lds, qr, r32, hi);
    finishSM(pB0, pB1, alB, l_reg, pa0, pa1, pa2, pa3); SBAR();
    SLOAD(SE, j + 2); SBAR();
    pv_d0(o, vb0 + (int)SHM_V, pa0, pa1, pa2, pa3); partialSM(pA0, pA1, m_reg, mnA, alA);
    __syncthreads(); SWAIT(); SWRITE(1, SO);
    RESC(alA); __syncthreads();
  }
  SBAR(); qkt(pB0, pB1, (bf16_t*)((char*)K_lds + SHM_K), qr, r32, hi);
  finishSM(pA0, pA1, alA, l_reg, pa0, pa1, pa2, pa3); SBAR();
  pv_d0(o, vb0, pa0, pa1, pa2, pa3); partialSM(pB0, pB1, m_reg, mnB, alB);
  __syncthreads(); RESC(alB);
  finishSM(pB0, pB1, alB, l_reg, pa0, pa1, pa2, pa3); SBAR();
  pv_d0(o, vb0 + (int)SHM_V, pa0, pa1, pa2, pa3);
  if (hi == 0) li_l[r32] = l_reg; asm volatile("s_waitcnt lgkmcnt(0)" ::: "memory");
  float rli[16];
#pragma unroll
  for (int r = 0; r < 16; ++r) rli[r] = __builtin_amdgcn_rcpf(li_l[crow(r, hi)]);
  bf16_t* Ow = Ob + (long)(wid * QBLK) * LDO;
#pragma unroll
  for (int r = 0; r < 16; ++r) { int orow = crow(r, hi);
#pragma unroll
    for (int d0 = 0; d0 < 4; ++d0) if (dost) Ow[(long)orow * LDO + d0 * 32 + r32] = (bf16_t)f2bf(o[d0][r] * rli[r]); }
  __syncthreads();
#undef SLOAD
#undef SWRITE
#undef SWAIT
#undef RESC
}
#undef KSWZ
#undef SBAR
}


#define XB_TMO      128
#define XB_XCNT(j)  (256  + 64 * (j))
#define XB_XSUB(j)  (1280 + 64 * (j))
#define XB_XGEN(j)  (2304 + 64 * (j))
#define XB_TOP      3328
#define XB_TOPGEN   3392
#define XCD_BAR_WORDS 3456
#define XB_SPIN_CAP (1u << 18)
__device__ __forceinline__ unsigned xb_ld(unsigned* p)              { return __hip_atomic_load(p, __ATOMIC_RELAXED, __HIP_MEMORY_SCOPE_AGENT); }
__device__ __forceinline__ unsigned xb_add(unsigned* p, unsigned v) { return __hip_atomic_fetch_add(p, v, __ATOMIC_RELAXED, __HIP_MEMORY_SCOPE_AGENT); }
__device__ __forceinline__ unsigned xb_xcc_id() { return (unsigned)__builtin_amdgcn_s_getreg((3 << 11) | 20) & 0xFu; }
#define XB_SPIN(cond, bar) do { unsigned _sp = 0; while (cond) { __builtin_amdgcn_s_sleep(1); \
    if ((++_sp & 255u) == 0u) { if (xb_ld(&(bar)[XB_TMO])) break; if (_sp > XB_SPIN_CAP) { atomicAdd(&(bar)[XB_TMO], 1u); break; } } } } while (0)
struct XcdBarrier { unsigned* bar; unsigned x; volatile LAS unsigned* st; };
__device__ __forceinline__ XcdBarrier xcd_barrier_post(unsigned* bar, volatile LAS unsigned* st) {
    XcdBarrier b; b.bar = bar; b.x = xb_xcc_id(); b.st = st;
    if (threadIdx.x == 0) (void)xb_add(&bar[XB_XCNT(b.x)], 1u);
    return b;
}
__device__ __forceinline__ void xcd_barrier_complete(unsigned* bar, unsigned x, unsigned& nloc, unsigned& nx) {
    const unsigned G = gridDim.x * gridDim.y * gridDim.z;
    unsigned sum, cnt, mine, sp = 0u;
    for (;;) {
        sum = 0u; cnt = 0u; mine = 0u;
#pragma unroll
        for (unsigned j = 0; j < 16; ++j) { const unsigned c = xb_ld(&bar[XB_XCNT(j)]); sum += c; cnt += (c > 0u) ? 1u : 0u; mine = (j == x) ? c : mine; }
        if (sum == G) break;
        __builtin_amdgcn_s_sleep(1);
        if ((++sp & 255u) == 0u) { if (xb_ld(&bar[XB_TMO])) break; if (sp > XB_SPIN_CAP) { atomicAdd(&bar[XB_TMO], 1u); break; } }
    }
    nloc = mine > 0u ? mine : 1u; nx = cnt > 0u ? cnt : 1u;
}
__device__ __forceinline__ void xcd_barrier(const XcdBarrier& b) {
    asm volatile("s_waitcnt vmcnt(0)" ::: "memory");
    __syncthreads();
    if (threadIdx.x == 0) {
        unsigned* bar = b.bar;
        __builtin_amdgcn_s_waitcnt(0);
        unsigned nloc = b.st[0], nx = b.st[1];
        if (nloc == 0u) { xcd_barrier_complete(bar, b.x, nloc, nx); b.st[0] = nloc; b.st[1] = nx; }
        const unsigned old = xb_add(&bar[XB_XSUB(b.x)], 1u);
        const unsigned gen = old / nloc;
        if (old + 1u == (gen + 1u) * nloc) {
            __builtin_amdgcn_fence(__ATOMIC_RELEASE, "agent");
            asm volatile("s_waitcnt vmcnt(0)" ::: "memory");
            const unsigned og = xb_add(&bar[XB_TOP], 1u);
            const unsigned tg = og / nx;
            if (og + 1u == (tg + 1u) * nx) xb_add(&bar[XB_TOPGEN], 1u);
            else XB_SPIN(xb_ld(&bar[XB_TOPGEN]) == tg, bar);
            __builtin_amdgcn_fence(__ATOMIC_ACQUIRE, "agent");
            xb_add(&bar[XB_XGEN(b.x)], 1u);
            asm volatile("s_waitcnt vmcnt(0)" ::: "memory");
        } else {
            XB_SPIN(xb_ld(&bar[XB_XGEN(b.x)]) == gen, bar);
            __builtin_amdgcn_fence(__ATOMIC_ACQUIRE, "agent");
            asm volatile("s_waitcnt vmcnt(0)" ::: "memory");
        }
    }
    __syncthreads();
}

typedef const __attribute__((address_space(4))) Args* ArgsP;
struct Fr {
    char* lds; LAS unsigned char* lds3; int tid, lane, wave, G, vcu, gw, NGW, bx;
    ArgsP ap;
};
#define WSB (F.ap->ws)
#define F_P ((bf16_t*)(WSB + WS_P))
#define F_H ((bf16_t*)(WSB + WS_H))
#define F_MIX ((bf16_t*)(WSB + WS_MIX))
#define F_CST ((bf16_t*)(WSB + WS_CST))
#define F_MOD ((float*)(WSB + WS_MOD))
#define F_LI ((float*)(WSB + WS_LI))
#define F_LF ((float*)(WSB + WS_LF))
#define F_GT ((float*)(WSB + WS_GT))
#define F_MLOC ((float*)(WSB + WS_GT) + 2048)
#define F_MIN ((float*)(WSB + WS_GT) + 4096)
#define F_NST ((float*)(WSB + WS_NST))
#define F_XC ((float*)(WSB + WS_XC))


__device__ __forceinline__ void tr_item(const float* W, int N, int k0, int n0, bf16_t* WT, int ldt, int drow0, const float* rscale, float* scr, int lane, int split = 1 << 30, int shift = 0) {
    const int cq = lane & 15, rq = lane >> 4, dn = n0 + 4 * cq, nn = dn < split ? dn : dn - shift; const bool ok = (nn < N) && (dn < split || dn >= split + shift);
    f32x4 v[16];
#pragma unroll
    for (int i = 0; i < 16; ++i) v[i] = ok ? __builtin_nontemporal_load((const f32x4*)(W + (size_t)(k0 + 4 * i + rq) * N + nn)) : (f32x4){0.f, 0.f, 0.f, 0.f};
#pragma unroll
    for (int i = 0; i < 16; ++i) { float* d = scr + (4 * i + rq) * 65 + 4 * cq; d[0] = v[i][0]; d[1] = v[i][1]; d[2] = v[i][2]; d[3] = v[i][3]; }
    asm volatile("s_waitcnt lgkmcnt(0)" ::: "memory");
    const int c = lane & 7;
#pragma unroll
    for (int j = 0; j < 8; ++j) { const int n = (lane >> 3) + 8 * j; const float* sp = scr + (8 * c) * 65 + n;
        const float sc = rscale ? rscale[n0 + n] : 1.f;
        u32x4 o; o.x = pk2(sp[0 * 65] * sc, sp[1 * 65] * sc); o.y = pk2(sp[2 * 65] * sc, sp[3 * 65] * sc); o.z = pk2(sp[4 * 65] * sc, sp[5 * 65] * sc); o.w = pk2(sp[6 * 65] * sc, sp[7 * 65] * sc);
        *(u32x4*)(WT + (size_t)(drow0 + n) * ldt + k0 + 8 * c) = o; }
    asm volatile("s_waitcnt lgkmcnt(0)" ::: "memory");
}
__device__ __forceinline__ void convert_weights(Fr& F, int l) {
    float* scr = (float*)(F.lds + F.wave * 16640);
    constexpr int I_IN = 32 * 188, I_FI = 32 * 176, I_FO = 88 * 32, I_UP = 16 * 32, I_OUT = 32 * 32, I_PL = 64;
    constexpr int NIT = I_IN + I_FI + I_FO + 3 * I_UP + I_OUT + I_PL;
    for (int it = F.gw; it < NIT; it += F.NGW) {
        int r = it;
        if (r < I_IN) { const int kb = r / 188, nb = r % 188; tr_item(F.ap->in[I_WIN] + (size_t)l * D * DIN, DIN, kb * 64, nb * 64, (bf16_t*)(WSB + WS_WIN), D, nb * 64, nullptr, scr, F.lane, C_GRAW, NP - C_GRAW); continue; } r -= I_IN;
        if (r < I_FI) { const int kb = r / 176, nb = r % 176, n0 = nb * 64, bj = n0 / DFF, jj0 = n0 % DFF;
            tr_item(F.ap->in[I_FFI] + (size_t)l * D * 2 * DFF, 2 * DFF, kb * 64, n0, (bf16_t*)(WSB + WS_WFI), D, (jj0 / 128) * 256 + bj * 128 + (jj0 % 128), nullptr, scr, F.lane); continue; } r -= I_FI;
        if (r < I_FO) { const int kb = r / 32, nb = r % 32; tr_item(F.ap->in[I_FFO] + (size_t)l * DFF * D, D, kb * 64, nb * 64, (bf16_t*)(WSB + WS_WFO), DFF, nb * 64, nullptr, scr, F.lane); continue; } r -= I_FO;
#define UPCASE(BR, IDX) if (r < I_UP) { const int kb = r / 32, nb = r % 32; \
            tr_item(F.ap->in[IDX] + (size_t)l * 1024 * D, D, kb * 64, nb * 64, (bf16_t*)(WSB + WS_WUP) + (size_t)(BR) * D * 1024, 1024, nb * 64, nullptr, scr, F.lane); continue; } r -= I_UP;
        UPCASE(0, I_UPA) UPCASE(1, I_UPM) UPCASE(2, I_UPP)
#undef UPCASE
        if (r < I_OUT) { const int kb = r / 32, nb = r % 32; tr_item(F.ap->in[I_WOUT] + (size_t)l * D * D, D, kb * 64, nb * 64, (bf16_t*)(WSB + WS_WOUT), D, nb * 64, nullptr, scr, F.lane); continue; } r -= I_OUT;
        { const int g = r / 16, q = r % 16, kb = q / 4, nb = q % 4;
          tr_item(F.ap->in[I_POOLW] + ((size_t)l * 4 + g) * 65536, 256, kb * 64, nb * 64, (bf16_t*)(WSB + WS_WPL) + (size_t)g * 65536, 256, nb * 64, F.ap->in[I_POOLS] + l * 1024 + g * 256, scr, F.lane); }
    }
}

__device__ __forceinline__ void mod_gemv(Fr& F) {
    float* sc = (float*)F.lds;
    float* red = (float*)(F.lds + 5 * 2048 * 4);
    for (int i = F.tid; i < 5 * 2048; i += 512) { const int m = i >> 11, k = i & 2047; const float v = m < 4 ? F.ap->in[I_C][m * 2048 + k] : F.ap->in[I_CCTX][k]; sc[i] = v / (1.f + __expf(-v)); }
    __syncthreads();
    const int kpar = F.lane >> 5, cl = F.lane & 31;
    for (int it = F.bx; it < 768; it += F.G) {
        const int l = it / 384, col = (it % 384) * 32 + cl;
        const float* w = F.ap->in[I_WMOD] + (size_t)l * D * 12288 + col;
        float a0 = 0, a1 = 0, a2 = 0, a3 = 0, a4 = 0;
        const int kbase = F.wave * 256 + kpar;
#pragma unroll 32
        for (int kk = 0; kk < 128; ++kk) { const int k = kbase + 2 * kk; const float wv = __builtin_nontemporal_load(w + (size_t)k * 12288);
            a0 += sc[k] * wv; a1 += sc[2048 + k] * wv; a2 += sc[4096 + k] * wv; a3 += sc[6144 + k] * wv; a4 += sc[8192 + k] * wv; }
        a0 += __shfl_xor(a0, 32); a1 += __shfl_xor(a1, 32); a2 += __shfl_xor(a2, 32); a3 += __shfl_xor(a3, 32); a4 += __shfl_xor(a4, 32);
        if (kpar == 0) { float* rp = red + F.wave * 160 + cl; rp[0] = a0; rp[32] = a1; rp[64] = a2; rp[96] = a3; rp[128] = a4; }
        __syncthreads();
        if (F.tid < 160) { float s = 0;
#pragma unroll
            for (int w8 = 0; w8 < 8; ++w8) s += red[w8 * 160 + F.tid];
            const int m = F.tid >> 5, c = (it % 384) * 32 + (F.tid & 31);
            F_MOD[((size_t)l * 5 + m) * 12288 + c] = s + F.ap->in[I_BMOD][l * 12288 + c]; }
        __syncthreads();
    }
}

__device__ __forceinline__ void ld_row(const float* p, int lane, f32x4 (&v)[8]) {
#pragma unroll
    for (int j = 0; j < 8; ++j) v[j] = __builtin_nontemporal_load((const f32x4*)p + lane + 64 * j);
}
__device__ __forceinline__ float row_rinv(const f32x4 (&v)[8]) {
    float s = 0.f;
#pragma unroll
    for (int j = 0; j < 8; ++j) s += (v[j].x * v[j].x + v[j].y * v[j].y) + (v[j].z * v[j].z + v[j].w * v[j].w);
    return 1.f / sqrtf(wave_sum(s) * (1.f / D) + EPS);
}
__device__ __forceinline__ void norm_mod_store(const f32x4 (&x)[8], const float* g, const float* sh, const float* sc, bf16_t* orow, int lane) {
    const float rinv = row_rinv(x);
#pragma unroll
    for (int j = 0; j < 8; ++j) { const int i = lane + 64 * j; const f32x4 gg = ((const f32x4*)g)[i], s1 = ((const f32x4*)sc)[i], s0 = ((const f32x4*)sh)[i];
        const f32x4 h = (x[j] * rinv * gg) * (1.f + s1) + s0;
        u32x2 w; w.x = pk2(h.x, h.y); w.y = pk2(h.z, h.w); ((u32x2*)orow)[i] = w; }
}
__device__ __forceinline__ int mod_row(int r) { return r < ML ? (r >> 12) : 4; }
__device__ __forceinline__ void phase_norm1(Fr& F, int l, const float* xlat, const float* xctx) {
    const float* g = F.ap->in[I_NORMG] + (size_t)l * 4 * D;
    for (int r = F.gw; r < MT; r += F.NGW) {
        const float* src = r < ML ? xlat + (size_t)r * D : xctx + (size_t)(r - ML) * D;
        const float* mod = F_MOD + ((size_t)l * 5 + mod_row(r)) * 12288;
        f32x4 x[8]; ld_row(src, F.lane, x);
        norm_mod_store(x, g, mod, mod + D, F_H + (size_t)r * D, F.lane);
    }
}
__device__ __forceinline__ void phase_resid(Fr& F, int l, int which, int nrows, const float* xlat_src, const float* xctx_src, bool nextnorm, const bool srcbf, const bool dstbf, const bool dost = true) {
    const float* ng = F.ap->in[I_NORMG] + (size_t)l * 4 * D;
    const bf16_t* Y = (const bf16_t*)(WSB + WS_YO);
    for (int r = F.gw; r < nrows; r += F.NGW) {
        const float* src = r < ML ? xlat_src + (size_t)r * D : xctx_src + (size_t)(r - ML) * D;
        float* dst = r < ML ? F.ap->out + (size_t)r * D : F_XC + (size_t)(r - ML) * D;
        const float* mod = F_MOD + ((size_t)l * 5 + mod_row(r)) * 12288;
        const float* gate = mod + (which == 0 ? 2 : 5) * D; const float* gy = ng + (which == 0 ? 1 : 3) * D;
        f32x4 y[8], x[8];
#pragma unroll
        for (int j = 0; j < 8; ++j) { const u32x2 w = __builtin_nontemporal_load((const u32x2*)(Y + (size_t)r * D) + F.lane + 64 * j);
            y[j] = (f32x4){__uint_as_float(w.x << 16), __uint_as_float(w.x & 0xffff0000u), __uint_as_float(w.y << 16), __uint_as_float(w.y & 0xffff0000u)}; }
        bf16_t* xb = (bf16_t*)(WSB + WS_XB) + (size_t)(r < ML ? r : 0) * D;
        if (r < ML && srcbf) {
#pragma unroll
            for (int j = 0; j < 8; ++j) { const u32x2 w = __builtin_nontemporal_load((const u32x2*)xb + F.lane + 64 * j);
                x[j] = (f32x4){__uint_as_float(w.x << 16), __uint_as_float(w.x & 0xffff0000u), __uint_as_float(w.y << 16), __uint_as_float(w.y & 0xffff0000u)}; }
        } else ld_row(src, F.lane, x);
        const float ry = row_rinv(y);
#pragma unroll
        for (int j = 0; j < 8; ++j) { const int i = F.lane + 64 * j; const f32x4 gt = ((const f32x4*)gate)[i], gg = ((const f32x4*)gy)[i];
            x[j] = x[j] + gt * (y[j] * ry * gg);
            if (dost) { if (r < ML && dstbf) { u32x2 w; w.x = pk2(x[j].x, x[j].y); w.y = pk2(x[j].z, x[j].w); ((u32x2*)xb)[i] = w; } else ((f32x4*)dst)[i] = x[j]; } }
        if (which == 0) norm_mod_store(x, ng + 2 * D, mod + 3 * D, mod + 4 * D, F_H + (size_t)r * D, F.lane);
        else if (nextnorm) { const float* mod2 = F_MOD + ((size_t)(l + 1) * 5 + mod_row(r)) * 12288;
            norm_mod_store(x, F.ap->in[I_NORMG] + (size_t)(l + 1) * 4 * D, mod2, mod2 + D, F_H + (size_t)r * D, F.lane); }
    }
}

__device__ __forceinline__ void phase_prep(Fr& F, int l, const bool dost = true) {
    const float* qkg = F.ap->in[I_QKG] + l * 256;
    const float* gb = F.ap->in[I_GATEB] + l * 16;
    const int lane = F.lane, i32 = lane & 31, sub = lane >> 5;
    float gq[4], gk[4];
#pragma unroll
    for (int e = 0; e < 4; ++e) { gq[e] = qkg[32 * e + i32]; gk[e] = qkg[128 + 32 * e + i32]; }
    const float inv = __builtin_amdgcn_exp2f(-(float)i32 * (13.287712379549449f / 32.f));
    for (int rp = F.gw; rp < MT / 2; rp += F.NGW) {
        const int r = 2 * rp + sub;
        bf16_t* prow = F_P + (size_t)r * NP;
        const bool lat = r < ML;
        const int nh = (lat || l == 0) ? 10 : 2;
        float cs0 = 1.f, sn0 = 0.f, cs1 = 1.f, sn1 = 0.f;
        if (lat) { const int t = r & 4095;
            float rev0 = (float)(t >> 6) * inv * 0.15915494309189535f, rev1 = (float)(t & 63) * inv * 0.15915494309189535f;
            rev0 -= rintf(rev0); rev1 -= rintf(rev1);
            sn0 = __builtin_amdgcn_sinf(rev0); cs0 = __builtin_amdgcn_cosf(rev0); sn1 = __builtin_amdgcn_sinf(rev1); cs1 = __builtin_amdgcn_cosf(rev1); }
        float x[10][4];
#pragma unroll
        for (int h = 0; h < 10; ++h) if (h < nh) { const int c0 = h < 2 ? C_AK + h * 128 : C_AQ + (h - 2) * 128;
#pragma unroll
            for (int e = 0; e < 4; ++e) x[h][e] = bf2f(prow[c0 + 32 * e + i32]); }
#pragma unroll
        for (int h = 0; h < 10; ++h) if (h < nh) {
            const int c0 = h < 2 ? C_AK + h * 128 : C_AQ + (h - 2) * 128;
            float ss = (x[h][0] * x[h][0] + x[h][1] * x[h][1]) + (x[h][2] * x[h][2] + x[h][3] * x[h][3]);
#pragma unroll
            for (int o = 1; o < 32; o <<= 1) ss += __shfl_xor(ss, o);
            const float rinv = __builtin_amdgcn_rsqf(ss * (1.f / 128.f) + EPS);
            const float a0 = x[h][0] * rinv * (h < 2 ? gk[0] : gq[0]), b0 = x[h][1] * rinv * (h < 2 ? gk[1] : gq[1]);
            const float a1 = x[h][2] * rinv * (h < 2 ? gk[2] : gq[2]), b1 = x[h][3] * rinv * (h < 2 ? gk[3] : gq[3]);
            if (dost) { prow[c0 + i32] = (bf16_t)f2bf(a0 * cs0 - b0 * sn0); prow[c0 + 32 + i32] = (bf16_t)f2bf(b0 * cs0 + a0 * sn0);
                        prow[c0 + 64 + i32] = (bf16_t)f2bf(a1 * cs1 - b1 * sn1); prow[c0 + 96 + i32] = (bf16_t)f2bf(b1 * cs1 + a1 * sn1); } }
        if (i32 < 16) { const int q = i32 & 7, d = q >> 2, hh = q & 3;
            const float raw = bf2f(prow[(i32 < 8 ? C_GI : C_GF) + q]);
            if (i32 < 8) F_LI[(size_t)r * 8 + q] = raw + gb[d * 8 + hh];
            else { const float xx = raw + gb[d * 8 + 4 + hh]; F_LF[(size_t)r * 8 + q] = fminf(xx, 0.f) - __logf(1.f + __expf(-fabsf(xx))); } }
    }
    const int nrows = (l == 0) ? MT : ML;
    const long total = (long)nrows * 128, nth = (long)F.G * 512;
    for (long it = (long)F.bx * 512 + F.tid; it < total; it += nth) {
        const int gi = (int)((it >> 6) & 3), c8 = (int)(it & 31) | (gi << 5), r = (int)((it >> 8) << 1) | (int)((it >> 5) & 1);
        const int T = r < ML ? SEQ : CTXL, t = r < ML ? (r & 4095) : ((r - ML) & 255);
        const bf16_t* base = F_P + (size_t)(r - t) * NP + C_PL + c8 * 8;
        float s[8] = {0, 0, 0, 0, 0, 0, 0, 0}; int cnt = 0, nwin = 0;
#define POOLW(HW) { bf16x8 v[2 * HW]; \
            _Pragma("unroll") for (int k = 0; k < 2 * HW; ++k) { const int u = t - HW + k; const bool ok = (u >= 0) && (u < T); const int uc = ok ? u : t; v[k] = *(const bf16x8*)(base + (size_t)uc * NP); cnt += ok ? 1 : 0; } \
            _Pragma("unroll") for (int k = 0; k < 2 * HW; ++k) { \
                _Pragma("unroll") for (int i = 0; i < 8; ++i) s[i] += bfs2f(v[k][i]); } nwin = 2 * HW; }
        if (gi == 0) POOLW(1) else if (gi == 1) POOLW(2) else if (gi == 2) POOLW(4) else POOLW(8)
#undef POOLW
        const bf16x8 self = *(const bf16x8*)(base + (size_t)t * NP); const float rc = __builtin_amdgcn_rcpf((float)cnt); const float ninv = (float)(nwin - cnt);
#pragma unroll
        for (int i = 0; i < 8; ++i) s[i] -= ninv * bfs2f(self[i]);
        u32x4 w; w.x = pk2(s[0] * rc - bfs2f(self[0]), s[1] * rc - bfs2f(self[1])); w.y = pk2(s[2] * rc - bfs2f(self[2]), s[3] * rc - bfs2f(self[3]));
        w.z = pk2(s[4] * rc - bfs2f(self[4]), s[5] * rc - bfs2f(self[5])); w.w = pk2(s[6] * rc - bfs2f(self[6]), s[7] * rc - bfs2f(self[7]));
        *(u32x4*)(F_MIX + (size_t)r * 1024 + c8 * 8) = w;
    }
}

__device__ __forceinline__ void chunk_bs(int cidx, int& b, int& slot) { if (cidx < 128) { b = cidx >> 5; slot = 2 + (cidx & 31); } else { b = (cidx - 128) >> 1; slot = (cidx - 128) & 1; } }
__device__ __forceinline__ int unit_idx(int b, int hh, int d, int slot) { return ((b * 4 + hh) * 2 + d) * NSLOT + slot; }
constexpr int VS = 136;
constexpr int LDS_VT = 0, LDS_KT = 256 * VS * 2, LDS_FS = LDS_KT + 128 * VS * 2, LDS_CH = LDS_FS + 5120;

__device__ __forceinline__ void stage_vt(Fr& F, bf16_t* VT, size_t R0, int hh) {
    for (int idx = F.tid; idx < 1024; idx += 512) { const int l4 = idx & 31, c8 = idx >> 5;
        const bf16_t* src = F_P + (R0 + 4 * l4) * NP + C_MV + hh * 256 + c8 * 8;
        const bf16x8 r0 = *(const bf16x8*)(src), r1 = *(const bf16x8*)(src + NP), r2 = *(const bf16x8*)(src + 2 * NP), r3 = *(const bf16x8*)(src + 3 * NP);
#pragma unroll
        for (int i = 0; i < 8; ++i) { u32x2 w; w.x = (unsigned)(unsigned short)r0[i] | ((unsigned)(unsigned short)r1[i] << 16); w.y = (unsigned)(unsigned short)r2[i] | ((unsigned)(unsigned short)r3[i] << 16);
            *(u32x2*)(VT + (c8 * 8 + i) * VS + 4 * l4) = w; } }
}
__device__ __forceinline__ void mls_cloc_unit(Fr& F, int cidx, int hh, int d, int l) {
    bf16_t* VT = (bf16_t*)(F.lds + LDS_VT); bf16_t* KT = (bf16_t*)(F.lds + LDS_KT); float* fs = (float*)(F.lds + LDS_FS);
    const int tid = F.tid, lane = F.lane, w = F.wave, fr = lane & 15, fq = lane >> 4;
    const size_t R0 = (size_t)cidx * 128; int b, slot; chunk_bs(cidx, b, slot); const int uidx = unit_idx(b, hh, d, slot);
    if (tid < 128) { const float* gb = F.ap->in[I_GATEB] + l * 16; const bf16_t* prow = F_P + (R0 + tid) * NP;
        const float xx = bf2f(prow[C_GF + d * 4 + hh]) + gb[d * 8 + 4 + hh];
        fs[tid] = fminf(xx, 0.f) - __logf(1.f + __expf(-fabsf(xx))); fs[128 + tid] = bf2f(prow[C_GI + d * 4 + hh]) + gb[d * 8 + hh]; }
    __syncthreads();
    float wend = 0.f, gtot = 0.f;
    {
        float lfv = tid < 128 ? fs[tid] : 0.f, p = lfv;
#pragma unroll
        for (int o = 1; o < 64; o <<= 1) { const float t = __shfl_up(p, o); if (lane >= o) p += t; }
        if (tid < 128 && lane == 63) fs[512 + w] = p;
        __syncthreads();
        const float tot0 = fs[512], tot1 = fs[513]; gtot = tot0 + tot1;
        const float bf_ = p + (w == 1 ? tot0 : 0.f);
        const float bsum = d == 0 ? bf_ : gtot - bf_ + lfv;
        wend = tid < 128 ? gtot - bsum + fs[128 + tid] : -3.0e38f;
        float mx = wend;
#pragma unroll
        for (int o = 1; o < 64; o <<= 1) mx = fmaxf(mx, __shfl_xor(mx, o));
        if (tid < 128 && lane == 0) fs[514 + w] = mx;
        __syncthreads();
        const float m = fmaxf(fs[514], fs[515]);
        if (tid < 128) { fs[384 + tid] = __expf(wend - m) * QK_SCALE;
            if (tid == 0) { F_GT[uidx] = gtot; F_MLOC[uidx] = m; } }
    }
    stage_vt(F, VT, R0, hh);
    __syncthreads();
    { const int l4 = tid & 31, c8 = tid >> 5;
        const bf16_t* src = F_P + (R0 + 4 * l4) * NP + C_MK + hh * 128 + c8 * 8;
        const bf16x8 r0 = *(const bf16x8*)(src), r1 = *(const bf16x8*)(src + NP), r2 = *(const bf16x8*)(src + 2 * NP), r3 = *(const bf16x8*)(src + 3 * NP);
        const float e0 = fs[384 + 4 * l4], e1 = fs[385 + 4 * l4], e2 = fs[386 + 4 * l4], e3 = fs[387 + 4 * l4];
#pragma unroll
        for (int i = 0; i < 8; ++i) { u32x2 w; w.x = pk2(bfs2f(r0[i]) * e0, bfs2f(r1[i]) * e1); w.y = pk2(bfs2f(r2[i]) * e2, bfs2f(r3[i]) * e3);
            *(u32x2*)(KT + (c8 * 8 + i) * VS + 4 * l4) = w; } }
    __syncthreads();
    f32x4 acc[2][8];
#pragma unroll
    for (int vi = 0; vi < 2; ++vi)
#pragma unroll
        for (int kb = 0; kb < 8; ++kb) acc[vi][kb] = (f32x4){0.f, 0.f, 0.f, 0.f};
#pragma unroll
    for (int lb = 0; lb < 4; ++lb) {
        bf16x8 xf[2];
#pragma unroll
        for (int vi = 0; vi < 2; ++vi) xf[vi] = *(const bf16x8*)(VT + (32 * w + 16 * vi + fr) * VS + lb * 32 + 8 * fq);
#pragma unroll
        for (int kb = 0; kb < 8; ++kb) { const bf16x8 yf = *(const bf16x8*)(KT + (16 * kb + fr) * VS + lb * 32 + 8 * fq);
#pragma unroll
            for (int vi = 0; vi < 2; ++vi) acc[vi][kb] = __builtin_amdgcn_mfma_f32_16x16x32_bf16(yf, xf[vi], acc[vi][kb], 0, 0, 0); }
    }
    bf16_t* Cst = F_CST + (size_t)uidx * 32768;
    __syncthreads();
#pragma unroll
    for (int vi = 0; vi < 2; ++vi)
#pragma unroll
        for (int kb = 0; kb < 8; ++kb)
        { u32x2 pk; pk.x = pk2(acc[vi][kb][0], acc[vi][kb][1]); pk.y = pk2(acc[vi][kb][2], acc[vi][kb][3]); *(u32x2*)(VT + (32 * w + 16 * vi + fr) * VS + 16 * kb + 4 * fq) = pk; }
    __syncthreads();
#pragma unroll
    for (int i = 0; i < 8; ++i) { const int idx = tid + 512 * i; *(u32x4*)(Cst + (idx >> 4) * 128 + (idx & 15) * 8) = *(const u32x4*)(VT + (idx >> 4) * VS + (idx & 15) * 8); }
    { const int k = tid >> 2, part = tid & 3; float sacc = 0.f;
#pragma unroll
        for (int q = 0; q < 4; ++q) { const bf16x8 t8 = *(const bf16x8*)(KT + k * VS + part * 32 + q * 8);
#pragma unroll
            for (int i = 0; i < 8; ++i) sacc += bfs2f(t8[i]); }
        sacc += __shfl_xor(sacc, 1); sacc += __shfl_xor(sacc, 2);
        if (part == 0) F_NST[(size_t)uidx * 128 + k] = sacc; }
    __syncthreads();
}
__device__ __forceinline__ int scan_slot(int d, int step) { return d == 0 ? step : (step == 0 ? 1 : (step == 1 ? 0 : 35 - step)); }
__device__ __forceinline__ void phase_scan(Fr& F, const bool dost = true) {
    const long nth = (long)F.G * 512;
    for (long gid = (long)F.bx * 512 + F.tid; gid < 32 * 4096; gid += nth) {
        const int seq = (int)(gid >> 12), vec = (int)(gid & 4095), d = seq & 1;
        bf16_t* base = F_CST + (size_t)seq * NSLOT * 32768 + vec * 8;
        float* nbase = F_NST + (size_t)seq * NSLOT * 128 + (vec & 15) * 8;
        const bool hasn = vec < 16;
        float z0 = 0.f; asm volatile("" : "+v"(z0));
        float st[8] = {z0, z0, z0, z0, z0, z0, z0, z0}, sn[8] = {z0, z0, z0, z0, z0, z0, z0, z0}; float m = 0.f;
        int slot = scan_slot(d, 0), slot1 = scan_slot(d, 1);
        bf16x8 cl = *(const bf16x8*)(base + (size_t)slot * 32768), cl1 = *(const bf16x8*)(base + (size_t)slot1 * 32768);
        f32x4 n0 = {0.f, 0.f, 0.f, 0.f}, n1 = {0.f, 0.f, 0.f, 0.f}, p0 = n0, p1 = n0;
        if (hasn) { n0 = *(const f32x4*)(nbase + slot * 128); n1 = *(const f32x4*)(nbase + slot * 128 + 4); p0 = *(const f32x4*)(nbase + slot1 * 128); p1 = *(const f32x4*)(nbase + slot1 * 128 + 4); }
        float g = F_GT[seq * NSLOT + slot], mc = F_MLOC[seq * NSLOT + slot], g1 = F_GT[seq * NSLOT + slot1], mc1 = F_MLOC[seq * NSLOT + slot1];
#pragma unroll 1
        for (int step = 0; step < NSLOT; ++step) {
            const int slot2 = scan_slot(d, step + 2 < NSLOT ? step + 2 : NSLOT - 1);
            const bool ld2 = step + 2 < NSLOT;
            bf16x8 cl2 = cl1; f32x4 q0 = p0, q1 = p1; float g2 = g1, mc2 = mc1;
            if (ld2) { cl2 = *(const bf16x8*)(base + (size_t)slot2 * 32768);
                if (hasn) { q0 = *(const f32x4*)(nbase + slot2 * 128); q1 = *(const f32x4*)(nbase + slot2 * 128 + 4); }
                g2 = F_GT[seq * NSLOT + slot2]; mc2 = F_MLOC[seq * NSLOT + slot2]; }
            asm volatile("" ::: "memory");
            if (dost) { u32x4 o; o.x = pk2(st[0], st[1]); o.y = pk2(st[2], st[3]); o.z = pk2(st[4], st[5]); o.w = pk2(st[6], st[7]);
                *(u32x4*)(base + (size_t)slot * 32768) = o;
                if (hasn) { *(f32x4*)(nbase + slot * 128) = (f32x4){sn[0], sn[1], sn[2], sn[3]}; *(f32x4*)(nbase + slot * 128 + 4) = (f32x4){sn[4], sn[5], sn[6], sn[7]}; } }
            if (vec == 0) F_MIN[seq * NSLOT + slot] = m;
            const float mn = fmaxf(g + m, mc), a = __expf(g + m - mn), s = __expf(mc - mn);
#pragma unroll
            for (int i = 0; i < 8; ++i) st[i] = a * st[i] + s * bfs2f(cl[i]);
#pragma unroll
            for (int i = 0; i < 4; ++i) { sn[i] = a * sn[i] + s * n0[i]; sn[4 + i] = a * sn[4 + i] + s * n1[i]; }
            m = mn; cl = cl1; n0 = p0; n1 = p1; g = g1; mc = mc1; slot = slot1;
            cl1 = cl2; p0 = q0; p1 = q1; g1 = g2; mc1 = mc2; slot1 = slot2; }
    }
}
__device__ __forceinline__ void mls_out_unit(Fr& F, int cidx, int hh, int l, const bool dost = true) {
    bf16_t* VT = (bf16_t*)(F.lds + LDS_VT); bf16_t* Kc = (bf16_t*)(F.lds + LDS_KT); float* fs = (float*)(F.lds + LDS_FS);
    float* lf_s = fs; float* li_s = fs + 256; float* csrc = fs + 512; float* mm = fs + 768; float* bj = fs + 1024;
    bf16_t* Ch = (bf16_t*)(F.lds + LDS_CH);
    const int tid = F.tid, lane = F.lane, w = F.wave, fr = lane & 15, fq = lane >> 4;
    const size_t R0 = (size_t)cidx * 128; int b, slot; chunk_bs(cidx, b, slot);
    if (tid < 256) { const int dd = tid >> 7, t = tid & 127; lf_s[tid] = F_LF[(R0 + t) * 8 + dd * 4 + hh]; li_s[tid] = F_LI[(R0 + t) * 8 + dd * 4 + hh]; }
    stage_vt(F, VT, R0, hh);
    for (int idx = tid; idx < 2048; idx += 512) { const int l2 = idx >> 4, c8 = idx & 15;
        *(bf16x8*)(Kc + l2 * VS + c8 * 8) = *(const bf16x8*)(F_P + (R0 + l2) * NP + C_MK + hh * 128 + c8 * 8); }
    __syncthreads();
    {
        float* tmp = (float*)(F.lds + LDS_CH);
        const bool act = tid < 256; const int dd = (tid >> 7) & 1, wp = w & 1;
        const float lfv = act ? lf_s[tid] : 0.f; float p = lfv;
#pragma unroll
        for (int o = 1; o < 64; o <<= 1) { const float t = __shfl_up(p, o); if (lane >= o) p += t; }
        if (act && lane == 63) tmp[w] = p;
        __syncthreads();
        const float t0 = tmp[2 * dd], t1 = tmp[2 * dd + 1], gt_ = t0 + t1;
        const float bfwd = p + (wp ? t0 : 0.f);
        const float bsum = dd == 0 ? bfwd : gt_ - bfwd + lfv;
        const float cs = act ? li_s[tid] - bsum : -3.0e38f;
        float pmx = cs, smx = cs;
#pragma unroll
        for (int o = 1; o < 64; o <<= 1) { const float a = __shfl_up(pmx, o), c = __shfl_down(smx, o); if (lane >= o) pmx = fmaxf(pmx, a); if (lane + o < 64) smx = fmaxf(smx, c); }
        if (act && lane == 63) tmp[4 + w] = pmx;
        __syncthreads();
        if (act) { const float other = tmp[4 + (w ^ 1)];
            float cm = dd == 0 ? (wp ? fmaxf(pmx, other) : pmx) : (wp ? smx : fmaxf(smx, other));
            cm = fmaxf(cm, F_MIN[unit_idx(b, hh, dd, slot)]);
            bj[tid] = bsum; csrc[tid] = cs; mm[tid] = cm; }
    }
    __syncthreads();
    const int j = 16 * w + fr;
    const bf16_t* prow = F_P + (R0 + j) * NP;
    f32x4 acc[16];
#pragma unroll
    for (int vb = 0; vb < 16; ++vb) acc[vb] = (f32x4){0.f, 0.f, 0.f, 0.f};
#pragma unroll 1
    for (int dd = 0; dd < 2; ++dd) {
        int jj = j; asm volatile("" : "+v"(jj));
        bf16x8 Yq[4];
#pragma unroll
        for (int kb = 0; kb < 4; ++kb) Yq[kb] = *(const bf16x8*)(F_P + (R0 + jj) * NP + C_MQ + hh * 128 + kb * 32 + 8 * fq);
        const int sgn = dd == 0 ? 1 : -1; const int bs = (4 * fq - jj) * sgn;
        const int uidx = unit_idx(b, hh, dd, slot);
        const bf16_t* Cin = F_CST + (size_t)uidx * 32768;
        const float m_in = F_MIN[uidx], mmj = mm[dd * 128 + j], bjj = bj[dd * 128 + j];
        f32x4 Sa[8];
#pragma unroll
        for (int sb = 0; sb < 8; ++sb) { Sa[sb] = (f32x4){0.f, 0.f, 0.f, 0.f};
#pragma unroll
            for (int kb = 0; kb < 4; ++kb) { const bf16x8 kf = *(const bf16x8*)(Kc + (16 * sb + fr) * VS + kb * 32 + 8 * fq);
                Sa[sb] = __builtin_amdgcn_mfma_f32_16x16x32_bf16(kf, Yq[kb], Sa[sb], 0, 0, 0); }
            __builtin_amdgcn_sched_barrier(0); }
        float dsum = 0.f;
#pragma unroll
        for (int sb = 0; sb < 8; ++sb)
#pragma unroll
            for (int e = 0; e < 4; ++e) { const int s = 16 * sb + 4 * fq + e; const bool valid = (bs + sgn * (16 * sb + e)) <= 0;
                const float wv = valid ? __expf(csrc[dd * 128 + s] - mmj) * Sa[sb][e] * QK_SCALE : 0.f; Sa[sb][e] = wv; dsum += wv; }
        dsum += __shfl_xor(dsum, 16); dsum += __shfl_xor(dsum, 32);
        float nq = 0.f; const float* nst = F_NST + (size_t)uidx * 128;
#pragma unroll
        for (int kb = 0; kb < 4; ++kb) { const f32x4 n0 = *(const f32x4*)(nst + kb * 32 + 8 * fq), n1 = *(const f32x4*)(nst + kb * 32 + 8 * fq + 4);
            nq += bfs2f(Yq[kb][0]) * n0[0] + bfs2f(Yq[kb][1]) * n0[1] + bfs2f(Yq[kb][2]) * n0[2] + bfs2f(Yq[kb][3]) * n0[3]
                + bfs2f(Yq[kb][4]) * n1[0] + bfs2f(Yq[kb][5]) * n1[1] + bfs2f(Yq[kb][6]) * n1[2] + bfs2f(Yq[kb][7]) * n1[3]; }
        nq += __shfl_xor(nq, 16); nq += __shfl_xor(nq, 32);
        const float inter = __expf(m_in - mmj);
        const float den = dsum + inter * nq;
        const float rden = 1.f / fmaxf(fabsf(den), __expf(-(bjj + mmj)));
        bf16x8 Wf[4], Yqs[4]; const float qsc = inter * rden;
#pragma unroll
        for (int kb = 0; kb < 4; ++kb) {
            u32x4 t; t.x = pk2(Sa[2 * kb][0] * rden, Sa[2 * kb][1] * rden); t.y = pk2(Sa[2 * kb][2] * rden, Sa[2 * kb][3] * rden);
            t.z = pk2(Sa[2 * kb + 1][0] * rden, Sa[2 * kb + 1][1] * rden); t.w = pk2(Sa[2 * kb + 1][2] * rden, Sa[2 * kb + 1][3] * rden);
            Wf[kb] = *reinterpret_cast<bf16x8*>(&t);
            u32x4 q; q.x = pk2(bfs2f(Yq[kb][0]) * qsc, bfs2f(Yq[kb][1]) * qsc); q.y = pk2(bfs2f(Yq[kb][2]) * qsc, bfs2f(Yq[kb][3]) * qsc);
            q.z = pk2(bfs2f(Yq[kb][4]) * qsc, bfs2f(Yq[kb][5]) * qsc); q.w = pk2(bfs2f(Yq[kb][6]) * qsc, bfs2f(Yq[kb][7]) * qsc);
            Yqs[kb] = *reinterpret_cast<bf16x8*>(&q); }
        bf16x8 pr[4];
#pragma unroll
        for (int i = 0; i < 4; ++i) { const int idx = tid + 512 * i; pr[i] = *(const bf16x8*)(Cin + (idx >> 4) * 128 + (idx & 15) * 8); }
#pragma unroll
        for (int h = 0; h < 2; ++h) {
            __syncthreads();
#pragma unroll
            for (int i = 0; i < 4; ++i) { const int idx = tid + 512 * i; *(bf16x8*)(Ch + (idx >> 4) * VS + (idx & 15) * 8) = pr[i]; }
            if (h == 0) {
#pragma unroll
                for (int i = 0; i < 4; ++i) { const int idx = tid + 512 * i; pr[i] = *(const bf16x8*)(Cin + (128 + (idx >> 4)) * 128 + (idx & 15) * 8); } }
            __syncthreads();
#pragma unroll
            for (int v8 = 0; v8 < 8; ++v8) { const int vb = 8 * h + v8;
#pragma unroll
                for (int kb = 0; kb < 4; ++kb) { const bf16x8 cf = *(const bf16x8*)(Ch + (16 * v8 + fr) * VS + kb * 32 + 8 * fq);
                    acc[vb] = __builtin_amdgcn_mfma_f32_16x16x32_bf16(cf, Yqs[kb], acc[vb], 0, 0, 0); }
#pragma unroll
                for (int kb = 0; kb < 4; ++kb) {
                    const u32x2 lo = *(const u32x2*)(VT + (16 * vb + fr) * VS + 32 * kb + 4 * fq), hi2 = *(const u32x2*)(VT + (16 * vb + fr) * VS + 32 * kb + 16 + 4 * fq);
                    u32x4 t; t.x = lo.x; t.y = lo.y; t.z = hi2.x; t.w = hi2.y;
                    acc[vb] = __builtin_amdgcn_mfma_f32_16x16x32_bf16(*reinterpret_cast<bf16x8*>(&t), Wf[kb], acc[vb], 0, 0, 0); }
                __builtin_amdgcn_sched_barrier(0);
            }
        }
    }
    float ss = 0.f;
#pragma unroll
    for (int vb = 0; vb < 16; ++vb) ss += (acc[vb][0] * acc[vb][0] + acc[vb][1] * acc[vb][1]) + (acc[vb][2] * acc[vb][2] + acc[vb][3] * acc[vb][3]);
    ss += __shfl_xor(ss, 16); ss += __shfl_xor(ss, 32);
    const float rinv = 1.f / sqrtf(ss * (1.f / 256.f) + EPS);
    const float* hg = F.ap->in[I_MLHG] + l * 1024 + hh * 256;
    bf16_t* orow = F_P + (R0 + j) * NP + C_O + hh * 256;
#pragma unroll
    for (int vb = 0; vb < 16; ++vb) { const int v0 = 16 * vb + 4 * fq;
        const u32x2 oraw = *(const u32x2*)(orow + v0); const f32x4 g4 = *(const f32x4*)(hg + v0);
        const float o0 = __uint_as_float(oraw.x << 16), o1 = __uint_as_float(oraw.x & 0xffff0000u), o2 = __uint_as_float(oraw.y << 16), o3 = __uint_as_float(oraw.y & 0xffff0000u);
        u32x2 wv; wv.x = pk2(acc[vb][0] * rinv * g4[0] * sigmoidf_(o0), acc[vb][1] * rinv * g4[1] * sigmoidf_(o1));
        wv.y = pk2(acc[vb][2] * rinv * g4[2] * sigmoidf_(o2), acc[vb][3] * rinv * g4[3] * sigmoidf_(o3));
        if (dost) *(u32x2*)(orow + v0) = wv; }
    __syncthreads();
}

#ifndef PHM
#define PHM 0xFFFF
#endif
#ifndef DUPM
#define DUPM 0
#endif
#define DOST (rep_ == ((DUPM >> RB_) & 1))
#define REP(bit) for (int rep_ = 0, RB_ = (bit); rep_ < ((DUPM >> (bit)) & 1) + 1; ++rep_)
#define GSYNC() do { ArgsP sa_ = (ArgsP)__builtin_amdgcn_kernarg_segment_ptr(); asm volatile("" : "+s"(sa_)); \
    XcdBarrier xb_; xb_.bar = (unsigned*)sa_->ws; xb_.x = xb_xcc_id(); xb_.st = misc; xcd_barrier(xb_); if (DUPM & 0x8000) xcd_barrier(xb_); } while (0)
__global__ void __launch_bounds__(512, 2) fwd_megakernel(Args args) {
    extern __shared__ __attribute__((aligned(16))) unsigned char lds_raw[];
    cg::grid_group grid = cg::this_grid();
    Fr F;
    F.lds = (char*)lds_raw; F.tid = threadIdx.x; F.lane = F.tid & 63; F.wave = __builtin_amdgcn_readfirstlane(F.tid >> 6);
    F.G = gridDim.x; F.bx = blockIdx.x; { const int bx = blockIdx.x; F.vcu = (F.G % 8 == 0) ? (bx % 8) * (F.G / 8) + bx / 8 : bx; }
    F.gw = F.bx * 8 + F.wave; F.NGW = F.G * 8;
    F.ap = (ArgsP)__builtin_amdgcn_kernarg_segment_ptr();
    LAS unsigned char* lds3 = (LAS unsigned char*)lds_raw;
#define PHB() do { int t_ = threadIdx.x; asm volatile("" : "+v"(t_)); F.tid = t_; F.lane = t_ & 63; F.wave = __builtin_amdgcn_readfirstlane(t_ >> 6); \
    ArgsP a_ = (ArgsP)__builtin_amdgcn_kernarg_segment_ptr(); asm volatile("" : "+s"(a_)); F.ap = a_; \
    unsigned lo_ = 0u; asm volatile("" : "+s"(lo_)); F.lds3 = lds3 + lo_; F.lds = (char*)F.lds3; \
    int bx_ = blockIdx.x, g_ = gridDim.x; asm volatile("" : "+s"(bx_), "+s"(g_)); F.bx = bx_; F.G = g_; F.vcu = (g_ % 8 == 0) ? (bx_ % 8) * (g_ / 8) + bx_ / 8 : bx_; F.gw = bx_ * 8 + F.wave; F.NGW = g_ * 8; } while (0)

#if PHM & (1<<0)
    volatile LAS unsigned* misc = (volatile LAS unsigned*)(lds3 + LDS_BYTES - 256);
    if (threadIdx.x < 2) misc[threadIdx.x] = 0u;
    if (blockIdx.x == 0) { unsigned* bw = (unsigned*)WSB; for (int i = threadIdx.x; i < XCD_BAR_WORDS; i += 512) __hip_atomic_store(bw + i, 0u, __ATOMIC_RELAXED, __HIP_MEMORY_SCOPE_AGENT); }
    __syncthreads();
    REP(0) { PHB();
    mod_gemv(F);
    convert_weights(F, 0); }
#endif
    __threadfence(); grid.sync();
    (void)xcd_barrier_post((unsigned*)WSB, misc);
#if PHM & (1<<1)
    REP(1) { PHB();
    phase_norm1(F, 0, F.ap->in[I_X], F.ap->in[I_CTX]); }
#endif
    GSYNC();

    for (int l = 0; l < 2; ++l) {
        const bool last = (l == 1);
        const int nMall = last ? 64 : 68;
#if PHM & (1<<2)
        PHB();
        REP(2)
        { PHB(); pg8::Gemm g{F_H, F_H, F_H, (const bf16_t*)(WSB + WS_WIN), (const bf16_t*)(WSB + WS_WIN), (const bf16_t*)(WSB + WS_WIN), D, D, 0};
          pg8::Sched S; if (!last) S.init(68, 47, 1, F.G, F.bx); else S.init(64, 47, 1, F.G, F.bx, 64, 4, 9);
          pg8::EpiWin E{F_P, (unsigned char*)(WSB + WS_G8)};
          pg8::gemm_phase<pg8::EpiWin>(F.lds3, g, S, E, F.tid); }
#endif
        GSYNC();
#if PHM & (1<<3)
        REP(3) { PHB();
        phase_prep(F, l, DOST); }
#endif
        __syncthreads();
#if PHM & (1<<5)
        REP(5) { PHB();
        for (int u = F.G - 1 - F.vcu; u < 136 * 8; u += F.G) { const int cidx = u >> 3, hh = (u >> 1) & 3, d = u & 1; mls_cloc_unit(F, cidx, hh, d, l); } }
#endif
        GSYNC();
#if PHM & (1<<4)
        REP(4)
        { PHB(); const bf16_t* wp = (const bf16_t*)(WSB + WS_WPL);
          pg8::Gemm g{F_MIX, F_MIX, F_MIX, wp, wp, wp, 1024, 256, 512};
          pg8::Sched S; S.init(nMall, 4, 1, F.G, F.G - 1 - F.bx);
          pg8::EpiBf16 E{F_P + C_PL, NP};
          pg8::gemm_phase<pg8::EpiBf16>(F.lds3, g, S, E, F.tid); }
#endif
        __syncthreads();
#if PHM & (1<<6)
        REP(6) { PHB();
        phase_scan(F, DOST); }
#endif
        GSYNC();
        { const int nchunk = last ? 128 : 136;
#if PHM & (1<<7)
          REP(7) { PHB();
          for (int u = F.bx; u < nchunk * 4; u += F.G) mls_out_unit(F, u >> 2, u & 3, l, DOST); }
#endif
#if PHM & (1<<8)
          REP(8) { PHB();
          const int nun = last ? 512 : 544;
          for (int u = F.vcu; u < nun; u += F.G) {
              if (u < 512) { const int qb = u & 15, hq = (u >> 4) & 3, kvh = (u >> 6) & 1, b = u >> 7, h = kvh * 4 + hq;
                  const size_t rq = (size_t)b * SEQ + qb * 256, rk = (size_t)b * SEQ, rc = (size_t)ML + b * CTXL;
                  att::attn_dense_body(F_P + rq * NP + C_AQ + h * 128, F_P + rk * NP + C_AK + kvh * 128,
                                       F_P + rc * NP + C_AK + kvh * 128, 64, F_P + rq * NP + C_AQ + h * 128, 68, F.lds, F.tid, DOST);
              } else { const int v = u - 512, b = v >> 3, h = v & 7, kvh = h >> 2; const size_t rc = (size_t)ML + b * CTXL;
                  att::attn_dense_body(F_P + rc * NP + C_AQ + h * 128, F_P + rc * NP + C_AK + kvh * 128,
                                       F_P + rc * NP + C_AK + kvh * 128, 4, F_P + rc * NP + C_AQ + h * 128, 4, F.lds, F.tid, DOST); }
          } }
#endif
        }
        GSYNC();
#if PHM & (1<<9)
        PHB();
        REP(9)
        { PHB(); const bf16_t* wu = (const bf16_t*)(WSB + WS_WUP);
          pg8::Gemm g{F_P + C_AQ, F_P + C_O, F_P + C_PL, wu, wu + (size_t)D * 1024, wu + (size_t)2 * D * 1024, NP, 1024, 0};
          pg8::Sched S; S.init(nMall, 8, 3, F.G, F.bx);
          pg8::EpiGate E{(const unsigned char*)(WSB + WS_G8), F_H};
          pg8::gemm_phase<pg8::EpiGate>(F.lds3, g, S, E, F.tid); }
#endif
        GSYNC();
#if PHM & (1<<10)
        PHB();
        REP(10)
        { PHB(); const bf16_t* wo = (const bf16_t*)(WSB + WS_WOUT);
          pg8::Gemm g{F_H, F_H, F_H, wo, wo, wo, D, D, 0};
          pg8::Sched S; S.init(nMall, 8, 1, F.G, F.bx);
          pg8::EpiBf16 E{(bf16_t*)(WSB + WS_YO), D};
          pg8::gemm_phase<pg8::EpiBf16>(F.lds3, g, S, E, F.tid); }
#endif
        GSYNC();
#if PHM & (1<<11)
        REP(11) { PHB();
        phase_resid(F, l, 0, nMall * 256, F.ap->in[I_X], l == 0 ? F.ap->in[I_CTX] : F_XC, false, l != 0, true, DOST); }
#endif
        GSYNC();
#if PHM & (1<<12)
        PHB();
        REP(12)
        { PHB(); const bf16_t* wf = (const bf16_t*)(WSB + WS_WFI);
          pg8::Gemm g{F_H, F_H, F_H, wf, wf, wf, D, D, 0};
          pg8::Sched S; S.init(nMall, 44, 1, F.G, F.bx);
          pg8::EpiSwiglu E{(bf16_t*)(WSB + WS_HID)};
          pg8::gemm_phase<pg8::EpiSwiglu>(F.lds3, g, S, E, F.tid); }
#endif
        GSYNC();
#if PHM & (1<<13)
        PHB();
        REP(13)
        { PHB(); const bf16_t* wf = (const bf16_t*)(WSB + WS_WFO); const bf16_t* hid = (const bf16_t*)(WSB + WS_HID);
          pg8::Gemm g{hid, hid, hid, wf, wf, wf, DFF, DFF, 0};
          pg8::Sched S; S.init(nMall, 8, 1, F.G, F.bx);
          pg8::EpiBf16 E{(bf16_t*)(WSB + WS_YO), D};
          pg8::gemm_phase<pg8::EpiBf16>(F.lds3, g, S, E, F.tid); }
#endif
        GSYNC();
#if PHM & (1<<14)
        REP(14) { PHB();
        phase_resid(F, l, 1, nMall * 256, F.ap->in[I_X], F_XC, !last, true, !last, DOST);
        if (!last) { __syncthreads(); convert_weights(F, 1); } }
#endif
        GSYNC();
    }
}

extern "C" void kernel_launch(void* const* d_in, const int* in_sizes, int n_in, void* d_out, int out_size, void* d_ws, size_t ws_size, hipStream_t stream) {
    static int grid = 0;
    if (grid == 0) {
        if (n_in != 19 || out_size != ML * D || ws_size < WS_END) { fprintf(stderr, "kernel_launch: unexpected shapes n_in %d out %d ws %zu (need %zu)\n", n_in, out_size, ws_size, (size_t)WS_END); grid = -1; return; }
        int dev = 0, cus = 0, per_cu = 0;
        hipGetDevice(&dev); hipDeviceGetAttribute(&cus, hipDeviceAttributeMultiprocessorCount, dev);
        if (hipFuncSetAttribute((const void*)fwd_megakernel, hipFuncAttributeMaxDynamicSharedMemorySize, LDS_BYTES) != hipSuccess) { fprintf(stderr, "kernel_launch: hipFuncSetAttribute failed\n"); grid = -1; return; }
        if (hipOccupancyMaxActiveBlocksPerMultiprocessor(&per_cu, (const void*)fwd_megakernel, 512, LDS_BYTES) != hipSuccess || per_cu < 1) { fprintf(stderr, "kernel_launch: occupancy query gave %d\n", per_cu); per_cu = 1; }
        (void)hipGetLastError();
        grid = cus * 1;
        fprintf(stderr, "kernel_launch: cus %d per_cu %d grid %d\n", cus, per_cu, grid);
    }
    if (grid < 0) return;
    Args a{};
    for (int i = 0; i < 19; ++i) a.in[i] = (const float*)d_in[i];
    a.out = (float*)d_out; a.ws = (unsigned char*)d_ws;
    void* kargs[] = {&a};
    hipError_t e = hipLaunchCooperativeKernel((const void*)fwd_megakernel, dim3(grid), dim3(512), kargs, LDS_BYTES, stream);
    if (e != hipSuccess) fprintf(stderr, "cooperative launch failed: %s (grid %d)\n", hipGetErrorString(e), grid);
}
```

```cpp
#include <hip/hip_runtime.h>
#include <hip/hip_cooperative_groups.h>
#include <cstdio>
#include <cstdint>
namespace cg = cooperative_groups;

#define LAS __attribute__((address_space(3)))
typedef unsigned short bf16_t;
typedef short bf16x8 __attribute__((ext_vector_type(8)));
typedef short s16x4 __attribute__((ext_vector_type(4)));
typedef float f32x4 __attribute__((ext_vector_type(4)));
typedef float f32x16 __attribute__((ext_vector_type(16)));
typedef unsigned u32x4 __attribute__((ext_vector_type(4)));
typedef unsigned u32x2 __attribute__((ext_vector_type(2)));

constexpr int D = 2048, NB = 4, SEQ = 4096, CTXL = 256;
constexpr int ML = NB * SEQ, MC = NB * CTXL, MT = ML + MC;
constexpr int DIN = 11792, NP = 5888, NWIN = 12032, NG = 6144, DFF = 5632;
constexpr int C_AK = 0, C_AV = 256, C_MK = 512, C_MV = 1024, C_GI = 2048, C_GF = 2056, C_AQ = 2064, C_MQ = 3088, C_O = 3600, C_PL = 4624, C_GRAW = 5648;
constexpr float EPS = 1e-6f;
constexpr int NSLOT = 34, NUNIT = NB * 4 * 2 * NSLOT;
constexpr float QK_SCALE = 0.08838834764831845f;

constexpr size_t MiB = 1u << 20;
constexpr size_t WS_MOD = 1 * MiB;
constexpr size_t WS_LI = 2 * MiB;
constexpr size_t WS_LF = 3 * MiB;
constexpr size_t WS_GT = 4 * MiB;
constexpr size_t WS_NST = 5 * MiB;
constexpr size_t WS_WIN = 6 * MiB;
constexpr size_t WS_WFI = 54 * MiB;
constexpr size_t WS_WFO = 98 * MiB;
constexpr size_t WS_WUP = 120 * MiB;
constexpr size_t WS_WOUT = 132 * MiB;
constexpr size_t WS_WPL = 140 * MiB;
constexpr size_t WS_XC = 141 * MiB;
constexpr size_t WS_H = 149 * MiB;
constexpr size_t WS_P = 217 * MiB;
constexpr size_t WS_MIX = 617 * MiB;
constexpr size_t WS_CST = 651 * MiB;
constexpr size_t WS_XB = 719 * MiB;
constexpr size_t WS_END = 783 * MiB;
constexpr size_t WS_YO = WS_P;
constexpr size_t WS_G8 = WS_P + 196 * MiB;
constexpr size_t WS_HID = WS_P + 160 * MiB;

constexpr int LDS_BYTES = 147456;

__device__ __forceinline__ float bf2f(bf16_t v) { return __uint_as_float((unsigned)v << 16); }
__device__ __forceinline__ float bfs2f(short v) { return __uint_as_float(((unsigned)(unsigned short)v) << 16); }
typedef float f32x2_t __attribute__((ext_vector_type(2))); typedef __bf16 bf16x2_t __attribute__((ext_vector_type(2)));
__device__ __forceinline__ unsigned pk2(float lo, float hi) { const f32x2_t v = {lo, hi}; const bf16x2_t b = __builtin_convertvector(v, bf16x2_t); return __builtin_bit_cast(unsigned, b); }
__device__ __forceinline__ unsigned f2bf(float f) { return pk2(f, 0.f) & 0xffffu; }
__device__ __forceinline__ float wave_sum(float v) {
#pragma unroll
    for (int o = 1; o < 64; o <<= 1) v += __shfl_xor(v, o);
    return v;
}
__device__ __forceinline__ float sigmoidf_(float x) { return __builtin_amdgcn_rcpf(1.f + __expf(-x)); }

struct Args { const float* in[19]; float* out; unsigned char* ws; };
enum { I_X = 0, I_C, I_CTX, I_CCTX, I_WMOD, I_BMOD, I_NORMG, I_WIN, I_GATEB, I_QKG, I_MLHG, I_POOLW, I_POOLS, I_UPA, I_UPM, I_UPP, I_WOUT, I_FFI, I_FFO };

namespace pg8 {
constexpr int BM = 256, BK = 64, HALF = 128, HTB = HALF * BK * 2, STAGE_BYTES = 8 * HTB, NXCD = 8, WGM = 8;
__host__ __device__ __forceinline__ int lds_byte(int r, int c) { const int st = (r >> 4) * 2 + (c >> 5), rr = r & 15, cc = c & 31, ob = rr * 64 + cc * 2; return st * 1024 + (ob ^ (((ob >> 9) & 1) << 5)); }
__host__ __device__ __forceinline__ void stage_rc(int b, int& R, int& C) { const int st = b / 1024, sb = b % 1024, swz = sb ^ (((sb >> 9) & 1) << 5); R = (st >> 1) * 16 + swz / 64; C = (st & 1) * 32 + (swz % 64) / 2; }
__host__ __device__ __forceinline__ int perm32(int rho) { const int n = rho >> 4, i = rho & 15; return 8 * (i >> 2) + 4 * n + (i & 3); }

struct Unit { int pm, pn, br; };
struct Gemm { const bf16_t* A0; const bf16_t* A1; const bf16_t* A2; const bf16_t* B0; const bf16_t* B1; const bf16_t* B2; int lda; int K; int apn; };

struct Sched {
    int nM, nN, nBr, G, c, nT1, pm2, nM2, nT;
    __device__ void init(int nM_, int nN_, int nBr_, int G_, int c_, int pm2_ = 0, int nM2_ = 0, int nN2_ = 0) {
        nM = nM_; nN = nN_; nBr = nBr_; G = G_; c = c_; nT1 = nM * nN; pm2 = pm2_; nM2 = nM2_; nT = nT1 + nM2_ * nN2_; }
    __device__ bool next(int i, Unit& u) const {
        const int it = i / nBr; u.br = i - it * nBr;
        const long L = (long)it * G + c; if (L >= nT) return false;
        if (L < nT1) {
            int wgid = (int)L; { const int q = nT1 / NXCD, r = nT1 % NXCD, xcd = wgid % NXCD, off = wgid / NXCD; wgid = (xcd < r ? xcd * (q + 1) : r * (q + 1) + (xcd - r) * q) + off; }
            const int nig = WGM * nN, gid = wgid / nig, fm = gid * WGM, gsz = (nM - fm) < WGM ? (nM - fm) : WGM;
            u.pm = fm + ((wgid % nig) % gsz); u.pn = (wgid % nig) / gsz;
        } else { const int r = (int)L - nT1; u.pm = pm2 + r % nM2; u.pn = r / nM2; }
        return true;
    }
};

__device__ __forceinline__ unsigned cvt_pk_bf16(float lo, float hi) { return pk2(lo, hi); }

struct EpiBf16 {
    static constexpr bool PERM = true;
    bf16_t* O; int ldc;
    __device__ __forceinline__ bool operator()(f32x4 (&acc)[2][2][4][2], const Unit& u, int wr, int wc, int fr, int fq) const {
        const int row0 = u.pm * BM + wr * 64 + fr, col0 = u.pn * BM + wc * 32 + 8 * fq;
#pragma unroll
        for (int ai = 0; ai < 2; ++ai)
#pragma unroll
            for (int m = 0; m < 4; ++m) { bf16_t* rowp = O + (size_t)(row0 + ai * HALF + m * 16) * ldc + col0;
#pragma unroll
                for (int bj = 0; bj < 2; ++bj) { const f32x4 v0 = acc[ai][bj][m][0], v1 = acc[ai][bj][m][1];
                    u32x4 w; w.x = cvt_pk_bf16(v0[0], v0[1]); w.y = cvt_pk_bf16(v0[2], v0[3]); w.z = cvt_pk_bf16(v1[0], v1[1]); w.w = cvt_pk_bf16(v1[2], v1[3]);
                    *(u32x4*)(rowp + bj * HALF) = w; } }
        return false;
    }
};
struct EpiWin {
    static constexpr bool PERM = true;
    bf16_t* O; unsigned char* G8;
    __device__ __forceinline__ bool operator()(f32x4 (&acc)[2][2][4][2], const Unit& u, int wr, int wc, int fr, int fq) const {
        const int row0 = u.pm * BM + wr * 64 + fr;
        if (u.pn < 23) {
            const int col0 = u.pn * BM + wc * 32 + 8 * fq;
#pragma unroll
            for (int ai = 0; ai < 2; ++ai)
#pragma unroll
                for (int m = 0; m < 4; ++m) { bf16_t* rowp = O + (size_t)(row0 + ai * HALF + m * 16) * NP + col0;
#pragma unroll
                    for (int bj = 0; bj < 2; ++bj) { const f32x4 v0 = acc[ai][bj][m][0], v1 = acc[ai][bj][m][1];
                        u32x4 w; w.x = cvt_pk_bf16(v0[0], v0[1]); w.y = cvt_pk_bf16(v0[2], v0[3]); w.z = cvt_pk_bf16(v1[0], v1[1]); w.w = cvt_pk_bf16(v1[2], v1[3]);
                        *(u32x4*)(rowp + bj * HALF) = w; } }
        } else {
            const int col0 = (u.pn - 23) * BM + wc * 32 + 8 * fq;
#pragma unroll
            for (int ai = 0; ai < 2; ++ai)
#pragma unroll
                for (int m = 0; m < 4; ++m) { unsigned char* rowp = G8 + (size_t)(row0 + ai * HALF + m * 16) * NG + col0;
#pragma unroll
                    for (int bj = 0; bj < 2; ++bj) { unsigned q[8];
#pragma unroll
                        for (int n = 0; n < 2; ++n)
#pragma unroll
                            for (int e = 0; e < 4; ++e) { const float sg = 256.f * __builtin_amdgcn_rcpf(1.f + __expf(-acc[ai][bj][m][n][e])); q[4 * n + e] = (unsigned)fminf(sg, 255.f); }
                        u32x2 w; w.x = q[0] | (q[1] << 8) | (q[2] << 16) | (q[3] << 24); w.y = q[4] | (q[5] << 8) | (q[6] << 16) | (q[7] << 24);
                        *(u32x2*)(rowp + bj * HALF) = w; } }
        }
        return false;
    }
};
struct EpiF32 {
    static constexpr bool PERM = false;
    float* C; int ldc;
    __device__ __forceinline__ bool operator()(f32x4 (&acc)[2][2][4][2], const Unit& u, int wr, int wc, int fr, int fq) const {
        const int row0 = u.pm * BM + wr * 64 + fr, col0 = u.pn * BM + wc * 32 + 4 * fq;
#pragma unroll
        for (int ai = 0; ai < 2; ++ai)
#pragma unroll
            for (int m = 0; m < 4; ++m) { float* rowp = C + (size_t)(row0 + ai * HALF + m * 16) * ldc + col0;
#pragma unroll
                for (int bj = 0; bj < 2; ++bj)
#pragma unroll
                    for (int n = 0; n < 2; ++n) *(f32x4*)(rowp + bj * HALF + n * 16) = acc[ai][bj][m][n]; }
        return false;
    }
};
struct EpiSwiglu {
    static constexpr bool PERM = true;
    bf16_t* O;
    __device__ __forceinline__ bool operator()(f32x4 (&acc)[2][2][4][2], const Unit& u, int wr, int wc, int fr, int fq) const {
        const int row0 = u.pm * BM + wr * 64 + fr, col0 = u.pn * HALF + wc * 32 + 8 * fq;
#pragma unroll
        for (int ai = 0; ai < 2; ++ai)
#pragma unroll
            for (int m = 0; m < 4; ++m) { bf16_t* rowp = O + (size_t)(row0 + ai * HALF + m * 16) * DFF + col0;
                float r[8];
#pragma unroll
                for (int n = 0; n < 2; ++n)
#pragma unroll
                    for (int e = 0; e < 4; ++e) { const float g = acc[ai][0][m][n][e], up = acc[ai][1][m][n][e]; r[4 * n + e] = g * up * __builtin_amdgcn_rcpf(1.f + __expf(-g)); }
                u32x4 w; w.x = cvt_pk_bf16(r[0], r[1]); w.y = cvt_pk_bf16(r[2], r[3]); w.z = cvt_pk_bf16(r[4], r[5]); w.w = cvt_pk_bf16(r[6], r[7]);
                *(u32x4*)rowp = w; }
        return false;
    }
};
struct EpiGate {
    static constexpr bool PERM = true;
    const unsigned char* G8; bf16_t* Y;
    __device__ __forceinline__ bool operator()(f32x4 (&acc)[2][2][4][2], const Unit& u, int wr, int wc, int fr, int fq) const {
        const int row0 = u.pm * BM + wr * 64 + fr, col0 = u.pn * BM + wc * 32 + 8 * fq;
#pragma unroll
        for (int ai = 0; ai < 2; ++ai)
#pragma unroll
            for (int m = 0; m < 4; ++m) { const size_t row = (size_t)(row0 + ai * HALF + m * 16);
#pragma unroll
                for (int bj = 0; bj < 2; ++bj) { const int col = col0 + bj * HALF;
                    const u32x2 ga = *(const u32x2*)(G8 + row * NG + u.br * D + col);
                    if (u.br < 2) {
                        const u32x2 gb = *(const u32x2*)(G8 + row * NG + (u.br + 1) * D + col);
#pragma unroll
                        for (int n = 0; n < 2; ++n)
#pragma unroll
                            for (int e = 0; e < 4; ++e) { const float sa = (float)(((n ? ga.y : ga.x) >> (8 * e)) & 255u) + 0.5f, sb = (float)(((n ? gb.y : gb.x) >> (8 * e)) & 255u) + 0.5f;
                                acc[ai][bj][m][n][e] *= sa * __builtin_amdgcn_rcpf(sb); }
                    } else {
                        float r[8];
#pragma unroll
                        for (int n = 0; n < 2; ++n)
#pragma unroll
                            for (int e = 0; e < 4; ++e) r[4 * n + e] = acc[ai][bj][m][n][e] * (((float)(((n ? ga.y : ga.x) >> (8 * e)) & 255u) + 0.5f) * (1.f / 256.f));
                        u32x4 w; w.x = cvt_pk_bf16(r[0], r[1]); w.y = cvt_pk_bf16(r[2], r[3]); w.z = cvt_pk_bf16(r[4], r[5]); w.w = cvt_pk_bf16(r[6], r[7]);
                        *(u32x4*)(Y + row * D + col) = w;
                    } } }
        return u.br < 2;
    }
};

template <class Epi>
__device__ __forceinline__ void gemm_phase(LAS unsigned char* lds, const Gemm g, const Sched& S, const Epi& E, const int tid) {
    const int wid = __builtin_amdgcn_readfirstlane(tid >> 6), lane = tid & 63, wr = wid >> 2, wc = wid & 3, fr = lane & 15, fq = lane >> 4;
    const int K = g.K, nt = K / BK, lda = g.lda;
    unsigned voffA[2], voffB[2];
#pragma unroll
    for (int i = 0; i < 2; ++i) { int R, C; stage_rc(tid * 16 + i * 8192, R, C); const int Rb = Epi::PERM ? ((R & ~31) + perm32(R & 31)) : R;
        voffA[i] = (unsigned)(R * lda + C) * 2u; voffB[i] = (unsigned)(Rb * K + C) * 2u; }
    const size_t kstep = (size_t)(BK * 2);
    const size_t hstepA = (size_t)HALF * lda * 2, hstepB = (size_t)HALF * K * 2;
    const size_t tstepA = 2 * hstepA, tstepB = 2 * hstepB;
    const unsigned ldsw = (unsigned)wid * 1024u;
    const int aoff = lds_byte(wr * 64 + fr, fq * 8), boff = lds_byte(wc * 32 + fr, fq * 8);
#define PG8_UA(u) ((const char*)((u).br == 0 ? g.A0 : ((u).br == 1 ? g.A1 : g.A2)) + (size_t)(u).pm * tstepA + (size_t)((u).pn * g.apn))
#define PG8_UB(u) ((const char*)((u).br == 0 ? g.B0 : ((u).br == 1 ? g.B1 : g.B2)) + (size_t)(u).pn * tstepB)
#define PG8_SA(b, h) (((b) * 2 + (h)) * HTB)
#define PG8_SB(b, h) ((4 + (b) * 2 + (h)) * HTB)
#define PG8_STAGE(bufoff, gbase, voff) do { _Pragma("unroll") for (int _i = 0; _i < 2; ++_i) \
        __builtin_amdgcn_global_load_lds((const unsigned*)((const char*)(gbase) + (voff)[_i]), (LAS unsigned*)(lds + (bufoff) + ldsw + _i * 8192), 16, 0, 0); } while (0)
#define PG8_LDA(dst, b, h) do { _Pragma("unroll") for (int m = 0; m < 4; ++m) _Pragma("unroll") for (int k = 0; k < 2; ++k) dst[m][k] = *(const LAS bf16x8*)(lds + PG8_SA(b, h) + aoff + m * 2048 + k * 1024); } while (0)
#define PG8_LDB(dst, b, h) do { _Pragma("unroll") for (int n = 0; n < 2; ++n) _Pragma("unroll") for (int k = 0; k < 2; ++k) dst[n][k] = *(const LAS bf16x8*)(lds + PG8_SB(b, h) + boff + n * 2048 + k * 1024); } while (0)
#define PG8_MMA(ai, bj, At, Bt) do { __builtin_amdgcn_s_setprio(1); _Pragma("unroll") for (int m = 0; m < 4; ++m) _Pragma("unroll") for (int n = 0; n < 2; ++n) _Pragma("unroll") for (int k = 0; k < 2; ++k) \
        acc[ai][bj][m][n] = __builtin_amdgcn_mfma_f32_16x16x32_bf16(Bt[n][k], At[m][k], acc[ai][bj][m][n], 0, 0, 0); __builtin_amdgcn_s_setprio(0); } while (0)
#define PG8_WAIT_V(n) asm volatile("s_waitcnt vmcnt(" #n ")" ::: "memory")
#define PG8_WAIT_L(n) asm volatile("s_waitcnt lgkmcnt(" #n ")" ::: "memory")
#define PG8_BAR __builtin_amdgcn_s_barrier()
#define PG8_SCHED __builtin_amdgcn_sched_barrier(0)
    Unit cur, nxt; int ui = 0;
    if (!S.next(0, cur)) return;
    f32x4 acc[2][2][4][2];
#pragma unroll
    for (int a = 0; a < 2; ++a)
#pragma unroll
        for (int b = 0; b < 2; ++b)
#pragma unroll
            for (int m = 0; m < 4; ++m)
#pragma unroll
                for (int n = 0; n < 2; ++n) acc[a][b][m][n] = (f32x4){0.f, 0.f, 0.f, 0.f};
    bf16x8 At[4][2], B0[2][2], B1[2][2];
    const char* cA = PG8_UA(cur); const char* cB = PG8_UB(cur);
    PG8_STAGE(PG8_SB(0, 0), cB, voffB); PG8_STAGE(PG8_SB(0, 1), cB + hstepB, voffB); PG8_STAGE(PG8_SA(0, 0), cA, voffA); PG8_STAGE(PG8_SA(0, 1), cA + hstepA, voffA);
    if (wr == 1) PG8_BAR;
    PG8_WAIT_V(2); PG8_BAR;
    PG8_STAGE(PG8_SB(1, 0), cB + kstep, voffB); PG8_STAGE(PG8_SA(1, 0), cA + kstep, voffA); PG8_STAGE(PG8_SB(1, 1), cB + hstepB + kstep, voffB);
    PG8_WAIT_V(6); PG8_BAR;
    for (;;) {
        const bool has_next = S.next(ui + 1, nxt);
        const char* nA = has_next ? PG8_UA(nxt) : cA; const char* nB = has_next ? PG8_UB(nxt) : cB;
#pragma unroll 1
        for (int t = 0; t < nt; t += 2) {
            const bool last = (t == nt - 2);
            const char* a1 = cA + (size_t)(t + 1) * kstep;
            const char* a2 = last ? nA : cA + (size_t)(t + 2) * kstep; const char* b2 = last ? nB : cB + (size_t)(t + 2) * kstep;
            const char* a3 = a2 + kstep; const char* b3 = b2 + kstep;
            PG8_LDB(B0, 0, 0); PG8_LDB(B1, 0, 1); PG8_SCHED; PG8_LDA(At, 0, 0); PG8_STAGE(PG8_SA(1, 1), a1 + hstepA, voffA);
            PG8_WAIT_V(8); PG8_WAIT_L(0); PG8_BAR; PG8_MMA(0, 0, At, B0); PG8_MMA(0, 1, At, B1); PG8_BAR; PG8_SCHED;
            PG8_LDA(At, 0, 1); PG8_STAGE(PG8_SB(0, 0), b2, voffB); PG8_STAGE(PG8_SB(0, 1), b2 + hstepB, voffB); PG8_STAGE(PG8_SA(0, 0), a2, voffA);
            PG8_WAIT_V(8); PG8_WAIT_L(0); PG8_BAR; PG8_MMA(1, 0, At, B0); PG8_MMA(1, 1, At, B1); PG8_BAR; PG8_SCHED;
            PG8_LDB(B0, 1, 0); PG8_LDB(B1, 1, 1); PG8_SCHED; PG8_LDA(At, 1, 0); PG8_STAGE(PG8_SA(0, 1), a2 + hstepA, voffA);
            PG8_WAIT_V(8); PG8_WAIT_L(0); PG8_BAR; PG8_MMA(0, 0, At, B0); PG8_MMA(0, 1, At, B1); PG8_BAR; PG8_SCHED;
            PG8_LDA(At, 1, 1); PG8_STAGE(PG8_SB(1, 0), b3, voffB); PG8_STAGE(PG8_SB(1, 1), b3 + hstepB, voffB); PG8_STAGE(PG8_SA(1, 0), a3, voffA);
            PG8_WAIT_V(8); PG8_WAIT_L(0); PG8_BAR; PG8_MMA(1, 0, At, B0); PG8_MMA(1, 1, At, B1); PG8_BAR; PG8_SCHED;
        }
        if (wr == 0) PG8_BAR;
        const bool keep = E(acc, cur, wr, wc, fr, fq);
        if (!has_next) break;
        if (!keep) {
#pragma unroll
            for (int a = 0; a < 2; ++a)
#pragma unroll
                for (int b = 0; b < 2; ++b)
#pragma unroll
                    for (int m = 0; m < 4; ++m)
#pragma unroll
                        for (int n = 0; n < 2; ++n) acc[a][b][m][n] = (f32x4){0.f, 0.f, 0.f, 0.f};
        }
        cur = nxt; cA = nA; cB = nB; ++ui;
        if (wr == 1) PG8_BAR;
    }
    PG8_WAIT_V(0);
    PG8_BAR;
#undef PG8_UA
#undef PG8_UB
#undef PG8_SA
#undef PG8_SB
#undef PG8_STAGE
#undef PG8_LDA
#undef PG8_LDB
#undef PG8_MMA
#undef PG8_WAIT_V
#undef PG8_WAIT_L
#undef PG8_BAR
#undef PG8_SCHED
}
}

namespace att {
constexpr int NW = 8, QBLK = 32, KVBLK = 64;
constexpr float SCALE = 0.088388347648318440f;
constexpr float THR = 8.f;
constexpr size_t SHM_V = KVBLK * 128 * 2, SHM_K = KVBLK * 128 * 2, SHM_ATTN = 2 * SHM_V + 2 * SHM_K + NW * 64 * 4;
#define KSWZ(row, colB) ((row) * 256 + ((colB) ^ (((row) & 7) << 4)))
#define SBAR() __builtin_amdgcn_sched_barrier(0)
__device__ __forceinline__ int crow(int r, int hi) { return (r & 3) + 8 * (r >> 2) + 4 * hi; }
__device__ __forceinline__ unsigned cvtpk(float lo, float hi) { unsigned r; asm volatile("v_cvt_pk_bf16_f32 %0, %1, %2" : "=v"(r) : "v"(lo), "v"(hi)); return r; }
__device__ __forceinline__ void partialSM(f32x16& p0, f32x16& p1, float& m_reg, float& mn, float& alpha) {
  constexpr float C = SCALE * 1.4426950408889634f;
  float pmax = p0[0];
#pragma unroll
  for (int r = 1; r < 16; ++r) pmax = fmaxf(pmax, p0[r]);
#pragma unroll
  for (int r = 0; r < 16; ++r) pmax = fmaxf(pmax, p1[r]);
  { auto rr = __builtin_amdgcn_permlane32_swap(__float_as_uint(pmax), __float_as_uint(pmax), false, false);
    pmax = fmaxf(__uint_as_float(rr[0]), __uint_as_float(rr[1])); }
  if (__builtin_expect(__all(pmax - m_reg <= THR / SCALE), 1)) { mn = m_reg; alpha = 1.f; }
  else { mn = fmaxf(m_reg, pmax); alpha = __builtin_amdgcn_exp2f((m_reg - mn) * C); m_reg = mn; }
  float mnC = -mn * C;
#pragma unroll
  for (int r = 0; r < 16; ++r) p0[r] = fmaf(p0[r], C, mnC);
#pragma unroll
  for (int r = 0; r < 16; ++r) p1[r] = fmaf(p1[r], C, mnC);
#pragma unroll
  for (int r = 0; r < 16; ++r) p0[r] = __builtin_amdgcn_exp2f(p0[r]);
}
__device__ __forceinline__ void finishSM(f32x16& p0, f32x16& p1, float alpha, float& l_reg, bf16x8& pa0, bf16x8& pa1, bf16x8& pa2, bf16x8& pa3) {
#pragma unroll
  for (int r = 0; r < 16; ++r) p1[r] = __builtin_amdgcn_exp2f(p1[r]);
  float ps = 0;
#pragma unroll
  for (int r = 0; r < 16; ++r) ps += p0[r];
#pragma unroll
  for (int r = 0; r < 16; ++r) ps += p1[r];
  { auto rr = __builtin_amdgcn_permlane32_swap(__float_as_uint(ps), __float_as_uint(ps), false, false);
    ps = __uint_as_float(rr[0]) + __uint_as_float(rr[1]); }
  l_reg = l_reg * alpha + ps;
#define PK4(P, BASE, OUT) do { unsigned a0 = cvtpk(P[BASE + 0], P[BASE + 1]), a1 = cvtpk(P[BASE + 2], P[BASE + 3]);   \
    unsigned b0 = cvtpk(P[BASE + 4], P[BASE + 5]), b1 = cvtpk(P[BASE + 6], P[BASE + 7]);                              \
    auto r0 = __builtin_amdgcn_permlane32_swap(a0, b0, false, false); auto r1 = __builtin_amdgcn_permlane32_swap(a1, b1, false, false); \
    u32x4 w = {r0[0], r1[0], r0[1], r1[1]}; OUT = *reinterpret_cast<bf16x8*>(&w); } while (0)
  PK4(p0, 0, pa0); PK4(p0, 8, pa1); PK4(p1, 0, pa2); PK4(p1, 8, pa3);
#undef PK4
}
__device__ __forceinline__ void qkt(f32x16& p0, f32x16& p1, const bf16_t* Ks, const bf16x8* qr, int r32, int hi) {
  p0 = f32x16{}; p1 = f32x16{};
#pragma unroll
  for (int d0 = 0; d0 < 8; ++d0) { int cb = (d0 * 16 + hi * 8) * 2;
    bf16x8 b0 = *reinterpret_cast<const bf16x8*>((const char*)Ks + KSWZ(r32, cb));
    bf16x8 b1 = *reinterpret_cast<const bf16x8*>((const char*)Ks + KSWZ(32 + r32, cb));
    p0 = __builtin_amdgcn_mfma_f32_32x32x16_bf16(b0, qr[d0], p0, 0, 0, 0);
    p1 = __builtin_amdgcn_mfma_f32_32x32x16_bf16(b1, qr[d0], p1, 0, 0, 0); }
}
__device__ __forceinline__ int v_st(int k, int c) { const int kk = (k & ~0xC) | ((k & 4) << 1) | ((k & 8) >> 1); return ((kk >> 3) * 4 + (c >> 5)) * 512 + ((kk & 7) * 32 + (c & 31)) * 2; }
__device__ __forceinline__ int v_rd_base(int lane) { return ((lane & 3) << 3) | (((lane >> 2) & 3) << 6) | (((lane >> 4) & 1) << 5) | (((lane >> 5) & 1) << 8); }
constexpr int v_rd_off(int d0, int ks, int half) { return d0 * 512 + ks * 4096 + half * 2048; }
template <int OFF> __device__ __forceinline__ s16x4 tr_read(int vb) {
  s16x4 r; asm volatile("ds_read_b64_tr_b16 %0, %1 offset:%2" : "=&v"(r) : "v"(vb), "i"(OFF) : "memory"); return r;
}
template <int D0> __device__ __forceinline__ void pv_one(f32x16& od, int vb, bf16x8 pa0, bf16x8 pa1, bf16x8 pa2, bf16x8 pa3) {
  const s16x4 l0 = tr_read<v_rd_off(D0, 0, 0)>(vb), h0 = tr_read<v_rd_off(D0, 0, 1)>(vb), l1 = tr_read<v_rd_off(D0, 1, 0)>(vb), h1 = tr_read<v_rd_off(D0, 1, 1)>(vb);
  const s16x4 l2 = tr_read<v_rd_off(D0, 2, 0)>(vb), h2 = tr_read<v_rd_off(D0, 2, 1)>(vb), l3 = tr_read<v_rd_off(D0, 3, 0)>(vb), h3 = tr_read<v_rd_off(D0, 3, 1)>(vb);
  asm volatile("s_waitcnt lgkmcnt(0)" ::: "memory"); SBAR();
#define PK(L, H) (bf16x8){L[0], L[1], L[2], L[3], H[0], H[1], H[2], H[3]}
  od = __builtin_amdgcn_mfma_f32_32x32x16_bf16(pa0, PK(l0, h0), od, 0, 0, 0);
  od = __builtin_amdgcn_mfma_f32_32x32x16_bf16(pa1, PK(l1, h1), od, 0, 0, 0);
  od = __builtin_amdgcn_mfma_f32_32x32x16_bf16(pa2, PK(l2, h2), od, 0, 0, 0);
  od = __builtin_amdgcn_mfma_f32_32x32x16_bf16(pa3, PK(l3, h3), od, 0, 0, 0);
#undef PK
}
__device__ __forceinline__ void pv_d0(f32x16* o, int vb, bf16x8 pa0, bf16x8 pa1, bf16x8 pa2, bf16x8 pa3) {
  pv_one<0>(o[0], vb, pa0, pa1, pa2, pa3); pv_one<1>(o[1], vb, pa0, pa1, pa2, pa3); pv_one<2>(o[2], vb, pa0, pa1, pa2, pa3); pv_one<3>(o[3], vb, pa0, pa1, pa2, pa3);
}
__device__ __forceinline__ void attn_dense_body(const bf16_t* Qb, const bf16_t* __restrict__ KL, const bf16_t* __restrict__ KC,
                                                int ntl, bf16_t* Ob, int NT, char* lds, const int tid, const bool dost = true) {
  constexpr int LDQ = NP, LDK = NP, LDO = NP;
  const int wid = tid >> 6, lane = tid & 63, r32 = lane & 31, hi = lane >> 5;
  bf16_t* V_lds = (bf16_t*)lds; bf16_t* K_lds = (bf16_t*)(lds + 2 * SHM_V);
  float* ws = (float*)(lds + 2 * SHM_V + 2 * SHM_K) + wid * 64; float* li_l = ws; float* al_l = ws + 32;
  float m_reg = -1e30f, l_reg = 0; f32x16 o[4] = {}; bf16x8 qr[8];
  const bf16_t* Qw = Qb + (long)(wid * QBLK + r32) * LDQ + hi * 8;
#pragma unroll
  for (int d0 = 0; d0 < 8; ++d0) qr[d0] = *reinterpret_cast<const bf16x8*>(Qw + d0 * 16);
  const int sr = tid >> 4, sc = (tid & 15) * 8, vst0 = v_st(sr, sc), vst1 = v_st(32 + sr, sc);
  const int vb0 = (int)(uintptr_t)V_lds + v_rd_base(lane);
  struct { bf16x8 vs0, vs1, ks0, ks1; } sr_[1];
  const int loff0 = sr * LDK + sc, loff1 = (32 + sr) * LDK + sc;
  const bf16_t* knext = (ntl > 0) ? KL : KC; int tl_ = 0;
#define SLOAD(i, t) do { const bf16_t* kt_ = knext; ++tl_; knext = (tl_ == ntl) ? KC : knext + (long)KVBLK * LDK; \
    sr_[i].vs0 = *reinterpret_cast<const bf16x8*>(kt_ + loff0 + (C_AV - C_AK)); sr_[i].vs1 = *reinterpret_cast<const bf16x8*>(kt_ + loff1 + (C_AV - C_AK)); \
    sr_[i].ks0 = *reinterpret_cast<const bf16x8*>(kt_ + loff0); sr_[i].ks1 = *reinterpret_cast<const bf16x8*>(kt_ + loff1); } while (0)
#define SWRITE(b, i) do { *(bf16x8*)((char*)V_lds + (b) * SHM_V + vst0) = sr_[i].vs0;          \
    *(bf16x8*)((char*)V_lds + (b) * SHM_V + vst1) = sr_[i].vs1; int kc = sc * 2;               \
    *(bf16x8*)((char*)K_lds + (b) * SHM_K + KSWZ(sr, kc)) = sr_[i].ks0;                       \
    *(bf16x8*)((char*)K_lds + (b) * SHM_K + KSWZ(32 + sr, kc)) = sr_[i].ks1; } while (0)
#define SWAIT() asm volatile("s_waitcnt vmcnt(0)" ::: "memory")
#define RESC(a) do { if (__any((a) < 1.f)) { if (hi == 0) al_l[r32] = (a); asm volatile("s_waitcnt lgkmcnt(0)" ::: "memory"); \
    _Pragma("unroll") for (int d = 0; d < 4; ++d) _Pragma("unroll") for (int r = 0; r < 16; ++r) o[d][r] *= al_l[crow(r, hi)]; } } while (0)
  f32x16 pA0, pA1, pB0, pB1; float mnA, mnB, alA, alB; bf16x8 pa0, pa1, pa2, pa3;
  constexpr int SE = 0, SO = 0;
  SLOAD(SE, 0); asm volatile("s_waitcnt vmcnt(0)" ::: "memory"); SWRITE(0, SE); __syncthreads();
  qkt(pA0, pA1, K_lds, qr, r32, hi); partialSM(pA0, pA1, m_reg, mnA, alA);
  SLOAD(SO, 1);
  SWAIT(); SWRITE(1, SO); __syncthreads();
  for (int j = 1; j + 1 < NT; j += 2) {
    SBAR(); qkt(pB0, pB1, (bf16_t*)((char*)K_lds + SHM_K), qr, r32, hi);
    finishSM(pA0, pA1, alA, l_reg, pa0, pa1, pa2, pa3); SBAR();
    SLOAD(SO, j + 1); SBAR();
    pv_d0(o, vb0, pa0, pa1, pa2, pa3); partialSM(pB0, pB1, m_reg, mnB, alB);
    __syncthreads(); SWAIT(); SWRITE(0, SE);
    RESC(alB); __syncthreads();
    SBAR(); qkt(pA0, pA1, K_lds, qr, r32, hi);
    finishSM(pB0, pB1, alB, l_reg, pa0, pa1, pa2, pa3); SBAR();
    SLOAD(SE, j + 2); SBAR();
    pv_d0(o, vb0 + (int)SHM_V, pa0, pa1, pa2, pa3); partialSM(pA0, pA1, m_reg, mnA, alA);
    __syncthreads(); SWAIT(); SWRITE(1, SO);
    RESC(alA); __syncthreads();
  }
  SBAR(); qkt(pB0, pB1, (bf16_t*)((char*)K_lds + SHM_K), qr, r32, hi);
  finishSM(pA0, pA1, alA, l_reg, pa0, pa1, pa2, pa3); SBAR();
  pv_d0(o, vb0, pa0, pa1, pa2, pa3); partialSM(pB0, pB1, m_reg, mnB, alB);
  __syncthreads(); RESC(alB);
  finishSM(pB0, pB1, alB, l_reg, pa0, pa1, pa2, pa3); SBAR();
  pv_d0(o, vb0 + (int)SHM_V, pa0, pa1, pa2, pa3);
  if (hi == 0) li_l[r32] = l_reg; asm volatile("s_waitcnt lgkmcnt(0)" ::: "memory");
  float rli[16];
#pragma unroll
  for (int r = 0; r < 16; ++r) rli[r] = __builtin_amdgcn_rcpf(li_l[crow(r, hi)]);
  bf16_t* Ow = Ob + (long)(wid * QBLK) * LDO;
#pragma unroll
  for (int r = 0; r < 16; ++r) { int orow = crow(r, hi);
#pragma unroll
    for (int d0 = 0; d0 < 4; ++d0) if (dost) Ow[(long)orow * LDO + d0 * 32 + r32] = (bf16_t)f2bf(o[d0][r] * rli[r]); }
  __syncthreads();
#undef SLOAD
#undef SWRITE
#undef SWAIT
#undef RESC
}
#undef KSWZ
#undef SBAR
}


#define XB_TMO      128
#define XB_XCNT(j)  (256  + 64 * (j))
#define XB_XSUB(j)  (1280 + 64 * (j))
#define XB_XGEN(j)  (2304 + 64 * (j))
#define XB_TOP      3328
#define XB_TOPGEN   3392
#define XCD_BAR_WORDS 3456
#define XB_SPIN_CAP (1u << 18)
__device__ __forceinline__ unsigned xb_ld(unsigned* p)              { return __hip_atomic_load(p, __ATOMIC_RELAXED, __HIP_MEMORY_SCOPE_AGENT); }
__device__ __forceinline__ unsigned xb_add(unsigned* p, unsigned v) { return __hip_atomic_fetch_add(p, v, __ATOMIC_RELAXED, __HIP_MEMORY_SCOPE_AGENT); }
__device__ __forceinline__ unsigned xb_xcc_id() { return (unsigned)__builtin_amdgcn_s_getreg((3 << 11) | 20) & 0xFu; }
#define XB_SPIN(cond, bar) do { unsigned _sp = 0; while (cond) { __builtin_amdgcn_s_sleep(1); \
    if ((++_sp & 255u) == 0u) { if (xb_ld(&(bar)[XB_TMO])) break; if (_sp > XB_SPIN_CAP) { atomicAdd(&(bar)[XB_TMO], 1u); break; } } } } while (0)
struct XcdBarrier { unsigned* bar; unsigned x; volatile LAS unsigned* st; };
__device__ __forceinline__ XcdBarrier xcd_barrier_post(unsigned* bar, volatile LAS unsigned* st) {
    XcdBarrier b; b.bar = bar; b.x = xb_xcc_id(); b.st = st;
    if (threadIdx.x == 0) (void)xb_add(&bar[XB_XCNT(b.x)], 1u);
    return b;
}
__device__ __forceinline__ void xcd_barrier_complete(unsigned* bar, unsigned x, unsigned& nloc, unsigned& nx) {
    const unsigned G = gridDim.x * gridDim.y * gridDim.z;
    unsigned sum, cnt, mine, sp = 0u;
    for (;;) {
        sum = 0u; cnt = 0u; mine = 0u;
#pragma unroll
        for (unsigned j = 0; j < 16; ++j) { const unsigned c = xb_ld(&bar[XB_XCNT(j)]); sum += c; cnt += (c > 0u) ? 1u : 0u; mine = (j == x) ? c : mine; }
        if (sum == G) break;
        __builtin_amdgcn_s_sleep(1);
        if ((++sp & 255u) == 0u) { if (xb_ld(&bar[XB_TMO])) break; if (sp > XB_SPIN_CAP) { atomicAdd(&bar[XB_TMO], 1u); break; } }
    }
    nloc = mine > 0u ? mine : 1u; nx = cnt > 0u ? cnt : 1u;
}
__device__ __forceinline__ void xcd_barrier(const XcdBarrier& b) {
    asm volatile("s_waitcnt vmcnt(0)" ::: "memory");
    __syncthreads();
    if (threadIdx.x == 0) {
        unsigned* bar = b.bar;
        __builtin_amdgcn_s_waitcnt(0);
        unsigned nloc = b.st[0], nx = b.st[1];
        if (nloc == 0u) { xcd_barrier_complete(bar, b.x, nloc, nx); b.st[0] = nloc; b.st[1] = nx; }
        const unsigned old = xb_add(&bar[XB_XSUB(b.x)], 1u);
        const unsigned gen = old / nloc;
        if (old + 1u == (gen + 1u) * nloc) {
            __builtin_amdgcn_fence(__ATOMIC_RELEASE, "agent");
            asm volatile("s_waitcnt vmcnt(0)" ::: "memory");
            const unsigned og = xb_add(&bar[XB_TOP], 1u);
            const unsigned tg = og / nx;
            if (og + 1u == (tg + 1u) * nx) xb_add(&bar[XB_TOPGEN], 1u);
            else XB_SPIN(xb_ld(&bar[XB_TOPGEN]) == tg, bar);
            __builtin_amdgcn_fence(__ATOMIC_ACQUIRE, "agent");
            xb_add(&bar[XB_XGEN(b.x)], 1u);
            asm volatile("s_waitcnt vmcnt(0)" ::: "memory");
        } else {
            XB_SPIN(xb_ld(&bar[XB_XGEN(b.x)]) == gen, bar);
            __builtin_amdgcn_fence(__ATOMIC_ACQUIRE, "agent");
            asm volatile("s_waitcnt vmcnt(0)" ::: "memory");
        }
    }
    __syncthreads();
}

typedef const __attribute__((address_space(4))) Args* ArgsP;
struct Fr {
    char* lds; LAS unsigned char* lds3; int tid, lane, wave, G, vcu, gw, NGW, bx;
    ArgsP ap;
};
#define WSB (F.ap->ws)
#define F_P ((bf16_t*)(WSB + WS_P))
#define F_H ((bf16_t*)(WSB + WS_H))
#define F_MIX ((bf16_t*)(WSB + WS_MIX))
#define F_CST ((bf16_t*)(WSB + WS_CST))
#define F_MOD ((float*)(WSB + WS_MOD))
#define F_LI ((float*)(WSB + WS_LI))
#define F_LF ((float*)(WSB + WS_LF))
#define F_GT ((float*)(WSB + WS_GT))
#define F_MLOC ((float*)(WSB + WS_GT) + 2048)
#define F_MIN ((float*)(WSB + WS_GT) + 4096)
#define F_NST ((float*)(WSB + WS_NST))
#define F_XC ((float*)(WSB + WS_XC))


__device__ __forceinline__ void tr_item(const float* W, int N, int k0, int n0, bf16_t* WT, int ldt, int drow0, const float* rscale, float* scr, int lane, int split = 1 << 30, int shift = 0) {
    const int cq = lane & 15, rq = lane >> 4, dn = n0 + 4 * cq, nn = dn < split ? dn : dn - shift; const bool ok = (nn < N) && (dn < split || dn >= split + shift);
    f32x4 v[16];
#pragma unroll
    for (int i = 0; i < 16; ++i) v[i] = ok ? __builtin_nontemporal_load((const f32x4*)(W + (size_t)(k0 + 4 * i + rq) * N + nn)) : (f32x4){0.f, 0.f, 0.f, 0.f};
#pragma unroll
    for (int i = 0; i < 16; ++i) { float* d = scr + (4 * i + rq) * 65 + 4 * cq; d[0] = v[i][0]; d[1] = v[i][1]; d[2] = v[i][2]; d[3] = v[i][3]; }
    asm volatile("s_waitcnt lgkmcnt(0)" ::: "memory");
    const int c = lane & 7;
#pragma unroll
    for (int j = 0; j < 8; ++j) { const int n = (lane >> 3) + 8 * j; const float* sp = scr + (8 * c) * 65 + n;
        const float sc = rscale ? rscale[n0 + n] : 1.f;
        u32x4 o; o.x = pk2(sp[0 * 65] * sc, sp[1 * 65] * sc); o.y = pk2(sp[2 * 65] * sc, sp[3 * 65] * sc); o.z = pk2(sp[4 * 65] * sc, sp[5 * 65] * sc); o.w = pk2(sp[6 * 65] * sc, sp[7 * 65] * sc);
        *(u32x4*)(WT + (size_t)(drow0 + n) * ldt + k0 + 8 * c) = o; }
    asm volatile("s_waitcnt lgkmcnt(0)" ::: "memory");
}
__device__ __forceinline__ void convert_weights(Fr& F, int l) {
    float* scr = (float*)(F.lds + F.wave * 16640);
    constexpr int I_IN = 32 * 188, I_FI = 32 * 176, I_FO = 88 * 32, I_UP = 16 * 32, I_OUT = 32 * 32, I_PL = 64;
    constexpr int NIT = I_IN + I_FI + I_FO + 3 * I_UP + I_OUT + I_PL;
    for (int it = F.gw; it < NIT; it += F.NGW) {
        int r = it;
        if (r < I_IN) { const int kb = r / 188, nb = r % 188; tr_item(F.ap->in[I_WIN] + (size_t)l * D * DIN, DIN, kb * 64, nb * 64, (bf16_t*)(WSB + WS_WIN), D, nb * 64, nullptr, scr, F.lane, C_GRAW, NP - C_GRAW); continue; } r -= I_IN;
        if (r < I_FI) { const int kb = r / 176, nb = r % 176, n0 = nb * 64, bj = n0 / DFF, jj0 = n0 % DFF;
            tr_item(F.ap->in[I_FFI] + (size_t)l * D * 2 * DFF, 2 * DFF, kb * 64, n0, (bf16_t*)(WSB + WS_WFI), D, (jj0 / 128) * 256 + bj * 128 + (jj0 % 128), nullptr, scr, F.lane); continue; } r -= I_FI;
        if (r < I_FO) { const int kb = r / 32, nb = r % 32; tr_item(F.ap->in[I_FFO] + (size_t)l * DFF * D, D, kb * 64, nb * 64, (bf16_t*)(WSB + WS_WFO), DFF, nb * 64, nullptr, scr, F.lane); continue; } r -= I_FO;
#define UPCASE(BR, IDX) if (r < I_UP) { const int kb = r / 32, nb = r % 32; \
            tr_item(F.ap->in[IDX] + (size_t)l * 1024 * D, D, kb * 64, nb * 64, (bf16_t*)(WSB + WS_WUP) + (size_t)(BR) * D * 1024, 1024, nb * 64, nullptr, scr, F.lane); continue; } r -= I_UP;
        UPCASE(0, I_UPA) UPCASE(1, I_UPM) UPCASE(2, I_UPP)
#undef UPCASE
        if (r < I_OUT) { const int kb = r / 32, nb = r % 32; tr_item(F.ap->in[I_WOUT] + (size_t)l * D * D, D, kb * 64, nb * 64, (bf16_t*)(WSB + WS_WOUT), D, nb * 64, nullptr, scr, F.lane); continue; } r -= I_OUT;
        { const int g = r / 16, q = r % 16, kb = q / 4, nb = q % 4;
          tr_item(F.ap->in[I_POOLW] + ((size_t)l * 4 + g) * 65536, 256, kb * 64, nb * 64, (bf16_t*)(WSB + WS_WPL) + (size_t)g * 65536, 256, nb * 64, F.ap->in[I_POOLS] + l * 1024 + g * 256, scr, F.lane); }
    }
}

__device__ __forceinline__ void mod_gemv(Fr& F) {
    float* sc = (float*)F.lds;
    float* red = (float*)(F.lds + 5 * 2048 * 4);
    for (int i = F.tid; i < 5 * 2048; i += 512) { const int m = i >> 11, k = i & 2047; const float v = m < 4 ? F.ap->in[I_C][m * 2048 + k] : F.ap->in[I_CCTX][k]; sc[i] = v / (1.f + __expf(-v)); }
    __syncthreads();
    const int kpar = F.lane >> 5, cl = F.lane & 31;
    for (int it = F.bx; it < 768; it += F.G) {
        const int l = it / 384, col = (it % 384) * 32 + cl;
        const float* w = F.ap->in[I_WMOD] + (size_t)l * D * 12288 + col;
        float a0 = 0, a1 = 0, a2 = 0, a3 = 0, a4 = 0;
        const int kbase = F.wave * 256 + kpar;
#pragma unroll 32
        for (int kk = 0; kk < 128; ++kk) { const int k = kbase + 2 * kk; const float wv = __builtin_nontemporal_load(w + (size_t)k * 12288);
            a0 += sc[k] * wv; a1 += sc[2048 + k] * wv; a2 += sc[4096 + k] * wv; a3 += sc[6144 + k] * wv; a4 += sc[8192 + k] * wv; }
        a0 += __shfl_xor(a0, 32); a1 += __shfl_xor(a1, 32); a2 += __shfl_xor(a2, 32); a3 += __shfl_xor(a3, 32); a4 += __shfl_xor(a4, 32);
        if (kpar == 0) { float* rp = red + F.wave * 160 + cl; rp[0] = a0; rp[32] = a1; rp[64] = a2; rp[96] = a3; rp[128] = a4; }
        __syncthreads();
        if (F.tid < 160) { float s = 0;
#pragma unroll
            for (int w8 = 0; w8 < 8; ++w8) s += red[w8 * 160 + F.tid];
            const int m = F.tid >> 5, c = (it % 384) * 32 + (F.tid & 31);
            F_MOD[((size_t)l * 5 + m) * 12288 + c] = s + F.ap->in[I_BMOD][l * 12288 + c]; }
        __syncthreads();
    }
}

__device__ __forceinline__ void ld_row(const float* p, int lane, f32x4 (&v)[8]) {
#pragma unroll
    for (int j = 0; j < 8; ++j) v[j] = __builtin_nontemporal_load((const f32x4*)p + lane + 64 * j);
}
__device__ __forceinline__ float row_rinv(const f32x4 (&v)[8]) {
    float s = 0.f;
#pragma unroll
    for (int j = 0; j < 8; ++j) s += (v[j].x * v[j].x + v[j].y * v[j].y) + (v[j].z * v[j].z + v[j].w * v[j].w);
    return 1.f / sqrtf(wave_sum(s) * (1.f / D) + EPS);
}
__device__ __forceinline__ void norm_mod_store(const f32x4 (&x)[8], const float* g, const float* sh, const float* sc, bf16_t* orow, int lane) {
    const float rinv = row_rinv(x);
#pragma unroll
    for (int j = 0; j < 8; ++j) { const int i = lane + 64 * j; const f32x4 gg = ((const f32x4*)g)[i], s1 = ((const f32x4*)sc)[i], s0 = ((const f32x4*)sh)[i];
        const f32x4 h = (x[j] * rinv * gg) * (1.f + s1) + s0;
        u32x2 w; w.x = pk2(h.x, h.y); w.y = pk2(h.z, h.w); ((u32x2*)orow)[i] = w; }
}
__device__ __forceinline__ int mod_row(int r) { return r < ML ? (r >> 12) : 4; }
__device__ __forceinline__ void phase_norm1(Fr& F, int l, const float* xlat, const float* xctx) {
    const float* g = F.ap->in[I_NORMG] + (size_t)l * 4 * D;
    for (int r = F.gw; r < MT; r += F.NGW) {
        const float* src = r < ML ? xlat + (size_t)r * D : xctx + (size_t)(r - ML) * D;
        const float* mod = F_MOD + ((size_t)l * 5 + mod_row(r)) * 12288;
        f32x4 x[8]; ld_row(src, F.lane, x);
        norm_mod_store(x, g, mod, mod + D, F_H + (size_t)r * D, F.lane);
    }
}
__device__ __forceinline__ void phase_resid(Fr& F, int l, int which, int nrows, const float* xlat_src, const float* xctx_src, bool nextnorm, const bool srcbf, const bool dstbf, const bool dost = true) {
    const float* ng = F.ap->in[I_NORMG] + (size_t)l * 4 * D;
    const bf16_t* Y = (const bf16_t*)(WSB + WS_YO);
    for (int r = F.gw; r < nrows; r += F.NGW) {
        const float* src = r < ML ? xlat_src + (size_t)r * D : xctx_src + (size_t)(r - ML) * D;
        float* dst = r < ML ? F.ap->out + (size_t)r * D : F_XC + (size_t)(r - ML) * D;
        const float* mod = F_MOD + ((size_t)l * 5 + mod_row(r)) * 12288;
        const float* gate = mod + (which == 0 ? 2 : 5) * D; const float* gy = ng + (which == 0 ? 1 : 3) * D;
        f32x4 y[8], x[8];
#pragma unroll
        for (int j = 0; j < 8; ++j) { const u32x2 w = __builtin_nontemporal_load((const u32x2*)(Y + (size_t)r * D) + F.lane + 64 * j);
            y[j] = (f32x4){__uint_as_float(w.x << 16), __uint_as_float(w.x & 0xffff0000u), __uint_as_float(w.y << 16), __uint_as_float(w.y & 0xffff0000u)}; }
        bf16_t* xb = (bf16_t*)(WSB + WS_XB) + (size_t)(r < ML ? r : 0) * D;
        if (r < ML && srcbf) {
#pragma unroll
            for (int j = 0; j < 8; ++j) { const u32x2 w = __builtin_nontemporal_load((const u32x2*)xb + F.lane + 64 * j);
                x[j] = (f32x4){__uint_as_float(w.x << 16), __uint_as_float(w.x & 0xffff0000u), __uint_as_float(w.y << 16), __uint_as_float(w.y & 0xffff0000u)}; }
        } else ld_row(src, F.lane, x);
        const float ry = row_rinv(y);
#pragma unroll
        for (int j = 0; j < 8; ++j) { const int i = F.lane + 64 * j; const f32x4 gt = ((const f32x4*)gate)[i], gg = ((const f32x4*)gy)[i];
            x[j] = x[j] + gt * (y[j] * ry * gg);
            if (dost) { if (r < ML && dstbf) { u32x2 w; w.x = pk2(x[j].x, x[j].y); w.y = pk2(x[j].z, x[j].w); ((u32x2*)xb)[i] = w; } else ((f32x4*)dst)[i] = x[j]; } }
        if (which == 0) norm_mod_store(x, ng + 2 * D, mod + 3 * D, mod + 4 * D, F_H + (size_t)r * D, F.lane);
        else if (nextnorm) { const float* mod2 = F_MOD + ((size_t)(l + 1) * 5 + mod_row(r)) * 12288;
            norm_mod_store(x, F.ap->in[I_NORMG] + (size_t)(l + 1) * 4 * D, mod2, mod2 + D, F_H + (size_t)r * D, F.lane); }
    }
}

__device__ __forceinline__ void phase_prep(Fr& F, int l, const bool dost = true) {
    const float* qkg = F.ap->in[I_QKG] + l * 256;
    const float* gb = F.ap->in[I_GATEB] + l * 16;
    const int lane = F.lane, i32 = lane & 31, sub = lane >> 5;
    float gq[4], gk[4];
#pragma unroll
    for (int e = 0; e < 4; ++e) { gq[e] = qkg[32 * e + i32]; gk[e] = qkg[128 + 32 * e + i32]; }
    const float inv = __builtin_amdgcn_exp2f(-(float)i32 * (13.287712379549449f / 32.f));
    for (int rp = F.gw; rp < MT / 2; rp += F.NGW) {
        const int r = 2 * rp + sub;
        bf16_t* prow = F_P + (size_t)r * NP;
        const bool lat = r < ML;
        const int nh = (lat || l == 0) ? 10 : 2;
        float cs0 = 1.f, sn0 = 0.f, cs1 = 1.f, sn1 = 0.f;
        if (lat) { const int t = r & 4095;
            float rev0 = (float)(t >> 6) * inv * 0.15915494309189535f, rev1 = (float)(t & 63) * inv * 0.15915494309189535f;
            rev0 -= rintf(rev0); rev1 -= rintf(rev1);
            sn0 = __builtin_amdgcn_sinf(rev0); cs0 = __builtin_amdgcn_cosf(rev0); sn1 = __builtin_amdgcn_sinf(rev1); cs1 = __builtin_amdgcn_cosf(rev1); }
        float x[10][4];
#pragma unroll
        for (int h = 0; h < 10; ++h) if (h < nh) { const int c0 = h < 2 ? C_AK + h * 128 : C_AQ + (h - 2) * 128;
#pragma unroll
            for (int e = 0; e < 4; ++e) x[h][e] = bf2f(prow[c0 + 32 * e + i32]); }
#pragma unroll
        for (int h = 0; h < 10; ++h) if (h < nh) {
            const int c0 = h < 2 ? C_AK + h * 128 : C_AQ + (h - 2) * 128;
            float ss = (x[h][0] * x[h][0] + x[h][1] * x[h][1]) + (x[h][2] * x[h][2] + x[h][3] * x[h][3]);
#pragma unroll
            for (int o = 1; o < 32; o <<= 1) ss += __shfl_xor(ss, o);
            const float rinv = __builtin_amdgcn_rsqf(ss * (1.f / 128.f) + EPS);
            const float a0 = x[h][0] * rinv * (h < 2 ? gk[0] : gq[0]), b0 = x[h][1] * rinv * (h < 2 ? gk[1] : gq[1]);
            const float a1 = x[h][2] * rinv * (h < 2 ? gk[2] : gq[2]), b1 = x[h][3] * rinv * (h < 2 ? gk[3] : gq[3]);
            if (dost) { prow[c0 + i32] = (bf16_t)f2bf(a0 * cs0 - b0 * sn0); prow[c0 + 32 + i32] = (bf16_t)f2bf(b0 * cs0 + a0 * sn0);
                        prow[c0 + 64 + i32] = (bf16_t)f2bf(a1 * cs1 - b1 * sn1); prow[c0 + 96 + i32] = (bf16_t)f2bf(b1 * cs1 + a1 * sn1); } }
        if (i32 < 16) { const int q = i32 & 7, d = q >> 2, hh = q & 3;
            const float raw = bf2f(prow[(i32 < 8 ? C_GI : C_GF) + q]);
            if (i32 < 8) F_LI[(size_t)r * 8 + q] = raw + gb[d * 8 + hh];
            else { const float xx = raw + gb[d * 8 + 4 + hh]; F_LF[(size_t)r * 8 + q] = fminf(xx, 0.f) - __logf(1.f + __expf(-fabsf(xx))); } }
    }
    const int nrows = (l == 0) ? MT : ML;
    const long total = (long)nrows * 128, nth = (long)F.G * 512;
    for (long it = (long)F.bx * 512 + F.tid; it < total; it += nth) {
        const int gi = (int)((it >> 6) & 3), c8 = (int)(it & 31) | (gi << 5), r = (int)((it >> 8) << 1) | (int)((it >> 5) & 1);
        const int T = r < ML ? SEQ : CTXL, t = r < ML ? (r & 4095) : ((r - ML) & 255);
        const bf16_t* base = F_P + (size_t)(r - t) * NP + C_PL + c8 * 8;
        float s[8] = {0, 0, 0, 0, 0, 0, 0, 0}; int cnt = 0, nwin = 0;
#define POOLW(HW) { bf16x8 v[2 * HW]; \
            _Pragma("unroll") for (int k = 0; k < 2 * HW; ++k) { const int u = t - HW + k; const bool ok = (u >= 0) && (u < T); const int uc = ok ? u : t; v[k] = *(const bf16x8*)(base + (size_t)uc * NP); cnt += ok ? 1 : 0; } \
            _Pragma("unroll") for (int k = 0; k < 2 * HW; ++k) { \
                _Pragma("unroll") for (int i = 0; i < 8; ++i) s[i] += bfs2f(v[k][i]); } nwin = 2 * HW; }
        if (gi == 0) POOLW(1) else if (gi == 1) POOLW(2) else if (gi == 2) POOLW(4) else POOLW(8)
#undef POOLW
        const bf16x8 self = *(const bf16x8*)(base + (size_t)t * NP); const float rc = __builtin_amdgcn_rcpf((float)cnt); const float ninv = (float)(nwin - cnt);
#pragma unroll
        for (int i = 0; i < 8; ++i) s[i] -= ninv * bfs2f(self[i]);
        u32x4 w; w.x = pk2(s[0] * rc - bfs2f(self[0]), s[1] * rc - bfs2f(self[1])); w.y = pk2(s[2] * rc - bfs2f(self[2]), s[3] * rc - bfs2f(self[3]));
        w.z = pk2(s[4] * rc - bfs2f(self[4]), s[5] * rc - bfs2f(self[5])); w.w = pk2(s[6] * rc - bfs2f(self[6]), s[7] * rc - bfs2f(self[7]));
        *(u32x4*)(F_MIX + (size_t)r * 1024 + c8 * 8) = w;
    }
}

__device__ __forceinline__ void chunk_bs(int cidx, int& b, int& slot) { if (cidx < 128) { b = cidx >> 5; slot = 2 + (cidx & 31); } else { b = (cidx - 128) >> 1; slot = (cidx - 128) & 1; } }
__device__ __forceinline__ int unit_idx(int b, int hh, int d, int slot) { return ((b * 4 + hh) * 2 + d) * NSLOT + slot; }
constexpr int VS = 136;
constexpr int LDS_VT = 0, LDS_KT = 256 * VS * 2, LDS_FS = LDS_KT + 128 * VS * 2, LDS_CH = LDS_FS + 5120;

__device__ __forceinline__ void stage_vt(Fr& F, bf16_t* VT, size_t R0, int hh) {
    for (int idx = F.tid; idx < 1024; idx += 512) { const int l4 = idx & 31, c8 = idx >> 5;
        const bf16_t* src = F_P + (R0 + 4 * l4) * NP + C_MV + hh * 256 + c8 * 8;
        const bf16x8 r0 = *(const bf16x8*)(src), r1 = *(const bf16x8*)(src + NP), r2 = *(const bf16x8*)(src + 2 * NP), r3 = *(const bf16x8*)(src + 3 * NP);
#pragma unroll
        for (int i = 0; i < 8; ++i) { u32x2 w; w.x = (unsigned)(unsigned short)r0[i] | ((unsigned)(unsigned short)r1[i] << 16); w.y = (unsigned)(unsigned short)r2[i] | ((unsigned)(unsigned short)r3[i] << 16);
            *(u32x2*)(VT + (c8 * 8 + i) * VS + 4 * l4) = w; } }
}
__device__ __forceinline__ void mls_cloc_unit(Fr& F, int cidx, int hh, int d, int l) {
    bf16_t* VT = (bf16_t*)(F.lds + LDS_VT); bf16_t* KT = (bf16_t*)(F.lds + LDS_KT); float* fs = (float*)(F.lds + LDS_FS);
    const int tid = F.tid, lane = F.lane, w = F.wave, fr = lane & 15, fq = lane >> 4;
    const size_t R0 = (size_t)cidx * 128; int b, slot; chunk_bs(cidx, b, slot); const int uidx = unit_idx(b, hh, d, slot);
    if (tid < 128) { const float* gb = F.ap->in[I_GATEB] + l * 16; const bf16_t* prow = F_P + (R0 + tid) * NP;
        const float xx = bf2f(prow[C_GF + d * 4 + hh]) + gb[d * 8 + 4 + hh];
        fs[tid] = fminf(xx, 0.f) - __logf(1.f + __expf(-fabsf(xx))); fs[128 + tid] = bf2f(prow[C_GI + d * 4 + hh]) + gb[d * 8 + hh]; }
    __syncthreads();
    float wend = 0.f, gtot = 0.f;
    {
        float lfv = tid < 128 ? fs[tid] : 0.f, p = lfv;
#pragma unroll
        for (int o = 1; o < 64; o <<= 1) { const float t = __shfl_up(p, o); if (lane >= o) p += t; }
        if (tid < 128 && lane == 63) fs[512 + w] = p;
        __syncthreads();
        const float tot0 = fs[512], tot1 = fs[513]; gtot = tot0 + tot1;
        const float bf_ = p + (w == 1 ? tot0 : 0.f);
        const float bsum = d == 0 ? bf_ : gtot - bf_ + lfv;
        wend = tid < 128 ? gtot - bsum + fs[128 + tid] : -3.0e38f;
        float mx = wend;
#pragma unroll
        for (int o = 1; o < 64; o <<= 1) mx = fmaxf(mx, __shfl_xor(mx, o));
        if (tid < 128 && lane == 0) fs[514 + w] = mx;
        __syncthreads();
        const float m = fmaxf(fs[514], fs[515]);
        if (tid < 128) { fs[384 + tid] = __expf(wend - m) * QK_SCALE;
            if (tid == 0) { F_GT[uidx] = gtot; F_MLOC[uidx] = m; } }
    }
    stage_vt(F, VT, R0, hh);
    __syncthreads();
    { const int l4 = tid & 31, c8 = tid >> 5;
        const bf16_t* src = F_P + (R0 + 4 * l4) * NP + C_MK + hh * 128 + c8 * 8;
        const bf16x8 r0 = *(const bf16x8*)(src), r1 = *(const bf16x8*)(src + NP), r2 = *(const bf16x8*)(src + 2 * NP), r3 = *(const bf16x8*)(src + 3 * NP);
        const float e0 = fs[384 + 4 * l4], e1 = fs[385 + 4 * l4], e2 = fs[386 + 4 * l4], e3 = fs[387 + 4 * l4];
#pragma unroll
        for (int i = 0; i < 8; ++i) { u32x2 w; w.x = pk2(bfs2f(r0[i]) * e0, bfs2f(r1[i]) * e1); w.y = pk2(bfs2f(r2[i]) * e2, bfs2f(r3[i]) * e3);
            *(u32x2*)(KT + (c8 * 8 + i) * VS + 4 * l4) = w; } }
    __syncthreads();
    f32x4 acc[2][8];
#pragma unroll
    for (int vi = 0; vi < 2; ++vi)
#pragma unroll
        for (int kb = 0; kb < 8; ++kb) acc[vi][kb] = (f32x4){0.f, 0.f, 0.f, 0.f};
#pragma unroll
    for (int lb = 0; lb < 4; ++lb) {
        bf16x8 xf[2];
#pragma unroll
        for (int vi = 0; vi < 2; ++vi) xf[vi] = *(const bf16x8*)(VT + (32 * w + 16 * vi + fr) * VS + lb * 32 + 8 * fq);
#pragma unroll
        for (int kb = 0; kb < 8; ++kb) { const bf16x8 yf = *(const bf16x8*)(KT + (16 * kb + fr) * VS + lb * 32 + 8 * fq);
#pragma unroll
            for (int vi = 0; vi < 2; ++vi) acc[vi][kb] = __builtin_amdgcn_mfma_f32_16x16x32_bf16(yf, xf[vi], acc[vi][kb], 0, 0, 0); }
    }
    bf16_t* Cst = F_CST + (size_t)uidx * 32768;
    __syncthreads();
#pragma unroll
    for (int vi = 0; vi < 2; ++vi)
#pragma unroll
        for (int kb = 0; kb < 8; ++kb)
        { u32x2 pk; pk.x = pk2(acc[vi][kb][0], acc[vi][kb][1]); pk.y = pk2(acc[vi][kb][2], acc[vi][kb][3]); *(u32x2*)(VT + (32 * w + 16 * vi + fr) * VS + 16 * kb + 4 * fq) = pk; }
    __syncthreads();
#pragma unroll
    for (int i = 0; i < 8; ++i) { const int idx = tid + 512 * i; *(u32x4*)(Cst + (idx >> 4) * 128 + (idx & 15) * 8) = *(const u32x4*)(VT + (idx >> 4) * VS + (idx & 15) * 8); }
    { const int k = tid >> 2, part = tid & 3; float sacc = 0.f;
#pragma unroll
        for (int q = 0; q < 4; ++q) { const bf16x8 t8 = *(const bf16x8*)(KT + k * VS + part * 32 + q * 8);
#pragma unroll
            for (int i = 0; i < 8; ++i) sacc += bfs2f(t8[i]); }
        sacc += __shfl_xor(sacc, 1); sacc += __shfl_xor(sacc, 2);
        if (part == 0) F_NST[(size_t)uidx * 128 + k] = sacc; }
    __syncthreads();
}
__device__ __forceinline__ int scan_slot(int d, int step) { return d == 0 ? step : (step == 0 ? 1 : (step == 1 ? 0 : 35 - step)); }
__device__ __forceinline__ void phase_scan(Fr& F, const bool dost = true) {
    const long nth = (long)F.G * 512;
    for (long gid = (long)F.bx * 512 + F.tid; gid < 32 * 4096; gid += nth) {
        const int seq = (int)(gid >> 12), vec = (int)(gid & 4095), d = seq & 1;
        bf16_t* base = F_CST + (size_t)seq * NSLOT * 32768 + vec * 8;
        float* nbase = F_NST + (size_t)seq * NSLOT * 128 + (vec & 15) * 8;
        const bool hasn = vec < 16;
        float z0 = 0.f; asm volatile("" : "+v"(z0));
        float st[8] = {z0, z0, z0, z0, z0, z0, z0, z0}, sn[8] = {z0, z0, z0, z0, z0, z0, z0, z0}; float m = 0.f;
        int slot = scan_slot(d, 0), slot1 = scan_slot(d, 1);
        bf16x8 cl = *(const bf16x8*)(base + (size_t)slot * 32768), cl1 = *(const bf16x8*)(base + (size_t)slot1 * 32768);
        f32x4 n0 = {0.f, 0.f, 0.f, 0.f}, n1 = {0.f, 0.f, 0.f, 0.f}, p0 = n0, p1 = n0;
        if (hasn) { n0 = *(const f32x4*)(nbase + slot * 128); n1 = *(const f32x4*)(nbase + slot * 128 + 4); p0 = *(const f32x4*)(nbase + slot1 * 128); p1 = *(const f32x4*)(nbase + slot1 * 128 + 4); }
        float g = F_GT[seq * NSLOT + slot], mc = F_MLOC[seq * NSLOT + slot], g1 = F_GT[seq * NSLOT + slot1], mc1 = F_MLOC[seq * NSLOT + slot1];
#pragma unroll 1
        for (int step = 0; step < NSLOT; ++step) {
            const int slot2 = scan_slot(d, step + 2 < NSLOT ? step + 2 : NSLOT - 1);
            const bool ld2 = step + 2 < NSLOT;
            bf16x8 cl2 = cl1; f32x4 q0 = p0, q1 = p1; float g2 = g1, mc2 = mc1;
            if (ld2) { cl2 = *(const bf16x8*)(base + (size_t)slot2 * 32768);
                if (hasn) { q0 = *(const f32x4*)(nbase + slot2 * 128); q1 = *(const f32x4*)(nbase + slot2 * 128 + 4); }
                g2 = F_GT[seq * NSLOT + slot2]; mc2 = F_MLOC[seq * NSLOT + slot2]; }
            asm volatile("" ::: "memory");
            if (dost) { u32x4 o; o.x = pk2(st[0], st[1]); o.y = pk2(st[2], st[3]); o.z = pk2(st[4], st[5]); o.w = pk2(st[6], st[7]);
                *(u32x4*)(base + (size_t)slot * 32768) = o;
                if (hasn) { *(f32x4*)(nbase + slot * 128) = (f32x4){sn[0], sn[1], sn[2], sn[3]}; *(f32x4*)(nbase + slot * 128 + 4) = (f32x4){sn[4], sn[5], sn[6], sn[7]}; } }
            if (vec == 0) F_MIN[seq * NSLOT + slot] = m;
            const float mn = fmaxf(g + m, mc), a = __expf(g + m - mn), s = __expf(mc - mn);
#pragma unroll
            for (int i = 0; i < 8; ++i) st[i] = a * st[i] + s * bfs2f(cl[i]);
#pragma unroll
            for (int i = 0; i < 4; ++i) { sn[i] = a * sn[i] + s * n0[i]; sn[4 + i] = a * sn[4 + i] + s * n1[i]; }
            m = mn; cl = cl1; n0 = p0; n1 = p1; g = g1; mc = mc1; slot = slot1;
            cl1 = cl2; p0 = q0; p1 = q1; g1 = g2; mc1 = mc2; slot1 = slot2; }
    }
}
__device__ __forceinline__ void mls_out_unit(Fr& F, int cidx, int hh, int l, const bool dost = true) {
    bf16_t* VT = (bf16_t*)(F.lds + LDS_VT); bf16_t* Kc = (bf16_t*)(F.lds + LDS_KT); float* fs = (float*)(F.lds + LDS_FS);
    float* lf_s = fs; float* li_s = fs + 256; float* csrc = fs + 512; float* mm = fs + 768; float* bj = fs + 1024;
    bf16_t* Ch = (bf16_t*)(F.lds + LDS_CH);
    const int tid = F.tid, lane = F.lane, w = F.wave, fr = lane & 15, fq = lane >> 4;
    const size_t R0 = (size_t)cidx * 128; int b, slot; chunk_bs(cidx, b, slot);
    if (tid < 256) { const int dd = tid >> 7, t = tid & 127; lf_s[tid] = F_LF[(R0 + t) * 8 + dd * 4 + hh]; li_s[tid] = F_LI[(R0 + t) * 8 + dd * 4 + hh]; }
    stage_vt(F, VT, R0, hh);
    for (int idx = tid; idx < 2048; idx += 512) { const int l2 = idx >> 4, c8 = idx & 15;
        *(bf16x8*)(Kc + l2 * VS + c8 * 8) = *(const bf16x8*)(F_P + (R0 + l2) * NP + C_MK + hh * 128 + c8 * 8); }
    __syncthreads();
    {
        float* tmp = (float*)(F.lds + LDS_CH);
        const bool act = tid < 256; const int dd = (tid >> 7) & 1, wp = w & 1;
        const float lfv = act ? lf_s[tid] : 0.f; float p = lfv;
#pragma unroll
        for (int o = 1; o < 64; o <<= 1) { const float t = __shfl_up(p, o); if (lane >= o) p += t; }
        if (act && lane == 63) tmp[w] = p;
        __syncthreads();
        const float t0 = tmp[2 * dd], t1 = tmp[2 * dd + 1], gt_ = t0 + t1;
        const float bfwd = p + (wp ? t0 : 0.f);
        const float bsum = dd == 0 ? bfwd : gt_ - bfwd + lfv;
        const float cs = act ? li_s[tid] - bsum : -3.0e38f;
        float pmx = cs, smx = cs;
#pragma unroll
        for (int o = 1; o < 64; o <<= 1) { const float a = __shfl_up(pmx, o), c = __shfl_down(smx, o); if (lane >= o) pmx = fmaxf(pmx, a); if (lane + o < 64) smx = fmaxf(smx, c); }
        if (act && lane == 63) tmp[4 + w] = pmx;
        __syncthreads();
        if (act) { const float other = tmp[4 + (w ^ 1)];
            float cm = dd == 0 ? (wp ? fmaxf(pmx, other) : pmx) : (wp ? smx : fmaxf(smx, other));
            cm = fmaxf(cm, F_MIN[unit_idx(b, hh, dd, slot)]);
            bj[tid] = bsum; csrc[tid] = cs; mm[tid] = cm; }
    }
    __syncthreads();
    const int j = 16 * w + fr;
    const bf16_t* prow = F_P + (R0 + j) * NP;
    f32x4 acc[16];
#pragma unroll
    for (int vb = 0; vb < 16; ++vb) acc[vb] = (f32x4){0.f, 0.f, 0.f, 0.f};
#pragma unroll 1
    for (int dd = 0; dd < 2; ++dd) {
        int jj = j; asm volatile("" : "+v"(jj));
        bf16x8 Yq[4];
#pragma unroll
        for (int kb = 0; kb < 4; ++kb) Yq[kb] = *(const bf16x8*)(F_P + (R0 + jj) * NP + C_MQ + hh * 128 + kb * 32 + 8 * fq);
        const int sgn = dd == 0 ? 1 : -1; const int bs = (4 * fq - jj) * sgn;
        const int uidx = unit_idx(b, hh, dd, slot);
        const bf16_t* Cin = F_CST + (size_t)uidx * 32768;
        const float m_in = F_MIN[uidx], mmj = mm[dd * 128 + j], bjj = bj[dd * 128 + j];
        f32x4 Sa[8];
#pragma unroll
        for (int sb = 0; sb < 8; ++sb) { Sa[sb] = (f32x4){0.f, 0.f, 0.f, 0.f};
#pragma unroll
            for (int kb = 0; kb < 4; ++kb) { const bf16x8 kf = *(const bf16x8*)(Kc + (16 * sb + fr) * VS + kb * 32 + 8 * fq);
                Sa[sb] = __builtin_amdgcn_mfma_f32_16x16x32_bf16(kf, Yq[kb], Sa[sb], 0, 0, 0); }
            __builtin_amdgcn_sched_barrier(0); }
        float dsum = 0.f;
#pragma unroll
        for (int sb = 0; sb < 8; ++sb)
#pragma unroll
            for (int e = 0; e < 4; ++e) { const int s = 16 * sb + 4 * fq + e; const bool valid = (bs + sgn * (16 * sb + e)) <= 0;
                const float wv = valid ? __expf(csrc[dd * 128 + s] - mmj) * Sa[sb][e] * QK_SCALE : 0.f; Sa[sb][e] = wv; dsum += wv; }
        dsum += __shfl_xor(dsum, 16); dsum += __shfl_xor(dsum, 32);
        float nq = 0.f; const float* nst = F_NST + (size_t)uidx * 128;
#pragma unroll
        for (int kb = 0; kb < 4; ++kb) { const f32x4 n0 = *(const f32x4*)(nst + kb * 32 + 8 * fq), n1 = *(const f32x4*)(nst + kb * 32 + 8 * fq + 4);
            nq += bfs2f(Yq[kb][0]) * n0[0] + bfs2f(Yq[kb][1]) * n0[1] + bfs2f(Yq[kb][2]) * n0[2] + bfs2f(Yq[kb][3]) * n0[3]
                + bfs2f(Yq[kb][4]) * n1[0] + bfs2f(Yq[kb][5]) * n1[1] + bfs2f(Yq[kb][6]) * n1[2] + bfs2f(Yq[kb][7]) * n1[3]; }
        nq += __shfl_xor(nq, 16); nq += __shfl_xor(nq, 32);
        const float inter = __expf(m_in - mmj);
        const float den = dsum + inter * nq;
        const float rden = 1.f / fmaxf(fabsf(den), __expf(-(bjj + mmj)));
        bf16x8 Wf[4], Yqs[4]; const float qsc = inter * rden;
#pragma unroll
        for (int kb = 0; kb < 4; ++kb) {
            u32x4 t; t.x = pk2(Sa[2 * kb][0] * rden, Sa[2 * kb][1] * rden); t.y = pk2(Sa[2 * kb][2] * rden, Sa[2 * kb][3] * rden);
            t.z = pk2(Sa[2 * kb + 1][0] * rden, Sa[2 * kb + 1][1] * rden); t.w = pk2(Sa[2 * kb + 1][2] * rden, Sa[2 * kb + 1][3] * rden);
            Wf[kb] = *reinterpret_cast<bf16x8*>(&t);
            u32x4 q; q.x = pk2(bfs2f(Yq[kb][0]) * qsc, bfs2f(Yq[kb][1]) * qsc); q.y = pk2(bfs2f(Yq[kb][2]) * qsc, bfs2f(Yq[kb][3]) * qsc);
            q.z = pk2(bfs2f(Yq[kb][4]) * qsc, bfs2f(Yq[kb][5]) * qsc); q.w = pk2(bfs2f(Yq[kb][6]) * qsc, bfs2f(Yq[kb][7]) * qsc);
            Yqs[kb] = *reinterpret_cast<bf16x8*>(&q); }
        bf16x8 pr[4];
#pragma unroll
        for (int i = 0; i < 4; ++i) { const int idx = tid + 512 * i; pr[i] = *(const bf16x8*)(Cin + (idx >> 4) * 128 + (idx & 15) * 8); }
#pragma unroll
        for (int h = 0; h < 2; ++h) {
            __syncthreads();
#pragma unroll
            for (int i = 0; i < 4; ++i) { const int idx = tid + 512 * i; *(bf16x8*)(Ch + (idx >> 4) * VS + (idx & 15) * 8) = pr[i]; }
            if (h == 0) {
#pragma unroll
                for (int i = 0; i < 4; ++i) { const int idx = tid + 512 * i; pr[i] = *(const bf16x8*)(Cin + (128 + (idx >> 4)) * 128 + (idx & 15) * 8); } }
            __syncthreads();
#pragma unroll
            for (int v8 = 0; v8 < 8; ++v8) { const int vb = 8 * h + v8;
#pragma unroll
                for (int kb = 0; kb < 4; ++kb) { const bf16x8 cf = *(const bf16x8*)(Ch + (16 * v8 + fr) * VS + kb * 32 + 8 * fq);
                    acc[vb] = __builtin_amdgcn_mfma_f32_16x16x32_bf16(cf, Yqs[kb], acc[vb], 0, 0, 0); }
#pragma unroll
                for (int kb = 0; kb < 4; ++kb) {
                    const u32x2 lo = *(const u32x2*)(VT + (16 * vb + fr) * VS + 32 * kb + 4 * fq), hi2 = *(const u32x2*)(VT + (16 * vb + fr) * VS + 32 * kb + 16 + 4 * fq);
                    u32x4 t; t.x = lo.x; t.y = lo.y; t.z = hi2.x; t.w = hi2.y;
                    acc[vb] = __builtin_amdgcn_mfma_f32_16x16x32_bf16(*reinterpret_cast<bf16x8*>(&t), Wf[kb], acc[vb], 0, 0, 0); }
                __builtin_amdgcn_sched_barrier(0);
            }
        }
    }
    float ss = 0.f;
#pragma unroll
    for (int vb = 0; vb < 16; ++vb) ss += (acc[vb][0] * acc[vb][0] + acc[vb][1] * acc[vb][1]) + (acc[vb][2] * acc[vb][2] + acc[vb][3] * acc[vb][3]);
    ss += __shfl_xor(ss, 16); ss += __shfl_xor(ss, 32);
    const float rinv = 1.f / sqrtf(ss * (1.f / 256.f) + EPS);
    const float* hg = F.ap->in[I_MLHG] + l * 1024 + hh * 256;
    bf16_t* orow = F_P + (R0 + j) * NP + C_O + hh * 256;
#pragma unroll
    for (int vb = 0; vb < 16; ++vb) { const int v0 = 16 * vb + 4 * fq;
        const u32x2 oraw = *(const u32x2*)(orow + v0); const f32x4 g4 = *(const f32x4*)(hg + v0);
        const float o0 = __uint_as_float(oraw.x << 16), o1 = __uint_as_float(oraw.x & 0xffff0000u), o2 = __uint_as_float(oraw.y << 16), o3 = __uint_as_float(oraw.y & 0xffff0000u);
        u32x2 wv; wv.x = pk2(acc[vb][0] * rinv * g4[0] * sigmoidf_(o0), acc[vb][1] * rinv * g4[1] * sigmoidf_(o1));
        wv.y = pk2(acc[vb][2] * rinv * g4[2] * sigmoidf_(o2), acc[vb][3] * rinv * g4[3] * sigmoidf_(o3));
        if (dost) *(u32x2*)(orow + v0) = wv; }
    __syncthreads();
}

#ifndef PHM
#define PHM 0xFFFF
#endif
#ifndef DUPM
#define DUPM 0
#endif
#define DOST (rep_ == ((DUPM >> RB_) & 1))
#define REP(bit) for (int rep_ = 0, RB_ = (bit); rep_ < ((DUPM >> (bit)) & 1) + 1; ++rep_)
#define GSYNC() do { ArgsP sa_ = (ArgsP)__builtin_amdgcn_kernarg_segment_ptr(); asm volatile("" : "+s"(sa_)); \
    XcdBarrier xb_; xb_.bar = (unsigned*)sa_->ws; xb_.x = xb_xcc_id(); xb_.st = misc; xcd_barrier(xb_); if (DUPM & 0x8000) xcd_barrier(xb_); } while (0)
__global__ void __launch_bounds__(512, 2) fwd_megakernel(Args args) {
    extern __shared__ __attribute__((aligned(16))) unsigned char lds_raw[];
    cg::grid_group grid = cg::this_grid();
    Fr F;
    F.lds = (char*)lds_raw; F.tid = threadIdx.x; F.lane = F.tid & 63; F.wave = __builtin_amdgcn_readfirstlane(F.tid >> 6);
    F.G = gridDim.x; F.bx = blockIdx.x; { const int bx = blockIdx.x; F.vcu = (F.G % 8 == 0) ? (bx % 8) * (F.G / 8) + bx / 8 : bx; }
    F.gw = F.bx * 8 + F.wave; F.NGW = F.G * 8;
    F.ap = (ArgsP)__builtin_amdgcn_kernarg_segment_ptr();
    LAS unsigned char* lds3 = (LAS unsigned char*)lds_raw;
#define PHB() do { int t_ = threadIdx.x; asm volatile("" : "+v"(t_)); F.tid = t_; F.lane = t_ & 63; F.wave = __builtin_amdgcn_readfirstlane(t_ >> 6); \
    ArgsP a_ = (ArgsP)__builtin_amdgcn_kernarg_segment_ptr(); asm volatile("" : "+s"(a_)); F.ap = a_; \
    unsigned lo_ = 0u; asm volatile("" : "+s"(lo_)); F.lds3 = lds3 + lo_; F.lds = (char*)F.lds3; \
    int bx_ = blockIdx.x, g_ = gridDim.x; asm volatile("" : "+s"(bx_), "+s"(g_)); F.bx = bx_; F.G = g_; F.vcu = (g_ % 8 == 0) ? (bx_ % 8) * (g_ / 8) + bx_ / 8 : bx_; F.gw = bx_ * 8 + F.wave; F.NGW = g_ * 8; } while (0)

#if PHM & (1<<0)
    volatile LAS unsigned* misc = (volatile LAS unsigned*)(lds3 + LDS_BYTES - 256);
    if (threadIdx.x < 2) misc[threadIdx.x] = 0u;
    if (blockIdx.x == 0) { unsigned* bw = (unsigned*)WSB; for (int i = threadIdx.x; i < XCD_BAR_WORDS; i += 512) __hip_atomic_store(bw + i, 0u, __ATOMIC_RELAXED, __HIP_MEMORY_SCOPE_AGENT); }
    __syncthreads();
    REP(0) { PHB();
    mod_gemv(F);
    convert_weights(F, 0); }
#endif
    __threadfence(); grid.sync();
    (void)xcd_barrier_post((unsigned*)WSB, misc);
#if PHM & (1<<1)
    REP(1) { PHB();
    phase_norm1(F, 0, F.ap->in[I_X], F.ap->in[I_CTX]); }
#endif
    GSYNC();

    for (int l = 0; l < 2; ++l) {
        const bool last = (l == 1);
        const int nMall = last ? 64 : 68;
#if PHM & (1<<2)
        PHB();
        REP(2)
        { PHB(); pg8::Gemm g{F_H, F_H, F_H, (const bf16_t*)(WSB + WS_WIN), (const bf16_t*)(WSB + WS_WIN), (const bf16_t*)(WSB + WS_WIN), D, D, 0};
          pg8::Sched S; if (!last) S.init(68, 47, 1, F.G, F.bx); else S.init(64, 47, 1, F.G, F.bx, 64, 4, 9);
          pg8::EpiWin E{F_P, (unsigned char*)(WSB + WS_G8)};
          pg8::gemm_phase<pg8::EpiWin>(F.lds3, g, S, E, F.tid); }
#endif
        GSYNC();
#if PHM & (1<<3)
        REP(3) { PHB();
        phase_prep(F, l, DOST); }
#endif
        __syncthreads();
#if PHM & (1<<5)
        REP(5) { PHB();
        for (int u = F.G - 1 - F.bx; u < 136 * 8; u += F.G) { const int cidx = u >> 3, hh = (u >> 1) & 3, d = u & 1; mls_cloc_unit(F, cidx, hh, d, l); } }
#endif
        GSYNC();
#if PHM & (1<<4)
        REP(4)
        { PHB(); const bf16_t* wp = (const bf16_t*)(WSB + WS_WPL);
          pg8::Gemm g{F_MIX, F_MIX, F_MIX, wp, wp, wp, 1024, 256, 512};
          pg8::Sched S; S.init(nMall, 4, 1, F.G, F.G - 1 - F.bx);
          pg8::EpiBf16 E{F_P + C_PL, NP};
          pg8::gemm_phase<pg8::EpiBf16>(F.lds3, g, S, E, F.tid); }
#endif
        __syncthreads();
#if PHM & (1<<6)
        REP(6) { PHB();
        phase_scan(F, DOST); }
#endif
        GSYNC();
        { const int nchunk = last ? 128 : 136;
#if PHM & (1<<7)
          REP(7) { PHB();
          for (int u = F.bx; u < nchunk * 4; u += F.G) mls_out_unit(F, u >> 2, u & 3, l, DOST); }
#endif
#if PHM & (1<<8)
          REP(8) { PHB();
          const int nun = last ? 512 : 544;
          for (int u = F.vcu; u < nun; u += F.G) {
              if (u < 512) { const int qb = u & 15, hq = (u >> 4) & 3, kvh = (u >> 6) & 1, b = u >> 7, h = kvh * 4 + hq;
                  const size_t rq = (size_t)b * SEQ + qb * 256, rk = (size_t)b * SEQ, rc = (size_t)ML + b * CTXL;
                  att::attn_dense_body(F_P + rq * NP + C_AQ + h * 128, F_P + rk * NP + C_AK + kvh * 128,
                                       F_P + rc * NP + C_AK + kvh * 128, 64, F_P + rq * NP + C_AQ + h * 128, 68, F.lds, F.tid, DOST);
              } else { const int v = u - 512, b = v >> 3, h = v & 7, kvh = h >> 2; const size_t rc = (size_t)ML + b * CTXL;
                  att::attn_dense_body(F_P + rc * NP + C_AQ + h * 128, F_P + rc * NP + C_AK + kvh * 128,
                                       F_P + rc * NP + C_AK + kvh * 128, 4, F_P + rc * NP + C_AQ + h * 128, 4, F.lds, F.tid, DOST); }
          } }
#endif
        }
        GSYNC();
#if PHM & (1<<9)
        PHB();
        REP(9)
        { PHB(); const bf16_t* wu = (const bf16_t*)(WSB + WS_WUP);
          pg8::Gemm g{F_P + C_AQ, F_P + C_O, F_P + C_PL, wu, wu + (size_t)D * 1024, wu + (size_t)2 * D * 1024, NP, 1024, 0};
          pg8::Sched S; S.init(nMall, 8, 3, F.G, F.bx);
          pg8::EpiGate E{(const unsigned char*)(WSB + WS_G8), F_H};
          pg8::gemm_phase<pg8::EpiGate>(F.lds3, g, S, E, F.tid); }
#endif
        GSYNC();
#if PHM & (1<<10)
        PHB();
        REP(10)
        { PHB(); const bf16_t* wo = (const bf16_t*)(WSB + WS_WOUT);
          pg8::Gemm g{F_H, F_H, F_H, wo, wo, wo, D, D, 0};
          pg8::Sched S; S.init(nMall, 8, 1, F.G, F.bx);
          pg8::EpiBf16 E{(bf16_t*)(WSB + WS_YO), D};
          pg8::gemm_phase<pg8::EpiBf16>(F.lds3, g, S, E, F.tid); }
#endif
        GSYNC();
#if PHM & (1<<11)
        REP(11) { PHB();
        phase_resid(F, l, 0, nMall * 256, F.ap->in[I_X], l == 0 ? F.ap->in[I_CTX] : F_XC, false, l != 0, true, DOST); }
#endif
        GSYNC();
#if PHM & (1<<12)
        PHB();
        REP(12)
        { PHB(); const bf16_t* wf = (const bf16_t*)(WSB + WS_WFI);
          pg8::Gemm g{F_H, F_H, F_H, wf, wf, wf, D, D, 0};
          pg8::Sched S; S.init(nMall, 44, 1, F.G, F.bx);
          pg8::EpiSwiglu E{(bf16_t*)(WSB + WS_HID)};
          pg8::gemm_phase<pg8::EpiSwiglu>(F.lds3, g, S, E, F.tid); }
#endif
        GSYNC();
#if PHM & (1<<13)
        PHB();
        REP(13)
        { PHB(); const bf16_t* wf = (const bf16_t*)(WSB + WS_WFO); const bf16_t* hid = (const bf16_t*)(WSB + WS_HID);
          pg8::Gemm g{hid, hid, hid, wf, wf, wf, DFF, DFF, 0};
          pg8::Sched S; S.init(nMall, 8, 1, F.G, F.bx);
          pg8::EpiBf16 E{(bf16_t*)(WSB + WS_YO), D};
          pg8::gemm_phase<pg8::EpiBf16>(F.lds3, g, S, E, F.tid); }
#endif
        GSYNC();
#if PHM & (1<<14)
        REP(14) { PHB();
        phase_resid(F, l, 1, nMall * 256, F.ap->in[I_X], F_XC, !last, true, !last, DOST);
        if (!last) { __syncthreads(); convert_weights(F, 1); } }
#endif
        GSYNC();
    }
}

extern "C" void kernel_launch(void* const* d_in, const int* in_sizes, int n_in, void* d_out, int out_size, void* d_ws, size_t ws_size, hipStream_t stream) {
    static int grid = 0;
    if (grid == 0) {
        if (n_in != 19 || out_size != ML * D || ws_size < WS_END) { fprintf(stderr, "kernel_launch: unexpected shapes n_in %d out %d ws %zu (need %zu)\n", n_in, out_size, ws_size, (size_t)WS_END); grid = -1; return; }
        int dev = 0, cus = 0, per_cu = 0;
        hipGetDevice(&dev); hipDeviceGetAttribute(&cus, hipDeviceAttributeMultiprocessorCount, dev);
        if (hipFuncSetAttribute((const void*)fwd_megakernel, hipFuncAttributeMaxDynamicSharedMemorySize, LDS_BYTES) != hipSuccess) { fprintf(stderr, "kernel_launch: hipFuncSetAttribute failed\n"); grid = -1; return; }
        if (hipOccupancyMaxActiveBlocksPerMultiprocessor(&per_cu, (const void*)fwd_megakernel, 512, LDS_BYTES) != hipSuccess || per_cu < 1) { fprintf(stderr, "kernel_launch: occupancy query gave %d\n", per_cu); per_cu = 1; }
        (void)hipGetLastError();
        grid = cus * 1;
        fprintf(stderr, "kernel_launch: cus %d per_cu %d grid %d\n", cus, per_cu, grid);
    }
    if (grid < 0) return;
    Args a{};
    for (int i = 0; i < 19; ++i) a.in[i] = (const float*)d_in[i];
    a.out = (float*)d_out; a.ws = (unsigned char*)d_ws;
    void* kargs[] = {&a};
    hipError_t e = hipLaunchCooperativeKernel((const void*)fwd_megakernel, dim3(grid), dim3(512), kargs, LDS_BYTES, stream);
    if (e != hipSuccess) fprintf(stderr, "cooperative launch failed: %s (grid %d)\n", hipGetErrorString(e), grid);
}
```

```cpp
#include <hip/hip_runtime.h>
#include <hip/hip_cooperative_groups.h>
#include <cstdio>
#include <cstdint>
namespace cg = cooperative_groups;

#define LAS __attribute__((address_space(3)))
typedef unsigned short bf16_t;
typedef short bf16x8 __attribute__((ext_vector_type(8)));
typedef short s16x4 __attribute__((ext_vector_type(4)));
typedef float f32x4 __attribute__((ext_vector_type(4)));
typedef float f32x16 __attribute__((ext_vector_type(16)));
typedef unsigned u32x4 __attribute__((ext_vector_type(4)));
typedef unsigned u32x2 __attribute__((ext_vector_type(2)));

constexpr int D = 2048, NB = 4, SEQ = 4096, CTXL = 256;
constexpr int ML = NB * SEQ, MC = NB * CTXL, MT = ML + MC;
constexpr int DIN = 11792, NP = 5888, NWIN = 12032, NG = 6144, DFF = 5632;
constexpr int C_AK = 0, C_AV = 256, C_MK = 512, C_MV = 1024, C_GI = 2048, C_GF = 2056, C_AQ = 2064, C_MQ = 3088, C_O = 3600, C_PL = 4624, C_GRAW = 5648;
constexpr float EPS = 1e-6f;
constexpr int NSLOT = 34, NUNIT = NB * 4 * 2 * NSLOT;
constexpr float QK_SCALE = 0.08838834764831845f;

constexpr size_t MiB = 1u << 20;
constexpr size_t WS_MOD = 1 * MiB;
constexpr size_t WS_LI = 2 * MiB;
constexpr size_t WS_LF = 3 * MiB;
constexpr size_t WS_GT = 4 * MiB;
constexpr size_t WS_NST = 5 * MiB;
constexpr size_t WS_WIN = 6 * MiB;
constexpr size_t WS_WFI = 54 * MiB;
constexpr size_t WS_WFO = 98 * MiB;
constexpr size_t WS_WUP = 120 * MiB;
constexpr size_t WS_WOUT = 132 * MiB;
constexpr size_t WS_WPL = 140 * MiB;
constexpr size_t WS_XC = 141 * MiB;
constexpr size_t WS_H = 149 * MiB;
constexpr size_t WS_P = 217 * MiB;
constexpr size_t WS_MIX = 617 * MiB;
constexpr size_t WS_CST = 651 * MiB;
constexpr size_t WS_XB = 719 * MiB;
constexpr size_t WS_END = 783 * MiB;
constexpr size_t WS_YO = WS_P;
constexpr size_t WS_G8 = WS_P + 196 * MiB;
constexpr size_t WS_HID = WS_P + 160 * MiB;

constexpr int LDS_BYTES = 147456;

__device__ __forceinline__ float bf2f(bf16_t v) { return __uint_as_float((unsigned)v << 16); }
__device__ __forceinline__ float bfs2f(short v) { return __uint_as_float(((unsigned)(unsigned short)v) << 16); }
typedef float f32x2_t __attribute__((ext_vector_type(2))); typedef __bf16 bf16x2_t __attribute__((ext_vector_type(2)));
__device__ __forceinline__ unsigned pk2(float lo, float hi) { const f32x2_t v = {lo, hi}; const bf16x2_t b = __builtin_convertvector(v, bf16x2_t); return __builtin_bit_cast(unsigned, b); }
__device__ __forceinline__ unsigned f2bf(float f) { return pk2(f, 0.f) & 0xffffu; }
__device__ __forceinline__ float wave_sum(float v) {
#pragma unroll
    for (int o = 1; o < 64; o <<= 1) v += __shfl_xor(v, o);
    return v;
}
__device__ __forceinline__ float sigmoidf_(float x) { return __builtin_amdgcn_rcpf(1.f + __expf(-x)); }

struct Args { const float* in[19]; float* out; unsigned char* ws; };
enum { I_X = 0, I_C, I_CTX, I_CCTX, I_WMOD, I_BMOD, I_NORMG, I_WIN, I_GATEB, I_QKG, I_MLHG, I_POOLW, I_POOLS, I_UPA, I_UPM, I_UPP, I_WOUT, I_FFI, I_FFO };

namespace pg8 {
constexpr int BM = 256, BK = 64, HALF = 128, HTB = HALF * BK * 2, STAGE_BYTES = 8 * HTB, NXCD = 8, WGM = 8;
__host__ __device__ __forceinline__ int lds_byte(int r, int c) { const int st = (r >> 4) * 2 + (c >> 5), rr = r & 15, cc = c & 31, ob = rr * 64 + cc * 2; return st * 1024 + (ob ^ (((ob >> 9) & 1) << 5)); }
__host__ __device__ __forceinline__ void stage_rc(int b, int& R, int& C) { const int st = b / 1024, sb = b % 1024, swz = sb ^ (((sb >> 9) & 1) << 5); R = (st >> 1) * 16 + swz / 64; C = (st & 1) * 32 + (swz % 64) / 2; }
__host__ __device__ __forceinline__ int perm32(int rho) { const int n = rho >> 4, i = rho & 15; return 8 * (i >> 2) + 4 * n + (i & 3); }

struct Unit { int pm, pn, br; };
struct Gemm { const bf16_t* A0; const bf16_t* A1; const bf16_t* A2; const bf16_t* B0; const bf16_t* B1; const bf16_t* B2; int lda; int K; int apn; };

struct Sched {
    int nM, nN, nBr, G, c, nT1, pm2, nM2, nT;
    __device__ void init(int nM_, int nN_, int nBr_, int G_, int c_, int pm2_ = 0, int nM2_ = 0, int nN2_ = 0) {
        nM = nM_; nN = nN_; nBr = nBr_; G = G_; c = c_; nT1 = nM * nN; pm2 = pm2_; nM2 = nM2_; nT = nT1 + nM2_ * nN2_; }
    __device__ bool next(int i, Unit& u) const {
        const int it = i / nBr; u.br = i - it * nBr;
        const long L = (long)it * G + c; if (L >= nT) return false;
        if (L < nT1) {
            int wgid = (int)L; { const int q = nT1 / NXCD, r = nT1 % NXCD, xcd = wgid % NXCD, off = wgid / NXCD; wgid = (xcd < r ? xcd * (q + 1) : r * (q + 1) + (xcd - r) * q) + off; }
            const int nig = WGM * nN, gid = wgid / nig, fm = gid * WGM, gsz = (nM - fm) < WGM ? (nM - fm) : WGM;
            u.pm = fm + ((wgid % nig) % gsz); u.pn = (wgid % nig) / gsz;
        } else { const int r = (int)L - nT1; u.pm = pm2 + r % nM2; u.pn = r / nM2; }
        return true;
    }
};

__device__ __forceinline__ unsigned cvt_pk_bf16(float lo, float hi) { return pk2(lo, hi); }

struct EpiBf16 {
    static constexpr bool PERM = true;
    bf16_t* O; int ldc;
    __device__ __forceinline__ bool operator()(f32x4 (&acc)[2][2][4][2], const Unit& u, int wr, int wc, int fr, int fq) const {
        const int row0 = u.pm * BM + wr * 64 + fr, col0 = u.pn * BM + wc * 32 + 8 * fq;
#pragma unroll
        for (int ai = 0; ai < 2; ++ai)
#pragma unroll
            for (int m = 0; m < 4; ++m) { bf16_t* rowp = O + (size_t)(row0 + ai * HALF + m * 16) * ldc + col0;
#pragma unroll
                for (int bj = 0; bj < 2; ++bj) { const f32x4 v0 = acc[ai][bj][m][0], v1 = acc[ai][bj][m][1];
                    u32x4 w; w.x = cvt_pk_bf16(v0[0], v0[1]); w.y = cvt_pk_bf16(v0[2], v0[3]); w.z = cvt_pk_bf16(v1[0], v1[1]); w.w = cvt_pk_bf16(v1[2], v1[3]);
                    *(u32x4*)(rowp + bj * HALF) = w; } }
        return false;
    }
};
struct EpiWin {
    static constexpr bool PERM = true;
    bf16_t* O; unsigned char* G8;
    __device__ __forceinline__ bool operator()(f32x4 (&acc)[2][2][4][2], const Unit& u, int wr, int wc, int fr, int fq) const {
        const int row0 = u.pm * BM + wr * 64 + fr;
        if (u.pn < 23) {
            const int col0 = u.pn * BM + wc * 32 + 8 * fq;
#pragma unroll
            for (int ai = 0; ai < 2; ++ai)
#pragma unroll
                for (int m = 0; m < 4; ++m) { bf16_t* rowp = O + (size_t)(row0 + ai * HALF + m * 16) * NP + col0;
#pragma unroll
                    for (int bj = 0; bj < 2; ++bj) { const f32x4 v0 = acc[ai][bj][m][0], v1 = acc[ai][bj][m][1];
                        u32x4 w; w.x = cvt_pk_bf16(v0[0], v0[1]); w.y = cvt_pk_bf16(v0[2], v0[3]); w.z = cvt_pk_bf16(v1[0], v1[1]); w.w = cvt_pk_bf16(v1[2], v1[3]);
                        *(u32x4*)(rowp + bj * HALF) = w; } }
        } else {
            const int col0 = (u.pn - 23) * BM + wc * 32 + 8 * fq;
#pragma unroll
            for (int ai = 0; ai < 2; ++ai)
#pragma unroll
                for (int m = 0; m < 4; ++m) { unsigned char* rowp = G8 + (size_t)(row0 + ai * HALF + m * 16) * NG + col0;
#pragma unroll
                    for (int bj = 0; bj < 2; ++bj) { unsigned q[8];
#pragma unroll
                        for (int n = 0; n < 2; ++n)
#pragma unroll
                            for (int e = 0; e < 4; ++e) { const float sg = 256.f * __builtin_amdgcn_rcpf(1.f + __expf(-acc[ai][bj][m][n][e])); q[4 * n + e] = (unsigned)fminf(sg, 255.f); }
                        u32x2 w; w.x = q[0] | (q[1] << 8) | (q[2] << 16) | (q[3] << 24); w.y = q[4] | (q[5] << 8) | (q[6] << 16) | (q[7] << 24);
                        *(u32x2*)(rowp + bj * HALF) = w; } }
        }
        return false;
    }
};
struct EpiF32 {
    static constexpr bool PERM = false;
    float* C; int ldc;
    __device__ __forceinline__ bool operator()(f32x4 (&acc)[2][2][4][2], const Unit& u, int wr, int wc, int fr, int fq) const {
        const int row0 = u.pm * BM + wr * 64 + fr, col0 = u.pn * BM + wc * 32 + 4 * fq;
#pragma unroll
        for (int ai = 0; ai < 2; ++ai)
#pragma unroll
            for (int m = 0; m < 4; ++m) { float* rowp = C + (size_t)(row0 + ai * HALF + m * 16) * ldc + col0;
#pragma unroll
                for (int bj = 0; bj < 2; ++bj)
#pragma unroll
                    for (int n = 0; n < 2; ++n) *(f32x4*)(rowp + bj * HALF + n * 16) = acc[ai][bj][m][n]; }
        return false;
    }
};
struct EpiSwiglu {
    static constexpr bool PERM = true;
    bf16_t* O;
    __device__ __forceinline__ bool operator()(f32x4 (&acc)[2][2][4][2], const Unit& u, int wr, int wc, int fr, int fq) const {
        const int row0 = u.pm * BM + wr * 64 + fr, col0 = u.pn * HALF + wc * 32 + 8 * fq;
#pragma unroll
        for (int ai = 0; ai < 2; ++ai)
#pragma unroll
            for (int m = 0; m < 4; ++m) { bf16_t* rowp = O + (size_t)(row0 + ai * HALF + m * 16) * DFF + col0;
                float r[8];
#pragma unroll
                for (int n = 0; n < 2; ++n)
#pragma unroll
                    for (int e = 0; e < 4; ++e) { const float g = acc[ai][0][m][n][e], up = acc[ai][1][m][n][e]; r[4 * n + e] = g * up * __builtin_amdgcn_rcpf(1.f + __expf(-g)); }
                u32x4 w; w.x = cvt_pk_bf16(r[0], r[1]); w.y = cvt_pk_bf16(r[2], r[3]); w.z = cvt_pk_bf16(r[4], r[5]); w.w = cvt_pk_bf16(r[6], r[7]);
                *(u32x4*)rowp = w; }
        return false;
    }
};
struct EpiGate {
    static constexpr bool PERM = true;
    const unsigned char* G8; bf16_t* Y;
    __device__ __forceinline__ bool operator()(f32x4 (&acc)[2][2][4][2], const Unit& u, int wr, int wc, int fr, int fq) const {
        const int row0 = u.pm * BM + wr * 64 + fr, col0 = u.pn * BM + wc * 32 + 8 * fq;
        const unsigned char* gp = G8 + (size_t)row0 * NG + u.br * D + col0;
        if (u.br < 2) {
#pragma unroll
            for (int ai = 0; ai < 2; ++ai)
#pragma unroll
                for (int m = 0; m < 4; ++m) { const unsigned char* rp = gp + (size_t)(ai * HALF + m * 16) * NG;
                    u32x2 ga[2], gb[2];
#pragma unroll
                    for (int bj = 0; bj < 2; ++bj) { ga[bj] = *(const u32x2*)(rp + bj * HALF); gb[bj] = *(const u32x2*)(rp + D + bj * HALF); }
#pragma unroll
                    for (int bj = 0; bj < 2; ++bj)
#pragma unroll
                        for (int n = 0; n < 2; ++n)
#pragma unroll
                            for (int e = 0; e < 4; ++e) { const float sa = (float)(((n ? ga[bj].y : ga[bj].x) >> (8 * e)) & 255u) + 0.5f, sb = (float)(((n ? gb[bj].y : gb[bj].x) >> (8 * e)) & 255u) + 0.5f;
                                acc[ai][bj][m][n][e] *= sa * __builtin_amdgcn_rcpf(sb); } }
            return true;
        }
#pragma unroll
        for (int ai = 0; ai < 2; ++ai)
#pragma unroll
            for (int m = 0; m < 4; ++m) { const size_t roff = (size_t)(ai * HALF + m * 16); const unsigned char* rp = gp + roff * NG;
                u32x2 ga[2];
#pragma unroll
                for (int bj = 0; bj < 2; ++bj) ga[bj] = *(const u32x2*)(rp + bj * HALF);
#pragma unroll
                for (int bj = 0; bj < 2; ++bj) { float r[8];
#pragma unroll
                    for (int n = 0; n < 2; ++n)
#pragma unroll
                        for (int e = 0; e < 4; ++e) r[4 * n + e] = acc[ai][bj][m][n][e] * (((float)(((n ? ga[bj].y : ga[bj].x) >> (8 * e)) & 255u) + 0.5f) * (1.f / 256.f));
                    u32x4 w; w.x = cvt_pk_bf16(r[0], r[1]); w.y = cvt_pk_bf16(r[2], r[3]); w.z = cvt_pk_bf16(r[4], r[5]); w.w = cvt_pk_bf16(r[6], r[7]);
                    *(u32x4*)(Y + ((size_t)row0 + roff) * D + col0 + bj * HALF) = w; } }
        return false;
    }
};

template <class Epi>
__device__ __forceinline__ void gemm_phase(LAS unsigned char* lds, const Gemm g, const Sched& S, const Epi& E, const int tid) {
    const int wid = __builtin_amdgcn_readfirstlane(tid >> 6), lane = tid & 63, wr = wid >> 2, wc = wid & 3, fr = lane & 15, fq = lane >> 4;
    const int K = g.K, nt = K / BK, lda = g.lda;
    unsigned voffA[2], voffB[2];
#pragma unroll
    for (int i = 0; i < 2; ++i) { int R, C; stage_rc(tid * 16 + i * 8192, R, C); const int Rb = Epi::PERM ? ((R & ~31) + perm32(R & 31)) : R;
        voffA[i] = (unsigned)(R * lda + C) * 2u; voffB[i] = (unsigned)(Rb * K + C) * 2u; }
    const size_t kstep = (size_t)(BK * 2);
    const size_t hstepA = (size_t)HALF * lda * 2, hstepB = (size_t)HALF * K * 2;
    const size_t tstepA = 2 * hstepA, tstepB = 2 * hstepB;
    const unsigned ldsw = (unsigned)wid * 1024u;
    const int aoff = lds_byte(wr * 64 + fr, fq * 8), boff = lds_byte(wc * 32 + fr, fq * 8);
#define PG8_UA(u) ((const char*)((u).br == 0 ? g.A0 : ((u).br == 1 ? g.A1 : g.A2)) + (size_t)(u).pm * tstepA + (size_t)((u).pn * g.apn))
#define PG8_UB(u) ((const char*)((u).br == 0 ? g.B0 : ((u).br == 1 ? g.B1 : g.B2)) + (size_t)(u).pn * tstepB)
#define PG8_SA(b, h) (((b) * 2 + (h)) * HTB)
#define PG8_SB(b, h) ((4 + (b) * 2 + (h)) * HTB)
#define PG8_STAGE(bufoff, gbase, voff) do { _Pragma("unroll") for (int _i = 0; _i < 2; ++_i) \
        __builtin_amdgcn_global_load_lds((const unsigned*)((const char*)(gbase) + (voff)[_i]), (LAS unsigned*)(lds + (bufoff) + ldsw + _i * 8192), 16, 0, 0); } while (0)
#define PG8_LDA(dst, b, h) do { _Pragma("unroll") for (int m = 0; m < 4; ++m) _Pragma("unroll") for (int k = 0; k < 2; ++k) dst[m][k] = *(const LAS bf16x8*)(lds + PG8_SA(b, h) + aoff + m * 2048 + k * 1024); } while (0)
#define PG8_LDB(dst, b, h) do { _Pragma("unroll") for (int n = 0; n < 2; ++n) _Pragma("unroll") for (int k = 0; k < 2; ++k) dst[n][k] = *(const LAS bf16x8*)(lds + PG8_SB(b, h) + boff + n * 2048 + k * 1024); } while (0)
#define PG8_MMA(ai, bj, At, Bt) do { __builtin_amdgcn_s_setprio(1); _Pragma("unroll") for (int m = 0; m < 4; ++m) _Pragma("unroll") for (int n = 0; n < 2; ++n) _Pragma("unroll") for (int k = 0; k < 2; ++k) \
        acc[ai][bj][m][n] = __builtin_amdgcn_mfma_f32_16x16x32_bf16(Bt[n][k], At[m][k], acc[ai][bj][m][n], 0, 0, 0); __builtin_amdgcn_s_setprio(0); } while (0)
#define PG8_WAIT_V(n) asm volatile("s_waitcnt vmcnt(" #n ")" ::: "memory")
#define PG8_WAIT_L(n) asm volatile("s_waitcnt lgkmcnt(" #n ")" ::: "memory")
#define PG8_BAR __builtin_amdgcn_s_barrier()
#define PG8_SCHED __builtin_amdgcn_sched_barrier(0)
    Unit cur, nxt; int ui = 0;
    if (!S.next(0, cur)) return;
    f32x4 acc[2][2][4][2];
#pragma unroll
    for (int a = 0; a < 2; ++a)
#pragma unroll
        for (int b = 0; b < 2; ++b)
#pragma unroll
            for (int m = 0; m < 4; ++m)
#pragma unroll
                for (int n = 0; n < 2; ++n) acc[a][b][m][n] = (f32x4){0.f, 0.f, 0.f, 0.f};
    bf16x8 At[4][2], B0[2][2], B1[2][2];
    const char* cA = PG8_UA(cur); const char* cB = PG8_UB(cur);
    PG8_STAGE(PG8_SB(0, 0), cB, voffB); PG8_STAGE(PG8_SB(0, 1), cB + hstepB, voffB); PG8_STAGE(PG8_SA(0, 0), cA, voffA); PG8_STAGE(PG8_SA(0, 1), cA + hstepA, voffA);
    if (wr == 1) PG8_BAR;
    PG8_WAIT_V(2); PG8_BAR;
    PG8_STAGE(PG8_SB(1, 0), cB + kstep, voffB); PG8_STAGE(PG8_SA(1, 0), cA + kstep, voffA); PG8_STAGE(PG8_SB(1, 1), cB + hstepB + kstep, voffB);
    PG8_WAIT_V(6); PG8_BAR;
    for (;;) {
        const bool has_next = S.next(ui + 1, nxt);
        const char* nA = has_next ? PG8_UA(nxt) : cA; const char* nB = has_next ? PG8_UB(nxt) : cB;
#pragma unroll 1
        for (int t = 0; t < nt; t += 2) {
            const bool last = (t == nt - 2);
            const char* a1 = cA + (size_t)(t + 1) * kstep;
            const char* a2 = last ? nA : cA + (size_t)(t + 2) * kstep; const char* b2 = last ? nB : cB + (size_t)(t + 2) * kstep;
            const char* a3 = a2 + kstep; const char* b3 = b2 + kstep;
            PG8_LDB(B0, 0, 0); PG8_LDB(B1, 0, 1); PG8_SCHED; PG8_LDA(At, 0, 0); PG8_STAGE(PG8_SA(1, 1), a1 + hstepA, voffA);
            PG8_WAIT_V(8); PG8_WAIT_L(0); PG8_BAR; PG8_MMA(0, 0, At, B0); PG8_MMA(0, 1, At, B1); PG8_BAR; PG8_SCHED;
            PG8_LDA(At, 0, 1); PG8_STAGE(PG8_SB(0, 0), b2, voffB); PG8_STAGE(PG8_SB(0, 1), b2 + hstepB, voffB); PG8_STAGE(PG8_SA(0, 0), a2, voffA);
            PG8_WAIT_V(8); PG8_WAIT_L(0); PG8_BAR; PG8_MMA(1, 0, At, B0); PG8_MMA(1, 1, At, B1); PG8_BAR; PG8_SCHED;
            PG8_LDB(B0, 1, 0); PG8_LDB(B1, 1, 1); PG8_SCHED; PG8_LDA(At, 1, 0); PG8_STAGE(PG8_SA(0, 1), a2 + hstepA, voffA);
            PG8_WAIT_V(8); PG8_WAIT_L(0); PG8_BAR; PG8_MMA(0, 0, At, B0); PG8_MMA(0, 1, At, B1); PG8_BAR; PG8_SCHED;
            PG8_LDA(At, 1, 1); PG8_STAGE(PG8_SB(1, 0), b3, voffB); PG8_STAGE(PG8_SB(1, 1), b3 + hstepB, voffB); PG8_STAGE(PG8_SA(1, 0), a3, voffA);
            PG8_WAIT_V(8); PG8_WAIT_L(0); PG8_BAR; PG8_MMA(1, 0, At, B0); PG8_MMA(1, 1, At, B1); PG8_BAR; PG8_SCHED;
        }
        if (wr == 0) PG8_BAR;
        const bool keep = E(acc, cur, wr, wc, fr, fq);
        if (!has_next) break;
        if (!keep) {
#pragma unroll
            for (int a = 0; a < 2; ++a)
#pragma unroll
                for (int b = 0; b < 2; ++b)
#pragma unroll
                    for (int m = 0; m < 4; ++m)
#pragma unroll
                        for (int n = 0; n < 2; ++n) acc[a][b][m][n] = (f32x4){0.f, 0.f, 0.f, 0.f};
        }
        cur = nxt; cA = nA; cB = nB; ++ui;
        if (wr == 1) PG8_BAR;
    }
    PG8_WAIT_V(0);
    PG8_BAR;
#undef PG8_UA
#undef PG8_UB
#undef PG8_SA
#undef PG8_SB
#undef PG8_STAGE
#undef PG8_LDA
#undef PG8_LDB
#undef PG8_MMA
#undef PG8_WAIT_V
#undef PG8_WAIT_L
#undef PG8_BAR
#undef PG8_SCHED
}
}

namespace att {
constexpr int NW = 8, QBLK = 32, KVBLK = 64;
constexpr float SCALE = 0.088388347648318440f;
constexpr float THR = 8.f;
constexpr size_t SHM_V = KVBLK * 128 * 2, SHM_K = KVBLK * 128 * 2, SHM_ATTN = 2 * SHM_V + 2 * SHM_K + NW * 64 * 4;
#define KSWZ(row, colB) ((row) * 256 + ((colB) ^ (((row) & 7) << 4)))
#define SBAR() __builtin_amdgcn_sched_barrier(0)
__device__ __forceinline__ int crow(int r, int hi) { return (r & 3) + 8 * (r >> 2) + 4 * hi; }
__device__ __forceinline__ unsigned cvtpk(float lo, float hi) { unsigned r; asm volatile("v_cvt_pk_bf16_f32 %0, %1, %2" : "=v"(r) : "v"(lo), "v"(hi)); return r; }
__device__ __forceinline__ void partialSM(f32x16& p0, f32x16& p1, float& m_reg, float& mn, float& alpha) {
  constexpr float C = SCALE * 1.4426950408889634f;
  float pmax = p0[0];
#pragma unroll
  for (int r = 1; r < 16; ++r) pmax = fmaxf(pmax, p0[r]);
#pragma unroll
  for (int r = 0; r < 16; ++r) pmax = fmaxf(pmax, p1[r]);
  { auto rr = __builtin_amdgcn_permlane32_swap(__float_as_uint(pmax), __float_as_uint(pmax), false, false);
    pmax = fmaxf(__uint_as_float(rr[0]), __uint_as_float(rr[1])); }
  if (__builtin_expect(__all(pmax - m_reg <= THR / SCALE), 1)) { mn = m_reg; alpha = 1.f; }
  else { mn = fmaxf(m_reg, pmax); alpha = __builtin_amdgcn_exp2f((m_reg - mn) * C); m_reg = mn; }
  float mnC = -mn * C;
#pragma unroll
  for (int r = 0; r < 16; ++r) p0[r] = fmaf(p0[r], C, mnC);
#pragma unroll
  for (int r = 0; r < 16; ++r) p1[r] = fmaf(p1[r], C, mnC);
#pragma unroll
  for (int r = 0; r < 16; ++r) p0[r] = __builtin_amdgcn_exp2f(p0[r]);
}
__device__ __forceinline__ void finishSM(f32x16& p0, f32x16& p1, float alpha, float& l_reg, bf16x8& pa0, bf16x8& pa1, bf16x8& pa2, bf16x8& pa3) {
#pragma unroll
  for (int r = 0; r < 16; ++r) p1[r] = __builtin_amdgcn_exp2f(p1[r]);
  float ps = 0;
#pragma unroll
  for (int r = 0; r < 16; ++r) ps += p0[r];
#pragma unroll
  for (int r = 0; r < 16; ++r) ps += p1[r];
  { auto rr = __builtin_amdgcn_permlane32_swap(__float_as_uint(ps), __float_as_uint(ps), false, false);
    ps = __uint_as_float(rr[0]) + __uint_as_float(rr[1]); }
  l_reg = l_reg * alpha + ps;
#define PK4(P, BASE, OUT) do { unsigned a0 = cvtpk(P[BASE + 0], P[BASE + 1]), a1 = cvtpk(P[BASE + 2], P[BASE + 3]);   \
    unsigned b0 = cvtpk(P[BASE + 4], P[BASE + 5]), b1 = cvtpk(P[BASE + 6], P[BASE + 7]);                              \
    auto r0 = __builtin_amdgcn_permlane32_swap(a0, b0, false, false); auto r1 = __builtin_amdgcn_permlane32_swap(a1, b1, false, false); \
    u32x4 w = {r0[0], r1[0], r0[1], r1[1]}; OUT = *reinterpret_cast<bf16x8*>(&w); } while (0)
  PK4(p0, 0, pa0); PK4(p0, 8, pa1); PK4(p1, 0, pa2); PK4(p1, 8, pa3);
#undef PK4
}
__device__ __forceinline__ void qkt(f32x16& p0, f32x16& p1, const bf16_t* Ks, const bf16x8* qr, int r32, int hi) {
  p0 = f32x16{}; p1 = f32x16{};
#pragma unroll
  for (int d0 = 0; d0 < 8; ++d0) { int cb = (d0 * 16 + hi * 8) * 2;
    bf16x8 b0 = *reinterpret_cast<const bf16x8*>((const char*)Ks + KSWZ(r32, cb));
    bf16x8 b1 = *reinterpret_cast<const bf16x8*>((const char*)Ks + KSWZ(32 + r32, cb));
    p0 = __builtin_amdgcn_mfma_f32_32x32x16_bf16(b0, qr[d0], p0, 0, 0, 0);
    p1 = __builtin_amdgcn_mfma_f32_32x32x16_bf16(b1, qr[d0], p1, 0, 0, 0); }
}
__device__ __forceinline__ int v_st(int k, int c) { const int kk = (k & ~0xC) | ((k & 4) << 1) | ((k & 8) >> 1); return ((kk >> 3) * 4 + (c >> 5)) * 512 + ((kk & 7) * 32 + (c & 31)) * 2; }
__device__ __forceinline__ int v_rd_base(int lane) { return ((lane & 3) << 3) | (((lane >> 2) & 3) << 6) | (((lane >> 4) & 1) << 5) | (((lane >> 5) & 1) << 8); }
constexpr int v_rd_off(int d0, int ks, int half) { return d0 * 512 + ks * 4096 + half * 2048; }
template <int OFF> __device__ __forceinline__ s16x4 tr_read(int vb) {
  s16x4 r; asm volatile("ds_read_b64_tr_b16 %0, %1 offset:%2" : "=&v"(r) : "v"(vb), "i"(OFF) : "memory"); return r;
}
template <int D0> __device__ __forceinline__ void pv_one(f32x16& od, int vb, bf16x8 pa0, bf16x8 pa1, bf16x8 pa2, bf16x8 pa3) {
  const s16x4 l0 = tr_read<v_rd_off(D0, 0, 0)>(vb), h0 = tr_read<v_rd_off(D0, 0, 1)>(vb), l1 = tr_read<v_rd_off(D0, 1, 0)>(vb), h1 = tr_read<v_rd_off(D0, 1, 1)>(vb);
  const s16x4 l2 = tr_read<v_rd_off(D0, 2, 0)>(vb), h2 = tr_read<v_rd_off(D0, 2, 1)>(vb), l3 = tr_read<v_rd_off(D0, 3, 0)>(vb), h3 = tr_read<v_rd_off(D0, 3, 1)>(vb);
  asm volatile("s_waitcnt lgkmcnt(0)" ::: "memory"); SBAR();
#define PK(L, H) (bf16x8){L[0], L[1], L[2], L[3], H[0], H[1], H[2], H[3]}
  od = __builtin_amdgcn_mfma_f32_32x32x16_bf16(pa0, PK(l0, h0), od, 0, 0, 0);
  od = __builtin_amdgcn_mfma_f32_32x32x16_bf16(pa1, PK(l1, h1), od, 0, 0, 0);
  od = __builtin_amdgcn_mfma_f32_32x32x16_bf16(pa2, PK(l2, h2), od, 0, 0, 0);
  od = __builtin_amdgcn_mfma_f32_32x32x16_bf16(pa3, PK(l3, h3), od, 0, 0, 0);
#undef PK
}
__device__ __forceinline__ void pv_d0(f32x16* o, int vb, bf16x8 pa0, bf16x8 pa1, bf16x8 pa2, bf16x8 pa3) {
  pv_one<0>(o[0], vb, pa0, pa1, pa2, pa3); pv_one<1>(o[1], vb, pa0, pa1, pa2, pa3); pv_one<2>(o[2], vb, pa0, pa1, pa2, pa3); pv_one<3>(o[3], vb, pa0, pa1, pa2, pa3);
}
__device__ __forceinline__ void attn_dense_body(const bf16_t* Qb, const bf16_t* __restrict__ KL, const bf16_t* __restrict__ KC,
                                                int ntl, bf16_t* Ob, int NT, char* lds, const int tid, const bool dost = true) {
  constexpr int LDQ = NP, LDK = NP, LDO = NP;
  const int wid = tid >> 6, lane = tid & 63, r32 = lane & 31, hi = lane >> 5;
  bf16_t* V_lds = (bf16_t*)lds; bf16_t* K_lds = (bf16_t*)(lds + 2 * SHM_V);
  float* ws = (float*)(lds + 2 * SHM_V + 2 * SHM_K) + wid * 64; float* li_l = ws; float* al_l = ws + 32;
  float m_reg = -1e30f, l_reg = 0; f32x16 o[4] = {}; bf16x8 qr[8];
  const bf16_t* Qw = Qb + (long)(wid * QBLK + r32) * LDQ + hi * 8;
#pragma unroll
  for (int d0 = 0; d0 < 8; ++d0) qr[d0] = *reinterpret_cast<const bf16x8*>(Qw + d0 * 16);
  const int sr = tid >> 4, sc = (tid & 15) * 8, vst0 = v_st(sr, sc), vst1 = v_st(32 + sr, sc);
  const int vb0 = (int)(uintptr_t)V_lds + v_rd_base(lane);
  struct { bf16x8 vs0, vs1, ks0, ks1; } sr_[1];
  const int loff0 = sr * LDK + sc, loff1 = (32 + sr) * LDK + sc;
  const bf16_t* knext = (ntl > 0) ? KL : KC; int tl_ = 0;
#define SLOAD(i, t) do { const bf16_t* kt_ = knext; ++tl_; knext = (tl_ == ntl) ? KC : knext + (long)KVBLK * LDK; \
    sr_[i].vs0 = *reinterpret_cast<const bf16x8*>(kt_ + loff0 + (C_AV - C_AK)); sr_[i].vs1 = *reinterpret_cast<const bf16x8*>(kt_ + loff1 + (C_AV - C_AK)); \
    sr_[i].ks0 = *reinterpret_cast<const bf16x8*>(kt_ + loff0); sr_[i].ks1 = *reinterpret_cast<const bf16x8*>(kt_ + loff1); } while (0)
#define SWRITE(b, i) do { *(bf16x8*)((char*)V_lds + (b) * SHM_V + vst0) = sr_[i].vs0;          \
    *(bf16x8*)((char*)V_lds + (b) * SHM_V + vst1) = sr_[i].vs1; int kc = sc * 2;               \
    *(bf16x8*)((char*)K_lds + (b) * SHM_K + KSWZ(sr, kc)) = sr_[i].ks0;                       \
    *(bf16x8*)((char*)K_lds + (b) * SHM_K + KSWZ(32 + sr, kc)) = sr_[i].ks1; } while (0)
#define SWAIT() asm volatile("s_waitcnt vmcnt(0)" ::: "memory")
#define RESC(a) do { if (__any((a) < 1.f)) { if (hi == 0) al_l[r32] = (a); asm volatile("s_waitcnt lgkmcnt(0)" ::: "memory"); \
    _Pragma("unroll") for (int d = 0; d < 4; ++d) _Pragma("unroll") for (int r = 0; r < 16; ++r) o[d][r] *= al_l[crow(r, hi)]; } } while (0)
  f32x16 pA0, pA1, pB0, pB1; float mnA, mnB, alA, alB; bf16x8 pa0, pa1, pa2, pa3;
  constexpr int SE = 0, SO = 0;
  SLOAD(SE, 0); asm volatile("s_waitcnt vmcnt(0)" ::: "memory"); SWRITE(0, SE); __syncthreads();
  qkt(pA0, pA1, K_lds, qr, r32, hi); partialSM(pA0, pA1, m_reg, mnA, alA);
  SLOAD(SO, 1);
  SWAIT(); SWRITE(1, SO); __syncthreads();
  for (int j = 1; j + 1 < NT; j += 2) {
    SBAR(); qkt(pB0, pB1, (bf16_t*)((char*)K_lds + SHM_K), qr, r32, hi);
    finishSM(pA0, pA1, alA, l_reg, pa0, pa1, pa2, pa3); SBAR();
    SLOAD(SO, j + 1); SBAR();
    pv_d0(o, vb0, pa0, pa1, pa2, pa3); partialSM(pB0, pB1, m_reg, mnB, alB);
    __syncthreads(); SWAIT(); SWRITE(0, SE);
    RESC(alB); __syncthreads();
    SBAR(); qkt(pA0, pA1, K_lds, qr, r32, hi);
    finishSM(pB0, pB1, alB, l_reg, pa0, pa1, pa2, pa3); SBAR();
    SLOAD(SE, j + 2); SBAR();
    pv_d0(o, vb0 + (int)SHM_V, pa0, pa1, pa2, pa3); partialSM(pA0, pA1, m_reg, mnA, alA);
    __syncthreads(); SWAIT(); SWRITE(1, SO);
    RESC(alA); __syncthreads();
  }
  SBAR(); qkt(pB0, pB1, (bf16_t*)((char*)K_lds + SHM_K), qr, r32, hi);
  finishSM(pA0, pA1, alA, l_reg, pa0, pa1, pa2, pa3); SBAR();
  pv_d0(o, vb0, pa0, pa1, pa2, pa3); partialSM(pB0, pB1, m_reg, mnB, alB);
  __syncthreads(); RESC(alB);
  finishSM(pB0, pB1, alB, l_reg, pa0, pa1, pa2, pa3); SBAR();
  pv_d0(o, vb0 + (int)SHM_V, pa0, pa1, pa2, pa3);
  if (hi == 0) li_l[r32] = l_reg; asm volatile("s_waitcnt lgkmcnt(0)" ::: "memory");
  float rli[16];
#pragma unroll
  for (int r = 0; r < 16; ++r) rli[r] = __builtin_amdgcn_rcpf(li_l[crow(r, hi)]);
  bf16_t* Ow = Ob + (long)(wid * QBLK) * LDO;
#pragma unroll
  for (int r = 0; r < 16; ++r) { int orow = crow(r, hi);
#pragma unroll
    for (int d0 = 0; d0 < 4; ++d0) if (dost) Ow[(long)orow * LDO + d0 * 32 + r32] = (bf16_t)f2bf(o[d0][r] * rli[r]); }
  __syncthreads();
#undef SLOAD
#undef SWRITE
#undef SWAIT
#undef RESC
}
#undef KSWZ
#undef SBAR
}


#define XB_TMO      128
#define XB_XCNT(j)  (256  + 64 * (j))
#define XB_XSUB(j)  (1280 + 64 * (j))
#define XB_XGEN(j)  (2304 + 64 * (j))
#define XB_TOP      3328
#define XB_TOPGEN   3392
#define XCD_BAR_WORDS 3456
#define XB_SPIN_CAP (1u << 18)
__device__ __forceinline__ unsigned xb_ld(unsigned* p)              { return __hip_atomic_load(p, __ATOMIC_RELAXED, __HIP_MEMORY_SCOPE_AGENT); }
__device__ __forceinline__ unsigned xb_add(unsigned* p, unsigned v) { return __hip_atomic_fetch_add(p, v, __ATOMIC_RELAXED, __HIP_MEMORY_SCOPE_AGENT); }
__device__ __forceinline__ unsigned xb_xcc_id() { return (unsigned)__builtin_amdgcn_s_getreg((3 << 11) | 20) & 0xFu; }
#define XB_SPIN(cond, bar) do { unsigned _sp = 0; while (cond) { __builtin_amdgcn_s_sleep(1); \
    if ((++_sp & 255u) == 0u) { if (xb_ld(&(bar)[XB_TMO])) break; if (_sp > XB_SPIN_CAP) { atomicAdd(&(bar)[XB_TMO], 1u); break; } } } } while (0)
struct XcdBarrier { unsigned* bar; unsigned x; volatile LAS unsigned* st; };
__device__ __forceinline__ XcdBarrier xcd_barrier_post(unsigned* bar, volatile LAS unsigned* st) {
    XcdBarrier b; b.bar = bar; b.x = xb_xcc_id(); b.st = st;
    if (threadIdx.x == 0) (void)xb_add(&bar[XB_XCNT(b.x)], 1u);
    return b;
}
__device__ __forceinline__ void xcd_barrier_complete(unsigned* bar, unsigned x, unsigned& nloc, unsigned& nx) {
    const unsigned G = gridDim.x * gridDim.y * gridDim.z;
    unsigned sum, cnt, mine, sp = 0u;
    for (;;) {
        sum = 0u; cnt = 0u; mine = 0u;
#pragma unroll
        for (unsigned j = 0; j < 16; ++j) { const unsigned c = xb_ld(&bar[XB_XCNT(j)]); sum += c; cnt += (c > 0u) ? 1u : 0u; mine = (j == x) ? c : mine; }
        if (sum == G) break;
        __builtin_amdgcn_s_sleep(1);
        if ((++sp & 255u) == 0u) { if (xb_ld(&bar[XB_TMO])) break; if (sp > XB_SPIN_CAP) { atomicAdd(&bar[XB_TMO], 1u); break; } }
    }
    nloc = mine > 0u ? mine : 1u; nx = cnt > 0u ? cnt : 1u;
}
__device__ __forceinline__ void xcd_barrier(const XcdBarrier& b) {
    asm volatile("s_waitcnt vmcnt(0)" ::: "memory");
    __syncthreads();
    if (threadIdx.x == 0) {
        unsigned* bar = b.bar;
        __builtin_amdgcn_s_waitcnt(0);
        unsigned nloc = b.st[0], nx = b.st[1];
        if (nloc == 0u) { xcd_barrier_complete(bar, b.x, nloc, nx); b.st[0] = nloc; b.st[1] = nx; }
        const unsigned old = xb_add(&bar[XB_XSUB(b.x)], 1u);
        const unsigned gen = old / nloc;
        if (old + 1u == (gen + 1u) * nloc) {
            __builtin_amdgcn_fence(__ATOMIC_RELEASE, "agent");
            asm volatile("s_waitcnt vmcnt(0)" ::: "memory");
            const unsigned og = xb_add(&bar[XB_TOP], 1u);
            const unsigned tg = og / nx;
            if (og + 1u == (tg + 1u) * nx) xb_add(&bar[XB_TOPGEN], 1u);
            else XB_SPIN(xb_ld(&bar[XB_TOPGEN]) == tg, bar);
            __builtin_amdgcn_fence(__ATOMIC_ACQUIRE, "agent");
            xb_add(&bar[XB_XGEN(b.x)], 1u);
            asm volatile("s_waitcnt vmcnt(0)" ::: "memory");
        } else {
            XB_SPIN(xb_ld(&bar[XB_XGEN(b.x)]) == gen, bar);
            __builtin_amdgcn_fence(__ATOMIC_ACQUIRE, "agent");
            asm volatile("s_waitcnt vmcnt(0)" ::: "memory");
        }
    }
    __syncthreads();
}

typedef const __attribute__((address_space(4))) Args* ArgsP;
struct Fr {
    char* lds; LAS unsigned char* lds3; int tid, lane, wave, G, vcu, gw, NGW, bx;
    ArgsP ap;
};
#define WSB (F.ap->ws)
#define F_P ((bf16_t*)(WSB + WS_P))
#define F_H ((bf16_t*)(WSB + WS_H))
#define F_MIX ((bf16_t*)(WSB + WS_MIX))
#define F_CST ((bf16_t*)(WSB + WS_CST))
#define F_MOD ((float*)(WSB + WS_MOD))
#define F_LI ((float*)(WSB + WS_LI))
#define F_LF ((float*)(WSB + WS_LF))
#define F_GT ((float*)(WSB + WS_GT))
#define F_MLOC ((float*)(WSB + WS_GT) + 2048)
#define F_MIN ((float*)(WSB + WS_GT) + 4096)
#define F_NST ((float*)(WSB + WS_NST))
#define F_XC ((float*)(WSB + WS_XC))


__device__ __forceinline__ void tr_item(const float* W, int N, int k0, int n0, bf16_t* WT, int ldt, int drow0, const float* rscale, float* scr, int lane, int split = 1 << 30, int shift = 0) {
    const int cq = lane & 15, rq = lane >> 4, dn = n0 + 4 * cq, nn = dn < split ? dn : dn - shift; const bool ok = (nn < N) && (dn < split || dn >= split + shift);
    f32x4 v[16];
#pragma unroll
    for (int i = 0; i < 16; ++i) v[i] = ok ? __builtin_nontemporal_load((const f32x4*)(W + (size_t)(k0 + 4 * i + rq) * N + nn)) : (f32x4){0.f, 0.f, 0.f, 0.f};
#pragma unroll
    for (int i = 0; i < 16; ++i) { float* d = scr + (4 * i + rq) * 65 + 4 * cq; d[0] = v[i][0]; d[1] = v[i][1]; d[2] = v[i][2]; d[3] = v[i][3]; }
    asm volatile("s_waitcnt lgkmcnt(0)" ::: "memory");
    const int c = lane & 7;
#pragma unroll
    for (int j = 0; j < 8; ++j) { const int n = (lane >> 3) + 8 * j; const float* sp = scr + (8 * c) * 65 + n;
        const float sc = rscale ? rscale[n0 + n] : 1.f;
        u32x4 o; o.x = pk2(sp[0 * 65] * sc, sp[1 * 65] * sc); o.y = pk2(sp[2 * 65] * sc, sp[3 * 65] * sc); o.z = pk2(sp[4 * 65] * sc, sp[5 * 65] * sc); o.w = pk2(sp[6 * 65] * sc, sp[7 * 65] * sc);
        *(u32x4*)(WT + (size_t)(drow0 + n) * ldt + k0 + 8 * c) = o; }
    asm volatile("s_waitcnt lgkmcnt(0)" ::: "memory");
}
__device__ __forceinline__ void convert_weights(Fr& F, int l) {
    float* scr = (float*)(F.lds + F.wave * 16640);
    constexpr int I_IN = 32 * 188, I_FI = 32 * 176, I_FO = 88 * 32, I_UP = 16 * 32, I_OUT = 32 * 32, I_PL = 64;
    constexpr int NIT = I_IN + I_FI + I_FO + 3 * I_UP + I_OUT + I_PL;
    for (int it = F.gw; it < NIT; it += F.NGW) {
        int r = it;
        if (r < I_IN) { const int kb = r / 188, nb = r % 188; tr_item(F.ap->in[I_WIN] + (size_t)l * D * DIN, DIN, kb * 64, nb * 64, (bf16_t*)(WSB + WS_WIN), D, nb * 64, nullptr, scr, F.lane, C_GRAW, NP - C_GRAW); continue; } r -= I_IN;
        if (r < I_FI) { const int kb = r / 176, nb = r % 176, n0 = nb * 64, bj = n0 / DFF, jj0 = n0 % DFF;
            tr_item(F.ap->in[I_FFI] + (size_t)l * D * 2 * DFF, 2 * DFF, kb * 64, n0, (bf16_t*)(WSB + WS_WFI), D, (jj0 / 128) * 256 + bj * 128 + (jj0 % 128), nullptr, scr, F.lane); continue; } r -= I_FI;
        if (r < I_FO) { const int kb = r / 32, nb = r % 32; tr_item(F.ap->in[I_FFO] + (size_t)l * DFF * D, D, kb * 64, nb * 64, (bf16_t*)(WSB + WS_WFO), DFF, nb * 64, nullptr, scr, F.lane); continue; } r -= I_FO;
#define UPCASE(BR, IDX) if (r < I_UP) { const int kb = r / 32, nb = r % 32; \
            tr_item(F.ap->in[IDX] + (size_t)l * 1024 * D, D, kb * 64, nb * 64, (bf16_t*)(WSB + WS_WUP) + (size_t)(BR) * D * 1024, 1024, nb * 64, nullptr, scr, F.lane); continue; } r -= I_UP;
        UPCASE(0, I_UPA) UPCASE(1, I_UPM) UPCASE(2, I_UPP)
#undef UPCASE
        if (r < I_OUT) { const int kb = r / 32, nb = r % 32; tr_item(F.ap->in[I_WOUT] + (size_t)l * D * D, D, kb * 64, nb * 64, (bf16_t*)(WSB + WS_WOUT), D, nb * 64, nullptr, scr, F.lane); continue; } r -= I_OUT;
        { const int g = r / 16, q = r % 16, kb = q / 4, nb = q % 4;
          tr_item(F.ap->in[I_POOLW] + ((size_t)l * 4 + g) * 65536, 256, kb * 64, nb * 64, (bf16_t*)(WSB + WS_WPL) + (size_t)g * 65536, 256, nb * 64, F.ap->in[I_POOLS] + l * 1024 + g * 256, scr, F.lane); }
    }
}

__device__ __forceinline__ void mod_gemv(Fr& F) {
    float* sc = (float*)F.lds;
    float* red = (float*)(F.lds + 5 * 2048 * 4);
    for (int i = F.tid; i < 5 * 2048; i += 512) { const int m = i >> 11, k = i & 2047; const float v = m < 4 ? F.ap->in[I_C][m * 2048 + k] : F.ap->in[I_CCTX][k]; sc[i] = v / (1.f + __expf(-v)); }
    __syncthreads();
    const int kpar = F.lane >> 5, cl = F.lane & 31;
    for (int it = F.bx; it < 768; it += F.G) {
        const int l = it / 384, col = (it % 384) * 32 + cl;
        const float* w = F.ap->in[I_WMOD] + (size_t)l * D * 12288 + col;
        float a0 = 0, a1 = 0, a2 = 0, a3 = 0, a4 = 0;
        const int kbase = F.wave * 256 + kpar;
#pragma unroll 32
        for (int kk = 0; kk < 128; ++kk) { const int k = kbase + 2 * kk; const float wv = __builtin_nontemporal_load(w + (size_t)k * 12288);
            a0 += sc[k] * wv; a1 += sc[2048 + k] * wv; a2 += sc[4096 + k] * wv; a3 += sc[6144 + k] * wv; a4 += sc[8192 + k] * wv; }
        a0 += __shfl_xor(a0, 32); a1 += __shfl_xor(a1, 32); a2 += __shfl_xor(a2, 32); a3 += __shfl_xor(a3, 32); a4 += __shfl_xor(a4, 32);
        if (kpar == 0) { float* rp = red + F.wave * 160 + cl; rp[0] = a0; rp[32] = a1; rp[64] = a2; rp[96] = a3; rp[128] = a4; }
        __syncthreads();
        if (F.tid < 160) { float s = 0;
#pragma unroll
            for (int w8 = 0; w8 < 8; ++w8) s += red[w8 * 160 + F.tid];
            const int m = F.tid >> 5, c = (it % 384) * 32 + (F.tid & 31);
            F_MOD[((size_t)l * 5 + m) * 12288 + c] = s + F.ap->in[I_BMOD][l * 12288 + c]; }
        __syncthreads();
    }
}

__device__ __forceinline__ void ld_row(const float* p, int lane, f32x4 (&v)[8]) {
#pragma unroll
    for (int j = 0; j < 8; ++j) v[j] = __builtin_nontemporal_load((const f32x4*)p + lane + 64 * j);
}
__device__ __forceinline__ float row_rinv(const f32x4 (&v)[8]) {
    float s = 0.f;
#pragma unroll
    for (int j = 0; j < 8; ++j) s += (v[j].x * v[j].x + v[j].y * v[j].y) + (v[j].z * v[j].z + v[j].w * v[j].w);
    return 1.f / sqrtf(wave_sum(s) * (1.f / D) + EPS);
}
__device__ __forceinline__ void norm_mod_store(const f32x4 (&x)[8], const float* g, const float* sh, const float* sc, bf16_t* orow, int lane) {
    const float rinv = row_rinv(x);
#pragma unroll
    for (int j = 0; j < 8; ++j) { const int i = lane + 64 * j; const f32x4 gg = ((const f32x4*)g)[i], s1 = ((const f32x4*)sc)[i], s0 = ((const f32x4*)sh)[i];
        const f32x4 h = (x[j] * rinv * gg) * (1.f + s1) + s0;
        u32x2 w; w.x = pk2(h.x, h.y); w.y = pk2(h.z, h.w); ((u32x2*)orow)[i] = w; }
}
__device__ __forceinline__ int mod_row(int r) { return r < ML ? (r >> 12) : 4; }
__device__ __forceinline__ void phase_norm1(Fr& F, int l, const float* xlat, const float* xctx) {
    const float* g = F.ap->in[I_NORMG] + (size_t)l * 4 * D;
    for (int r = F.gw; r < MT; r += F.NGW) {
        const float* src = r < ML ? xlat + (size_t)r * D : xctx + (size_t)(r - ML) * D;
        const float* mod = F_MOD + ((size_t)l * 5 + mod_row(r)) * 12288;
        f32x4 x[8]; ld_row(src, F.lane, x);
        norm_mod_store(x, g, mod, mod + D, F_H + (size_t)r * D, F.lane);
    }
}
__device__ __forceinline__ void phase_resid(Fr& F, int l, int which, int nrows, const float* xlat_src, const float* xctx_src, bool nextnorm, const bool srcbf, const bool dstbf, const bool dost = true) {
    const float* ng = F.ap->in[I_NORMG] + (size_t)l * 4 * D;
    const bf16_t* Y = (const bf16_t*)(WSB + WS_YO);
    for (int r = F.gw; r < nrows; r += F.NGW) {
        const float* src = r < ML ? xlat_src + (size_t)r * D : xctx_src + (size_t)(r - ML) * D;
        float* dst = r < ML ? F.ap->out + (size_t)r * D : F_XC + (size_t)(r - ML) * D;
        const float* mod = F_MOD + ((size_t)l * 5 + mod_row(r)) * 12288;
        const float* gate = mod + (which == 0 ? 2 : 5) * D; const float* gy = ng + (which == 0 ? 1 : 3) * D;
        f32x4 y[8], x[8];
#pragma unroll
        for (int j = 0; j < 8; ++j) { const u32x2 w = __builtin_nontemporal_load((const u32x2*)(Y + (size_t)r * D) + F.lane + 64 * j);
            y[j] = (f32x4){__uint_as_float(w.x << 16), __uint_as_float(w.x & 0xffff0000u), __uint_as_float(w.y << 16), __uint_as_float(w.y & 0xffff0000u)}; }
        bf16_t* xb = (bf16_t*)(WSB + WS_XB) + (size_t)(r < ML ? r : 0) * D;
        if (r < ML && srcbf) {
#pragma unroll
            for (int j = 0; j < 8; ++j) { const u32x2 w = __builtin_nontemporal_load((const u32x2*)xb + F.lane + 64 * j);
                x[j] = (f32x4){__uint_as_float(w.x << 16), __uint_as_float(w.x & 0xffff0000u), __uint_as_float(w.y << 16), __uint_as_float(w.y & 0xffff0000u)}; }
        } else ld_row(src, F.lane, x);
        const float ry = row_rinv(y);
#pragma unroll
        for (int j = 0; j < 8; ++j) { const int i = F.lane + 64 * j; const f32x4 gt = ((const f32x4*)gate)[i], gg = ((const f32x4*)gy)[i];
            x[j] = x[j] + gt * (y[j] * ry * gg);
            if (dost) { if (r < ML && dstbf) { u32x2 w; w.x = pk2(x[j].x, x[j].y); w.y = pk2(x[j].z, x[j].w); ((u32x2*)xb)[i] = w; } else ((f32x4*)dst)[i] = x[j]; } }
        if (which == 0) norm_mod_store(x, ng + 2 * D, mod + 3 * D, mod + 4 * D, F_H + (size_t)r * D, F.lane);
        else if (nextnorm) { const float* mod2 = F_MOD + ((size_t)(l + 1) * 5 + mod_row(r)) * 12288;
            norm_mod_store(x, F.ap->in[I_NORMG] + (size_t)(l + 1) * 4 * D, mod2, mod2 + D, F_H + (size_t)r * D, F.lane); }
    }
}

__device__ __forceinline__ void phase_prep(Fr& F, int l, const bool dost = true) {
    const float* qkg = F.ap->in[I_QKG] + l * 256;
    const float* gb = F.ap->in[I_GATEB] + l * 16;
    const int lane = F.lane, i32 = lane & 31, sub = lane >> 5;
    float gq[4], gk[4];
#pragma unroll
    for (int e = 0; e < 4; ++e) { gq[e] = qkg[32 * e + i32]; gk[e] = qkg[128 + 32 * e + i32]; }
    const float inv = __builtin_amdgcn_exp2f(-(float)i32 * (13.287712379549449f / 32.f));
    for (int rp = F.gw; rp < MT / 2; rp += F.NGW) {
        const int r = 2 * rp + sub;
        bf16_t* prow = F_P + (size_t)r * NP;
        const bool lat = r < ML;
        const int nh = (lat || l == 0) ? 10 : 2;
        float cs0 = 1.f, sn0 = 0.f, cs1 = 1.f, sn1 = 0.f;
        if (lat) { const int t = r & 4095;
            float rev0 = (float)(t >> 6) * inv * 0.15915494309189535f, rev1 = (float)(t & 63) * inv * 0.15915494309189535f;
            rev0 -= rintf(rev0); rev1 -= rintf(rev1);
            sn0 = __builtin_amdgcn_sinf(rev0); cs0 = __builtin_amdgcn_cosf(rev0); sn1 = __builtin_amdgcn_sinf(rev1); cs1 = __builtin_amdgcn_cosf(rev1); }
        float x[10][4];
#pragma unroll
        for (int h = 0; h < 10; ++h) if (h < nh) { const int c0 = h < 2 ? C_AK + h * 128 : C_AQ + (h - 2) * 128;
#pragma unroll
            for (int e = 0; e < 4; ++e) x[h][e] = bf2f(prow[c0 + 32 * e + i32]); }
#pragma unroll
        for (int h = 0; h < 10; ++h) if (h < nh) {
            const int c0 = h < 2 ? C_AK + h * 128 : C_AQ + (h - 2) * 128;
            float ss = (x[h][0] * x[h][0] + x[h][1] * x[h][1]) + (x[h][2] * x[h][2] + x[h][3] * x[h][3]);
#pragma unroll
            for (int o = 1; o < 32; o <<= 1) ss += __shfl_xor(ss, o);
            const float rinv = __builtin_amdgcn_rsqf(ss * (1.f / 128.f) + EPS);
            const float a0 = x[h][0] * rinv * (h < 2 ? gk[0] : gq[0]), b0 = x[h][1] * rinv * (h < 2 ? gk[1] : gq[1]);
            const float a1 = x[h][2] * rinv * (h < 2 ? gk[2] : gq[2]), b1 = x[h][3] * rinv * (h < 2 ? gk[3] : gq[3]);
            if (dost) { prow[c0 + i32] = (bf16_t)f2bf(a0 * cs0 - b0 * sn0); prow[c0 + 32 + i32] = (bf16_t)f2bf(b0 * cs0 + a0 * sn0);
                        prow[c0 + 64 + i32] = (bf16_t)f2bf(a1 * cs1 - b1 * sn1); prow[c0 + 96 + i32] = (bf16_t)f2bf(b1 * cs1 + a1 * sn1); } }
        if (i32 < 16) { const int q = i32 & 7, d = q >> 2, hh = q & 3;
            const float raw = bf2f(prow[(i32 < 8 ? C_GI : C_GF) + q]);
            if (i32 < 8) F_LI[(size_t)r * 8 + q] = raw + gb[d * 8 + hh];
            else { const float xx = raw + gb[d * 8 + 4 + hh]; F_LF[(size_t)r * 8 + q] = fminf(xx, 0.f) - __logf(1.f + __expf(-fabsf(xx))); } }
    }
    const int nrows = (l == 0) ? MT : ML;
    const long total = (long)nrows * 128, nth = (long)F.G * 512;
    for (long it = (long)F.bx * 512 + F.tid; it < total; it += nth) {
        const int gi = (int)((it >> 6) & 3), c8 = (int)(it & 31) | (gi << 5), r = (int)((it >> 8) << 1) | (int)((it >> 5) & 1);
        const int T = r < ML ? SEQ : CTXL, t = r < ML ? (r & 4095) : ((r - ML) & 255);
        const bf16_t* base = F_P + (size_t)(r - t) * NP + C_PL + c8 * 8;
        float s[8] = {0, 0, 0, 0, 0, 0, 0, 0}; int cnt = 0, nwin = 0;
#define POOLW(HW) { bf16x8 v[2 * HW]; \
            _Pragma("unroll") for (int k = 0; k < 2 * HW; ++k) { const int u = t - HW + k; const bool ok = (u >= 0) && (u < T); const int uc = ok ? u : t; v[k] = *(const bf16x8*)(base + (size_t)uc * NP); cnt += ok ? 1 : 0; } \
            _Pragma("unroll") for (int k = 0; k < 2 * HW; ++k) { \
                _Pragma("unroll") for (int i = 0; i < 8; ++i) s[i] += bfs2f(v[k][i]); } nwin = 2 * HW; }
        if (gi == 0) POOLW(1) else if (gi == 1) POOLW(2) else if (gi == 2) POOLW(4) else POOLW(8)
#undef POOLW
        const bf16x8 self = *(const bf16x8*)(base + (size_t)t * NP); const float rc = __builtin_amdgcn_rcpf((float)cnt); const float ninv = (float)(nwin - cnt);
#pragma unroll
        for (int i = 0; i < 8; ++i) s[i] -= ninv * bfs2f(self[i]);
        u32x4 w; w.x = pk2(s[0] * rc - bfs2f(self[0]), s[1] * rc - bfs2f(self[1])); w.y = pk2(s[2] * rc - bfs2f(self[2]), s[3] * rc - bfs2f(self[3]));
        w.z = pk2(s[4] * rc - bfs2f(self[4]), s[5] * rc - bfs2f(self[5])); w.w = pk2(s[6] * rc - bfs2f(self[6]), s[7] * rc - bfs2f(self[7]));
        *(u32x4*)(F_MIX + (size_t)r * 1024 + c8 * 8) = w;
    }
}

__device__ __forceinline__ void chunk_bs(int cidx, int& b, int& slot) { if (cidx < 128) { b = cidx >> 5; slot = 2 + (cidx & 31); } else { b = (cidx - 128) >> 1; slot = (cidx - 128) & 1; } }
__device__ __forceinline__ int unit_idx(int b, int hh, int d, int slot) { return ((b * 4 + hh) * 2 + d) * NSLOT + slot; }
constexpr int VS = 136;
constexpr int LDS_VT = 0, LDS_KT = 256 * VS * 2, LDS_FS = LDS_KT + 128 * VS * 2, LDS_CH = LDS_FS + 5120;

__device__ __forceinline__ void stage_vt(Fr& F, bf16_t* VT, size_t R0, int hh) {
    for (int idx = F.tid; idx < 1024; idx += 512) { const int l4 = idx & 31, c8 = idx >> 5;
        const bf16_t* src = F_P + (R0 + 4 * l4) * NP + C_MV + hh * 256 + c8 * 8;
        const bf16x8 r0 = *(const bf16x8*)(src), r1 = *(const bf16x8*)(src + NP), r2 = *(const bf16x8*)(src + 2 * NP), r3 = *(const bf16x8*)(src + 3 * NP);
#pragma unroll
        for (int i = 0; i < 8; ++i) { u32x2 w; w.x = (unsigned)(unsigned short)r0[i] | ((unsigned)(unsigned short)r1[i] << 16); w.y = (unsigned)(unsigned short)r2[i] | ((unsigned)(unsigned short)r3[i] << 16);
            *(u32x2*)(VT + (c8 * 8 + i) * VS + 4 * l4) = w; } }
}
__device__ __forceinline__ void mls_cloc_unit(Fr& F, int cidx, int hh, int d, int l) {
    bf16_t* VT = (bf16_t*)(F.lds + LDS_VT); bf16_t* KT = (bf16_t*)(F.lds + LDS_KT); float* fs = (float*)(F.lds + LDS_FS);
    const int tid = F.tid, lane = F.lane, w = F.wave, fr = lane & 15, fq = lane >> 4;
    const size_t R0 = (size_t)cidx * 128; int b, slot; chunk_bs(cidx, b, slot); const int uidx = unit_idx(b, hh, d, slot);
    if (tid < 128) { const float* gb = F.ap->in[I_GATEB] + l * 16; const bf16_t* prow = F_P + (R0 + tid) * NP;
        const float xx = bf2f(prow[C_GF + d * 4 + hh]) + gb[d * 8 + 4 + hh];
        fs[tid] = fminf(xx, 0.f) - __logf(1.f + __expf(-fabsf(xx))); fs[128 + tid] = bf2f(prow[C_GI + d * 4 + hh]) + gb[d * 8 + hh]; }
    __syncthreads();
    float wend = 0.f, gtot = 0.f;
    {
        float lfv = tid < 128 ? fs[tid] : 0.f, p = lfv;
#pragma unroll
        for (int o = 1; o < 64; o <<= 1) { const float t = __shfl_up(p, o); if (lane >= o) p += t; }
        if (tid < 128 && lane == 63) fs[512 + w] = p;
        __syncthreads();
        const float tot0 = fs[512], tot1 = fs[513]; gtot = tot0 + tot1;
        const float bf_ = p + (w == 1 ? tot0 : 0.f);
        const float bsum = d == 0 ? bf_ : gtot - bf_ + lfv;
        wend = tid < 128 ? gtot - bsum + fs[128 + tid] : -3.0e38f;
        float mx = wend;
#pragma unroll
        for (int o = 1; o < 64; o <<= 1) mx = fmaxf(mx, __shfl_xor(mx, o));
        if (tid < 128 && lane == 0) fs[514 + w] = mx;
        __syncthreads();
        const float m = fmaxf(fs[514], fs[515]);
        if (tid < 128) { fs[384 + tid] = __expf(wend - m) * QK_SCALE;
            if (tid == 0) { F_GT[uidx] = gtot; F_MLOC[uidx] = m; } }
    }
    stage_vt(F, VT, R0, hh);
    __syncthreads();
    { const int l4 = tid & 31, c8 = tid >> 5;
        const bf16_t* src = F_P + (R0 + 4 * l4) * NP + C_MK + hh * 128 + c8 * 8;
        const bf16x8 r0 = *(const bf16x8*)(src), r1 = *(const bf16x8*)(src + NP), r2 = *(const bf16x8*)(src + 2 * NP), r3 = *(const bf16x8*)(src + 3 * NP);
        const float e0 = fs[384 + 4 * l4], e1 = fs[385 + 4 * l4], e2 = fs[386 + 4 * l4], e3 = fs[387 + 4 * l4];
#pragma unroll
        for (int i = 0; i < 8; ++i) { u32x2 w; w.x = pk2(bfs2f(r0[i]) * e0, bfs2f(r1[i]) * e1); w.y = pk2(bfs2f(r2[i]) * e2, bfs2f(r3[i]) * e3);
            *(u32x2*)(KT + (c8 * 8 + i) * VS + 4 * l4) = w; } }
    __syncthreads();
    f32x4 acc[2][8];
#pragma unroll
    for (int vi = 0; vi < 2; ++vi)
#pragma unroll
        for (int kb = 0; kb < 8; ++kb) acc[vi][kb] = (f32x4){0.f, 0.f, 0.f, 0.f};
#pragma unroll
    for (int lb = 0; lb < 4; ++lb) {
        bf16x8 xf[2];
#pragma unroll
        for (int vi = 0; vi < 2; ++vi) xf[vi] = *(const bf16x8*)(VT + (32 * w + 16 * vi + fr) * VS + lb * 32 + 8 * fq);
#pragma unroll
        for (int kb = 0; kb < 8; ++kb) { const bf16x8 yf = *(const bf16x8*)(KT + (16 * kb + fr) * VS + lb * 32 + 8 * fq);
#pragma unroll
            for (int vi = 0; vi < 2; ++vi) acc[vi][kb] = __builtin_amdgcn_mfma_f32_16x16x32_bf16(yf, xf[vi], acc[vi][kb], 0, 0, 0); }
    }
    bf16_t* Cst = F_CST + (size_t)uidx * 32768;
    __syncthreads();
#pragma unroll
    for (int vi = 0; vi < 2; ++vi)
#pragma unroll
        for (int kb = 0; kb < 8; ++kb)
        { u32x2 pk; pk.x = pk2(acc[vi][kb][0], acc[vi][kb][1]); pk.y = pk2(acc[vi][kb][2], acc[vi][kb][3]); *(u32x2*)(VT + (32 * w + 16 * vi + fr) * VS + 16 * kb + 4 * fq) = pk; }
    __syncthreads();
#pragma unroll
    for (int i = 0; i < 8; ++i) { const int idx = tid + 512 * i; *(u32x4*)(Cst + (idx >> 4) * 128 + (idx & 15) * 8) = *(const u32x4*)(VT + (idx >> 4) * VS + (idx & 15) * 8); }
    { const int k = tid >> 2, part = tid & 3; float sacc = 0.f;
#pragma unroll
        for (int q = 0; q < 4; ++q) { const bf16x8 t8 = *(const bf16x8*)(KT + k * VS + part * 32 + q * 8);
#pragma unroll
            for (int i = 0; i < 8; ++i) sacc += bfs2f(t8[i]); }
        sacc += __shfl_xor(sacc, 1); sacc += __shfl_xor(sacc, 2);
        if (part == 0) F_NST[(size_t)uidx * 128 + k] = sacc; }
    __syncthreads();
}
__device__ __forceinline__ int scan_slot(int d, int step) { return d == 0 ? step : (step == 0 ? 1 : (step == 1 ? 0 : 35 - step)); }
__device__ __forceinline__ void phase_scan(Fr& F, const bool dost = true) {
    const long nth = (long)F.G * 512;
    for (long gid = (long)F.bx * 512 + F.tid; gid < 32 * 4096; gid += nth) {
        const int seq = (int)(gid >> 12), vec = (int)(gid & 4095), d = seq & 1;
        bf16_t* base = F_CST + (size_t)seq * NSLOT * 32768 + vec * 8;
        float* nbase = F_NST + (size_t)seq * NSLOT * 128 + (vec & 15) * 8;
        const bool hasn = vec < 16;
        float z0 = 0.f; asm volatile("" : "+v"(z0));
        float st[8] = {z0, z0, z0, z0, z0, z0, z0, z0}, sn[8] = {z0, z0, z0, z0, z0, z0, z0, z0}; float m = 0.f;
        int slot = scan_slot(d, 0), slot1 = scan_slot(d, 1);
        bf16x8 cl = *(const bf16x8*)(base + (size_t)slot * 32768), cl1 = *(const bf16x8*)(base + (size_t)slot1 * 32768);
        f32x4 n0 = {0.f, 0.f, 0.f, 0.f}, n1 = {0.f, 0.f, 0.f, 0.f}, p0 = n0, p1 = n0;
        if (hasn) { n0 = *(const f32x4*)(nbase + slot * 128); n1 = *(const f32x4*)(nbase + slot * 128 + 4); p0 = *(const f32x4*)(nbase + slot1 * 128); p1 = *(const f32x4*)(nbase + slot1 * 128 + 4); }
        float g = F_GT[seq * NSLOT + slot], mc = F_MLOC[seq * NSLOT + slot], g1 = F_GT[seq * NSLOT + slot1], mc1 = F_MLOC[seq * NSLOT + slot1];
#pragma unroll 1
        for (int step = 0; step < NSLOT; ++step) {
            const int slot2 = scan_slot(d, step + 2 < NSLOT ? step + 2 : NSLOT - 1);
            const bool ld2 = step + 2 < NSLOT;
            bf16x8 cl2 = cl1; f32x4 q0 = p0, q1 = p1; float g2 = g1, mc2 = mc1;
            if (ld2) { cl2 = *(const bf16x8*)(base + (size_t)slot2 * 32768);
                if (hasn) { q0 = *(const f32x4*)(nbase + slot2 * 128); q1 = *(const f32x4*)(nbase + slot2 * 128 + 4); }
                g2 = F_GT[seq * NSLOT + slot2]; mc2 = F_MLOC[seq * NSLOT + slot2]; }
            asm volatile("" ::: "memory");
            if (dost) { u32x4 o; o.x = pk2(st[0], st[1]); o.y = pk2(st[2], st[3]); o.z = pk2(st[4], st[5]); o.w = pk2(st[6], st[7]);
                *(u32x4*)(base + (size_t)slot * 32768) = o;
                if (hasn) { *(f32x4*)(nbase + slot * 128) = (f32x4){sn[0], sn[1], sn[2], sn[3]}; *(f32x4*)(nbase + slot * 128 + 4) = (f32x4){sn[4], sn[5], sn[6], sn[7]}; } }
            if (vec == 0) F_MIN[seq * NSLOT + slot] = m;
            const float mn = fmaxf(g + m, mc), a = __expf(g + m - mn), s = __expf(mc - mn);
#pragma unroll
            for (int i = 0; i < 8; ++i) st[i] = a * st[i] + s * bfs2f(cl[i]);
#pragma unroll
            for (int i = 0; i < 4; ++i) { sn[i] = a * sn[i] + s * n0[i]; sn[4 + i] = a * sn[4 + i] + s * n1[i]; }
            m = mn; cl = cl1; n0 = p0; n1 = p1; g = g1; mc = mc1; slot = slot1;
            cl1 = cl2; p0 = q0; p1 = q1; g1 = g2; mc1 = mc2; slot1 = slot2; }
    }
}
__device__ __forceinline__ void mls_out_unit(Fr& F, int cidx, int hh, int l, const bool dost = true) {
    bf16_t* VT = (bf16_t*)(F.lds + LDS_VT); bf16_t* Kc = (bf16_t*)(F.lds + LDS_KT); float* fs = (float*)(F.lds + LDS_FS);
    float* lf_s = fs; float* li_s = fs + 256; float* csrc = fs + 512; float* mm = fs + 768; float* bj = fs + 1024;
    bf16_t* Ch = (bf16_t*)(F.lds + LDS_CH);
    const int tid = F.tid, lane = F.lane, w = F.wave, fr = lane & 15, fq = lane >> 4;
    const size_t R0 = (size_t)cidx * 128; int b, slot; chunk_bs(cidx, b, slot);
    if (tid < 256) { const int dd = tid >> 7, t = tid & 127; lf_s[tid] = F_LF[(R0 + t) * 8 + dd * 4 + hh]; li_s[tid] = F_LI[(R0 + t) * 8 + dd * 4 + hh]; }
    stage_vt(F, VT, R0, hh);
    for (int idx = tid; idx < 2048; idx += 512) { const int l2 = idx >> 4, c8 = idx & 15;
        *(bf16x8*)(Kc + l2 * VS + c8 * 8) = *(const bf16x8*)(F_P + (R0 + l2) * NP + C_MK + hh * 128 + c8 * 8); }
    __syncthreads();
    {
        float* tmp = (float*)(F.lds + LDS_CH);
        const bool act = tid < 256; const int dd = (tid >> 7) & 1, wp = w & 1;
        const float lfv = act ? lf_s[tid] : 0.f; float p = lfv;
#pragma unroll
        for (int o = 1; o < 64; o <<= 1) { const float t = __shfl_up(p, o); if (lane >= o) p += t; }
        if (act && lane == 63) tmp[w] = p;
        __syncthreads();
        const float t0 = tmp[2 * dd], t1 = tmp[2 * dd + 1], gt_ = t0 + t1;
        const float bfwd = p + (wp ? t0 : 0.f);
        const float bsum = dd == 0 ? bfwd : gt_ - bfwd + lfv;
        const float cs = act ? li_s[tid] - bsum : -3.0e38f;
        float pmx = cs, smx = cs;
#pragma unroll
        for (int o = 1; o < 64; o <<= 1) { const float a = __shfl_up(pmx, o), c = __shfl_down(smx, o); if (lane >= o) pmx = fmaxf(pmx, a); if (lane + o < 64) smx = fmaxf(smx, c); }
        if (act && lane == 63) tmp[4 + w] = pmx;
        __syncthreads();
        if (act) { const float other = tmp[4 + (w ^ 1)];
            float cm = dd == 0 ? (wp ? fmaxf(pmx, other) : pmx) : (wp ? smx : fmaxf(smx, other));
            cm = fmaxf(cm, F_MIN[unit_idx(b, hh, dd, slot)]);
            bj[tid] = bsum; csrc[tid] = cs; mm[tid] = cm; }
    }
    __syncthreads();
    const int j = 16 * w + fr;
    const bf16_t* prow = F_P + (R0 + j) * NP;
    f32x4 acc[16];
#pragma unroll
    for (int vb = 0; vb < 16; ++vb) acc[vb] = (f32x4){0.f, 0.f, 0.f, 0.f};
#pragma unroll 1
    for (int dd = 0; dd < 2; ++dd) {
        int jj = j; asm volatile("" : "+v"(jj));
        bf16x8 Yq[4];
#pragma unroll
        for (int kb = 0; kb < 4; ++kb) Yq[kb] = *(const bf16x8*)(F_P + (R0 + jj) * NP + C_MQ + hh * 128 + kb * 32 + 8 * fq);
        const int sgn = dd == 0 ? 1 : -1; const int bs = (4 * fq - jj) * sgn;
        const int uidx = unit_idx(b, hh, dd, slot);
        const bf16_t* Cin = F_CST + (size_t)uidx * 32768;
        const float m_in = F_MIN[uidx], mmj = mm[dd * 128 + j], bjj = bj[dd * 128 + j];
        f32x4 Sa[8];
#pragma unroll
        for (int sb = 0; sb < 8; ++sb) { Sa[sb] = (f32x4){0.f, 0.f, 0.f, 0.f};
#pragma unroll
            for (int kb = 0; kb < 4; ++kb) { const bf16x8 kf = *(const bf16x8*)(Kc + (16 * sb + fr) * VS + kb * 32 + 8 * fq);
                Sa[sb] = __builtin_amdgcn_mfma_f32_16x16x32_bf16(kf, Yq[kb], Sa[sb], 0, 0, 0); }
            __builtin_amdgcn_sched_barrier(0); }
        float dsum = 0.f;
#pragma unroll
        for (int sb = 0; sb < 8; ++sb)
#pragma unroll
            for (int e = 0; e < 4; ++e) { const int s = 16 * sb + 4 * fq + e; const bool valid = (bs + sgn * (16 * sb + e)) <= 0;
                const float wv = valid ? __expf(csrc[dd * 128 + s] - mmj) * Sa[sb][e] * QK_SCALE : 0.f; Sa[sb][e] = wv; dsum += wv; }
        dsum += __shfl_xor(dsum, 16); dsum += __shfl_xor(dsum, 32);
        float nq = 0.f; const float* nst = F_NST + (size_t)uidx * 128;
#pragma unroll
        for (int kb = 0; kb < 4; ++kb) { const f32x4 n0 = *(const f32x4*)(nst + kb * 32 + 8 * fq), n1 = *(const f32x4*)(nst + kb * 32 + 8 * fq + 4);
            nq += bfs2f(Yq[kb][0]) * n0[0] + bfs2f(Yq[kb][1]) * n0[1] + bfs2f(Yq[kb][2]) * n0[2] + bfs2f(Yq[kb][3]) * n0[3]
                + bfs2f(Yq[kb][4]) * n1[0] + bfs2f(Yq[kb][5]) * n1[1] + bfs2f(Yq[kb][6]) * n1[2] + bfs2f(Yq[kb][7]) * n1[3]; }
        nq += __shfl_xor(nq, 16); nq += __shfl_xor(nq, 32);
        const float inter = __expf(m_in - mmj);
        const float den = dsum + inter * nq;
        const float rden = 1.f / fmaxf(fabsf(den), __expf(-(bjj + mmj)));
        bf16x8 Wf[4], Yqs[4]; const float qsc = inter * rden;
#pragma unroll
        for (int kb = 0; kb < 4; ++kb) {
            u32x4 t; t.x = pk2(Sa[2 * kb][0] * rden, Sa[2 * kb][1] * rden); t.y = pk2(Sa[2 * kb][2] * rden, Sa[2 * kb][3] * rden);
            t.z = pk2(Sa[2 * kb + 1][0] * rden, Sa[2 * kb + 1][1] * rden); t.w = pk2(Sa[2 * kb + 1][2] * rden, Sa[2 * kb + 1][3] * rden);
            Wf[kb] = *reinterpret_cast<bf16x8*>(&t);
            u32x4 q; q.x = pk2(bfs2f(Yq[kb][0]) * qsc, bfs2f(Yq[kb][1]) * qsc); q.y = pk2(bfs2f(Yq[kb][2]) * qsc, bfs2f(Yq[kb][3]) * qsc);
            q.z = pk2(bfs2f(Yq[kb][4]) * qsc, bfs2f(Yq[kb][5]) * qsc); q.w = pk2(bfs2f(Yq[kb][6]) * qsc, bfs2f(Yq[kb][7]) * qsc);
            Yqs[kb] = *reinterpret_cast<bf16x8*>(&q); }
        bf16x8 pr[4];
#pragma unroll
        for (int i = 0; i < 4; ++i) { const int idx = tid + 512 * i; pr[i] = *(const bf16x8*)(Cin + (idx >> 4) * 128 + (idx & 15) * 8); }
#pragma unroll
        for (int h = 0; h < 2; ++h) {
            __syncthreads();
#pragma unroll
            for (int i = 0; i < 4; ++i) { const int idx = tid + 512 * i; *(bf16x8*)(Ch + (idx >> 4) * VS + (idx & 15) * 8) = pr[i]; }
            if (h == 0) {
#pragma unroll
                for (int i = 0; i < 4; ++i) { const int idx = tid + 512 * i; pr[i] = *(const bf16x8*)(Cin + (128 + (idx >> 4)) * 128 + (idx & 15) * 8); } }
            __syncthreads();
#pragma unroll
            for (int v8 = 0; v8 < 8; ++v8) { const int vb = 8 * h + v8;
#pragma unroll
                for (int kb = 0; kb < 4; ++kb) { const bf16x8 cf = *(const bf16x8*)(Ch + (16 * v8 + fr) * VS + kb * 32 + 8 * fq);
                    acc[vb] = __builtin_amdgcn_mfma_f32_16x16x32_bf16(cf, Yqs[kb], acc[vb], 0, 0, 0); }
#pragma unroll
                for (int kb = 0; kb < 4; ++kb) {
                    const u32x2 lo = *(const u32x2*)(VT + (16 * vb + fr) * VS + 32 * kb + 4 * fq), hi2 = *(const u32x2*)(VT + (16 * vb + fr) * VS + 32 * kb + 16 + 4 * fq);
                    u32x4 t; t.x = lo.x; t.y = lo.y; t.z = hi2.x; t.w = hi2.y;
                    acc[vb] = __builtin_amdgcn_mfma_f32_16x16x32_bf16(*reinterpret_cast<bf16x8*>(&t), Wf[kb], acc[vb], 0, 0, 0); }
                __builtin_amdgcn_sched_barrier(0);
            }
        }
    }
    float ss = 0.f;
#pragma unroll
    for (int vb = 0; vb < 16; ++vb) ss += (acc[vb][0] * acc[vb][0] + acc[vb][1] * acc[vb][1]) + (acc[vb][2] * acc[vb][2] + acc[vb][3] * acc[vb][3]);
    ss += __shfl_xor(ss, 16); ss += __shfl_xor(ss, 32);
    const float rinv = 1.f / sqrtf(ss * (1.f / 256.f) + EPS);
    const float* hg = F.ap->in[I_MLHG] + l * 1024 + hh * 256;
    bf16_t* orow = F_P + (R0 + j) * NP + C_O + hh * 256;
#pragma unroll
    for (int vb = 0; vb < 16; ++vb) { const int v0 = 16 * vb + 4 * fq;
        const u32x2 oraw = *(const u32x2*)(orow + v0); const f32x4 g4 = *(const f32x4*)(hg + v0);
        const float o0 = __uint_as_float(oraw.x << 16), o1 = __uint_as_float(oraw.x & 0xffff0000u), o2 = __uint_as_float(oraw.y << 16), o3 = __uint_as_float(oraw.y & 0xffff0000u);
        u32x2 wv; wv.x = pk2(acc[vb][0] * rinv * g4[0] * sigmoidf_(o0), acc[vb][1] * rinv * g4[1] * sigmoidf_(o1));
        wv.y = pk2(acc[vb][2] * rinv * g4[2] * sigmoidf_(o2), acc[vb][3] * rinv * g4[3] * sigmoidf_(o3));
        if (dost) *(u32x2*)(orow + v0) = wv; }
    __syncthreads();
}

#ifndef PHM
#define PHM 0xFFFF
#endif
#ifndef DUPM
#define DUPM 0
#endif
#define DOST (rep_ == ((DUPM >> RB_) & 1))
#define REP(bit) for (int rep_ = 0, RB_ = (bit); rep_ < ((DUPM >> (bit)) & 1) + 1; ++rep_)
#define GSYNC() do { ArgsP sa_ = (ArgsP)__builtin_amdgcn_kernarg_segment_ptr(); asm volatile("" : "+s"(sa_)); \
    XcdBarrier xb_; xb_.bar = (unsigned*)sa_->ws; xb_.x = xb_xcc_id(); xb_.st = misc; xcd_barrier(xb_); if (DUPM & 0x8000) xcd_barrier(xb_); } while (0)
__global__ void __launch_bounds__(512, 2) fwd_megakernel(Args args) {
    extern __shared__ __attribute__((aligned(16))) unsigned char lds_raw[];
    cg::grid_group grid = cg::this_grid();
    Fr F;
    F.lds = (char*)lds_raw; F.tid = threadIdx.x; F.lane = F.tid & 63; F.wave = __builtin_amdgcn_readfirstlane(F.tid >> 6);
    F.G = gridDim.x; F.bx = blockIdx.x; { const int bx = blockIdx.x; F.vcu = (F.G % 8 == 0) ? (bx % 8) * (F.G / 8) + bx / 8 : bx; }
    F.gw = F.bx * 8 + F.wave; F.NGW = F.G * 8;
    F.ap = (ArgsP)__builtin_amdgcn_kernarg_segment_ptr();
    LAS unsigned char* lds3 = (LAS unsigned char*)lds_raw;
#define PHB() do { int t_ = threadIdx.x; asm volatile("" : "+v"(t_)); F.tid = t_; F.lane = t_ & 63; F.wave = __builtin_amdgcn_readfirstlane(t_ >> 6); \
    ArgsP a_ = (ArgsP)__builtin_amdgcn_kernarg_segment_ptr(); asm volatile("" : "+s"(a_)); F.ap = a_; \
    unsigned lo_ = 0u; asm volatile("" : "+s"(lo_)); F.lds3 = lds3 + lo_; F.lds = (char*)F.lds3; \
    int bx_ = blockIdx.x, g_ = gridDim.x; asm volatile("" : "+s"(bx_), "+s"(g_)); F.bx = bx_; F.G = g_; F.vcu = (g_ % 8 == 0) ? (bx_ % 8) * (g_ / 8) + bx_ / 8 : bx_; F.gw = bx_ * 8 + F.wave; F.NGW = g_ * 8; } while (0)

#if PHM & (1<<0)
    volatile LAS unsigned* misc = (volatile LAS unsigned*)(lds3 + LDS_BYTES - 256);
    if (threadIdx.x < 2) misc[threadIdx.x] = 0u;
    if (blockIdx.x == 0) { unsigned* bw = (unsigned*)WSB; for (int i = threadIdx.x; i < XCD_BAR_WORDS; i += 512) __hip_atomic_store(bw + i, 0u, __ATOMIC_RELAXED, __HIP_MEMORY_SCOPE_AGENT); }
    __syncthreads();
    REP(0) { PHB();
    mod_gemv(F);
    convert_weights(F, 0); }
#endif
    __threadfence(); grid.sync();
    (void)xcd_barrier_post((unsigned*)WSB, misc);
#if PHM & (1<<1)
    REP(1) { PHB();
    phase_norm1(F, 0, F.ap->in[I_X], F.ap->in[I_CTX]); }
#endif
    GSYNC();

    for (int l = 0; l < 2; ++l) {
        const bool last = (l == 1);
        const int nMall = last ? 64 : 68;
#if PHM & (1<<2)
        PHB();
        REP(2)
        { PHB(); pg8::Gemm g{F_H, F_H, F_H, (const bf16_t*)(WSB + WS_WIN), (const bf16_t*)(WSB + WS_WIN), (const bf16_t*)(WSB + WS_WIN), D, D, 0};
          pg8::Sched S; if (!last) S.init(68, 47, 1, F.G, F.bx); else S.init(64, 47, 1, F.G, F.bx, 64, 4, 9);
          pg8::EpiWin E{F_P, (unsigned char*)(WSB + WS_G8)};
          pg8::gemm_phase<pg8::EpiWin>(F.lds3, g, S, E, F.tid); }
#endif
        GSYNC();
#if PHM & (1<<3)
        REP(3) { PHB();
        phase_prep(F, l, DOST); }
#endif
        __syncthreads();
#if PHM & (1<<5)
        REP(5) { PHB();
        for (int u = F.G - 1 - F.bx; u < 136 * 8; u += F.G) { const int cidx = u >> 3, hh = (u >> 1) & 3, d = u & 1; mls_cloc_unit(F, cidx, hh, d, l); } }
#endif
        GSYNC();
#if PHM & (1<<4)
        REP(4)
        { PHB(); const bf16_t* wp = (const bf16_t*)(WSB + WS_WPL);
          pg8::Gemm g{F_MIX, F_MIX, F_MIX, wp, wp, wp, 1024, 256, 512};
          pg8::Sched S; S.init(nMall, 4, 1, F.G, F.G - 1 - F.bx);
          pg8::EpiBf16 E{F_P + C_PL, NP};
          pg8::gemm_phase<pg8::EpiBf16>(F.lds3, g, S, E, F.tid); }
#endif
        __syncthreads();
#if PHM & (1<<6)
        REP(6) { PHB();
        phase_scan(F, DOST); }
#endif
        GSYNC();
        { const int nchunk = last ? 128 : 136;
#if PHM & (1<<7)
          REP(7) { PHB();
          for (int u = F.bx; u < nchunk * 4; u += F.G) mls_out_unit(F, u >> 2, u & 3, l, DOST); }
#endif
#if PHM & (1<<8)
          REP(8) { PHB();
          const int nun = last ? 512 : 544;
          for (int u = F.vcu; u < nun; u += F.G) {
              if (u < 512) { const int qb = u & 15, hq = (u >> 4) & 3, kvh = (u >> 6) & 1, b = u >> 7, h = kvh * 4 + hq;
                  const size_t rq = (size_t)b * SEQ + qb * 256, rk = (size_t)b * SEQ, rc = (size_t)ML + b * CTXL;
                  att::attn_dense_body(F_P + rq * NP + C_AQ + h * 128, F_P + rk * NP + C_AK + kvh * 128,
                                       F_P + rc * NP + C_AK + kvh * 128, 64, F_P + rq * NP + C_AQ + h * 128, 68, F.lds, F.tid, DOST);
              } else { const int v = u - 512, b = v >> 3, h = v & 7, kvh = h >> 2; const size_t rc = (size_t)ML + b * CTXL;
                  att::attn_dense_body(F_P + rc * NP + C_AQ + h * 128, F_P + rc * NP + C_AK + kvh * 128,
                                       F_P + rc * NP + C_AK + kvh * 128, 4, F_P + rc * NP + C_AQ + h * 128, 4, F.lds, F.tid, DOST); }
          } }
#endif
        }
        GSYNC();
#if PHM & (1<<9)
        PHB();
        REP(9)
        { PHB(); const bf16_t* wu = (const bf16_t*)(WSB + WS_WUP);
          pg8::Gemm g{F_P + C_AQ, F_P + C_O, F_P + C_PL, wu, wu + (size_t)D * 1024, wu + (size_t)2 * D * 1024, NP, 1024, 0};
          pg8::Sched S; S.init(nMall, 8, 3, F.G, F.bx);
          pg8::EpiGate E{(const unsigned char*)(WSB + WS_G8), F_H};
          pg8::gemm_phase<pg8::EpiGate>(F.lds3, g, S, E, F.tid); }
#endif
        GSYNC();
#if PHM & (1<<10)
        PHB();
        REP(10)
        { PHB(); const bf16_t* wo = (const bf16_t*)(WSB + WS_WOUT);
          pg8::Gemm g{F_H, F_H, F_H, wo, wo, wo, D, D, 0};
          pg8::Sched S; S.init(nMall, 8, 1, F.G, F.bx);
          pg8::EpiBf16 E{(bf16_t*)(WSB + WS_YO), D};
          pg8::gemm_phase<pg8::EpiBf16>(F.lds3, g, S, E, F.tid); }
#endif
        GSYNC();
#if PHM & (1<<11)
        REP(11) { PHB();
        phase_resid(F, l, 0, nMall * 256, F.ap->in[I_X], l == 0 ? F.ap->in[I_CTX] : F_XC, false, l != 0, true, DOST); }
#endif
        GSYNC();
#if PHM & (1<<12)
        PHB();
        REP(12)
        { PHB(); const bf16_t* wf = (const bf16_t*)(WSB + WS_WFI);
          pg8::Gemm g{F_H, F_H, F_H, wf, wf, wf, D, D, 0};
          pg8::Sched S; S.init(nMall, 44, 1, F.G, F.bx);
          pg8::EpiSwiglu E{(bf16_t*)(WSB + WS_HID)};
          pg8::gemm_phase<pg8::EpiSwiglu>(F.lds3, g, S, E, F.tid); }
#endif
        GSYNC();
#if PHM & (1<<13)
        PHB();
        REP(13)
        { PHB(); const bf16_t* wf = (const bf16_t*)(WSB + WS_WFO); const bf16_t* hid = (const bf16_t*)(WSB + WS_HID);
          pg8::Gemm g{hid, hid, hid, wf, wf, wf, DFF, DFF, 0};
          pg8::Sched S; S.init(nMall, 8, 1, F.G, F.bx);
          pg8::EpiBf16 E{(bf16_t*)(WSB + WS_YO), D};
          pg8::gemm_phase<pg8::EpiBf16>(F.lds3, g, S, E, F.tid); }
#endif
        GSYNC();
#if PHM & (1<<14)
        REP(14) { PHB();
        phase_resid(F, l, 1, nMall * 256, F.ap->in[I_X], F_XC, !last, true, !last, DOST);
        if (!last) { __syncthreads(); convert_weights(F, 1); } }
#endif
        GSYNC();
    }
}

extern "C" void kernel_launch(void* const* d_in, const int* in_sizes, int n_in, void* d_out, int out_size, void* d_ws, size_t ws_size, hipStream_t stream) {
    static int grid = 0;
    if (grid == 0) {
        if (n_in != 19 || out_size != ML * D || ws_size < WS_END) { fprintf(stderr, "kernel_launch: unexpected shapes n_in %d out %d ws %zu (need %zu)\n", n_in, out_size, ws_size, (size_t)WS_END); grid = -1; return; }
        int dev = 0, cus = 0, per_cu = 0;
        hipGetDevice(&dev); hipDeviceGetAttribute(&cus, hipDeviceAttributeMultiprocessorCount, dev);
        if (hipFuncSetAttribute((const void*)fwd_megakernel, hipFuncAttributeMaxDynamicSharedMemorySize, LDS_BYTES) != hipSuccess) { fprintf(stderr, "kernel_launch: hipFuncSetAttribute failed\n"); grid = -1; return; }
        if (hipOccupancyMaxActiveBlocksPerMultiprocessor(&per_cu, (const void*)fwd_megakernel, 512, LDS_BYTES) != hipSuccess || per_cu < 1) { fprintf(stderr, "kernel_launch: occupancy query gave %d\n", per_cu); per_cu = 1; }
        (void)hipGetLastError();
        grid = cus * 1;
        fprintf(stderr, "kernel_launch: cus %d per_cu %d grid %d\n", cus, per_cu, grid);
    }
    if (grid < 0) return;
    Args a{};
    for (int i = 0; i < 19; ++i) a.in[i] = (const float*)d_in[i];
    a.out = (float*)d_out; a.ws = (unsigned char*)d_ws;
    void* kargs[] = {&a};
    hipError_t e = hipLaunchCooperativeKernel((const void*)fwd_megakernel, dim3(grid), dim3(512), kargs, LDS_BYTES, stream);
    if (e != hipSuccess) fprintf(stderr, "cooperative launch failed: %s (grid %d)\n", hipGetErrorString(e), grid);
}
```

```cpp
#include <hip/hip_runtime.h>
#include <hip/hip_cooperative_groups.h>
#include <cstdio>
#include <cstdint>
namespace cg = cooperative_groups;

#define LAS __attribute__((address_space(3)))
typedef unsigned short bf16_t;
typedef short bf16x8 __attribute__((ext_vector_type(8)));
typedef short s16x4 __attribute__((ext_vector_type(4)));
typedef float f32x4 __attribute__((ext_vector_type(4)));
typedef float f32x16 __attribute__((ext_vector_type(16)));
typedef unsigned u32x4 __attribute__((ext_vector_type(4)));
typedef unsigned u32x2 __attribute__((ext_vector_type(2)));

constexpr int D = 2048, NB = 4, SEQ = 4096, CTXL = 256;
constexpr int ML = NB * SEQ, MC = NB * CTXL, MT = ML + MC;
constexpr int DIN = 11792, NP = 5888, NWIN = 12032, NG = 6144, DFF = 5632;
constexpr int C_AK = 0, C_AV = 256, C_MK = 512, C_MV = 1024, C_GI = 2048, C_GF = 2056, C_AQ = 2064, C_MQ = 3088, C_O = 3600, C_PL = 4624, C_GRAW = 5648;
constexpr float EPS = 1e-6f;
constexpr int NSLOT = 34, NUNIT = NB * 4 * 2 * NSLOT;
constexpr float QK_SCALE = 0.08838834764831845f;

constexpr size_t MiB = 1u << 20;
constexpr size_t WS_MOD = 1 * MiB;
constexpr size_t WS_LI = 2 * MiB;
constexpr size_t WS_LF = 3 * MiB;
constexpr size_t WS_GT = 4 * MiB;
constexpr size_t WS_NST = 5 * MiB;
constexpr size_t WS_WIN = 6 * MiB;
constexpr size_t WS_WFI = 54 * MiB;
constexpr size_t WS_WFO = 98 * MiB;
constexpr size_t WS_WUP = 120 * MiB;
constexpr size_t WS_WOUT = 132 * MiB;
constexpr size_t WS_WPL = 140 * MiB;
constexpr size_t WS_XC = 141 * MiB;
constexpr size_t WS_H = 149 * MiB;
constexpr size_t WS_P = 217 * MiB;
constexpr size_t WS_MIX = 617 * MiB;
constexpr size_t WS_CST = 651 * MiB;
constexpr size_t WS_XB = 719 * MiB;
constexpr size_t WS_END = 783 * MiB;
constexpr size_t WS_YO = WS_P;
constexpr size_t WS_G8 = WS_P + 196 * MiB;
constexpr size_t WS_HID = WS_P + 160 * MiB;

constexpr int LDS_BYTES = 147456;

__device__ __forceinline__ float bf2f(bf16_t v) { return __uint_as_float((unsigned)v << 16); }
__device__ __forceinline__ float bfs2f(short v) { return __uint_as_float(((unsigned)(unsigned short)v) << 16); }
typedef float f32x2_t __attribute__((ext_vector_type(2))); typedef __bf16 bf16x2_t __attribute__((ext_vector_type(2)));
__device__ __forceinline__ unsigned pk2(float lo, float hi) { const f32x2_t v = {lo, hi}; const bf16x2_t b = __builtin_convertvector(v, bf16x2_t); return __builtin_bit_cast(unsigned, b); }
__device__ __forceinline__ unsigned f2bf(float f) { return pk2(f, 0.f) & 0xffffu; }
__device__ __forceinline__ float wave_sum(float v) {
#pragma unroll
    for (int o = 1; o < 64; o <<= 1) v += __shfl_xor(v, o);
    return v;
}
__device__ __forceinline__ float sigmoidf_(float x) { return __builtin_amdgcn_rcpf(1.f + __expf(-x)); }

struct Args { const float* in[19]; float* out; unsigned char* ws; };
enum { I_X = 0, I_C, I_CTX, I_CCTX, I_WMOD, I_BMOD, I_NORMG, I_WIN, I_GATEB, I_QKG, I_MLHG, I_POOLW, I_POOLS, I_UPA, I_UPM, I_UPP, I_WOUT, I_FFI, I_FFO };

namespace pg8 {
constexpr int BM = 256, BK = 64, HALF = 128, HTB = HALF * BK * 2, STAGE_BYTES = 8 * HTB, NXCD = 8, WGM = 8;
__host__ __device__ __forceinline__ int lds_byte(int r, int c) { const int st = (r >> 4) * 2 + (c >> 5), rr = r & 15, cc = c & 31, ob = rr * 64 + cc * 2; return st * 1024 + (ob ^ (((ob >> 9) & 1) << 5)); }
__host__ __device__ __forceinline__ void stage_rc(int b, int& R, int& C) { const int st = b / 1024, sb = b % 1024, swz = sb ^ (((sb >> 9) & 1) << 5); R = (st >> 1) * 16 + swz / 64; C = (st & 1) * 32 + (swz % 64) / 2; }
__host__ __device__ __forceinline__ int perm32(int rho) { const int n = rho >> 4, i = rho & 15; return 8 * (i >> 2) + 4 * n + (i & 3); }

struct Unit { int pm, pn, br; };
struct Gemm { const bf16_t* A0; const bf16_t* A1; const bf16_t* A2; const bf16_t* B0; const bf16_t* B1; const bf16_t* B2; int lda; int K; int apn; };

struct Sched {
    int nM, nN, nBr, G, c, nT1, pm2, nM2, nT;
    __device__ void init(int nM_, int nN_, int nBr_, int G_, int c_, int pm2_ = 0, int nM2_ = 0, int nN2_ = 0) {
        nM = nM_; nN = nN_; nBr = nBr_; G = G_; c = c_; nT1 = nM * nN; pm2 = pm2_; nM2 = nM2_; nT = nT1 + nM2_ * nN2_; }
    __device__ bool next(int i, Unit& u) const {
        const int it = i / nBr; u.br = i - it * nBr;
        const long L = (long)it * G + c; if (L >= nT) return false;
        if (L < nT1) {
            int wgid = (int)L; { const int q = nT1 / NXCD, r = nT1 % NXCD, xcd = wgid % NXCD, off = wgid / NXCD; wgid = (xcd < r ? xcd * (q + 1) : r * (q + 1) + (xcd - r) * q) + off; }
            const int nig = WGM * nN, gid = wgid / nig, fm = gid * WGM, gsz = (nM - fm) < WGM ? (nM - fm) : WGM;
            u.pm = fm + ((wgid % nig) % gsz); u.pn = (wgid % nig) / gsz;
        } else { const int r = (int)L - nT1; u.pm = pm2 + r % nM2; u.pn = r / nM2; }
        return true;
    }
};

__device__ __forceinline__ unsigned cvt_pk_bf16(float lo, float hi) { return pk2(lo, hi); }

struct EpiBf16 {
    static constexpr bool PERM = true;
    bf16_t* O; int ldc;
    __device__ __forceinline__ bool operator()(f32x4 (&acc)[2][2][4][2], const Unit& u, int wr, int wc, int fr, int fq) const {
        const int row0 = u.pm * BM + wr * 64 + fr, col0 = u.pn * BM + wc * 32 + 8 * fq;
#pragma unroll
        for (int ai = 0; ai < 2; ++ai)
#pragma unroll
            for (int m = 0; m < 4; ++m) { bf16_t* rowp = O + (size_t)(row0 + ai * HALF + m * 16) * ldc + col0;
#pragma unroll
                for (int bj = 0; bj < 2; ++bj) { const f32x4 v0 = acc[ai][bj][m][0], v1 = acc[ai][bj][m][1];
                    u32x4 w; w.x = cvt_pk_bf16(v0[0], v0[1]); w.y = cvt_pk_bf16(v0[2], v0[3]); w.z = cvt_pk_bf16(v1[0], v1[1]); w.w = cvt_pk_bf16(v1[2], v1[3]);
                    *(u32x4*)(rowp + bj * HALF) = w; } }
        return false;
    }
};
struct EpiWin {
    static constexpr bool PERM = true;
    bf16_t* O; unsigned char* G8;
    __device__ __forceinline__ bool operator()(f32x4 (&acc)[2][2][4][2], const Unit& u, int wr, int wc, int fr, int fq) const {
        const int row0 = u.pm * BM + wr * 64 + fr;
        if (u.pn < 23) {
            const int col0 = u.pn * BM + wc * 32 + 8 * fq;
#pragma unroll
            for (int ai = 0; ai < 2; ++ai)
#pragma unroll
                for (int m = 0; m < 4; ++m) { bf16_t* rowp = O + (size_t)(row0 + ai * HALF + m * 16) * NP + col0;
#pragma unroll
                    for (int bj = 0; bj < 2; ++bj) { const f32x4 v0 = acc[ai][bj][m][0], v1 = acc[ai][bj][m][1];
                        u32x4 w; w.x = cvt_pk_bf16(v0[0], v0[1]); w.y = cvt_pk_bf16(v0[2], v0[3]); w.z = cvt_pk_bf16(v1[0], v1[1]); w.w = cvt_pk_bf16(v1[2], v1[3]);
                        *(u32x4*)(rowp + bj * HALF) = w; } }
        } else {
            const int col0 = (u.pn - 23) * BM + wc * 32 + 8 * fq;
#pragma unroll
            for (int ai = 0; ai < 2; ++ai)
#pragma unroll
                for (int m = 0; m < 4; ++m) { unsigned char* rowp = G8 + (size_t)(row0 + ai * HALF + m * 16) * NG + col0;
#pragma unroll
                    for (int bj = 0; bj < 2; ++bj) { unsigned q[8];
#pragma unroll
                        for (int n = 0; n < 2; ++n)
#pragma unroll
                            for (int e = 0; e < 4; ++e) { const float sg = 256.f * __builtin_amdgcn_rcpf(1.f + __expf(-acc[ai][bj][m][n][e])); q[4 * n + e] = (unsigned)fminf(sg, 255.f); }
                        u32x2 w; w.x = q[0] | (q[1] << 8) | (q[2] << 16) | (q[3] << 24); w.y = q[4] | (q[5] << 8) | (q[6] << 16) | (q[7] << 24);
                        *(u32x2*)(rowp + bj * HALF) = w; } }
        }
        return false;
    }
};
struct EpiF32 {
    static constexpr bool PERM = false;
    float* C; int ldc;
    __device__ __forceinline__ bool operator()(f32x4 (&acc)[2][2][4][2], const Unit& u, int wr, int wc, int fr, int fq) const {
        const int row0 = u.pm * BM + wr * 64 + fr, col0 = u.pn * BM + wc * 32 + 4 * fq;
#pragma unroll
        for (int ai = 0; ai < 2; ++ai)
#pragma unroll
            for (int m = 0; m < 4; ++m) { float* rowp = C + (size_t)(row0 + ai * HALF + m * 16) * ldc + col0;
#pragma unroll
                for (int bj = 0; bj < 2; ++bj)
#pragma unroll
                    for (int n = 0; n < 2; ++n) *(f32x4*)(rowp + bj * HALF + n * 16) = acc[ai][bj][m][n]; }
        return false;
    }
};
struct EpiSwiglu {
    static constexpr bool PERM = true;
    bf16_t* O;
    __device__ __forceinline__ bool operator()(f32x4 (&acc)[2][2][4][2], const Unit& u, int wr, int wc, int fr, int fq) const {
        const int row0 = u.pm * BM + wr * 64 + fr, col0 = u.pn * HALF + wc * 32 + 8 * fq;
#pragma unroll
        for (int ai = 0; ai < 2; ++ai)
#pragma unroll
            for (int m = 0; m < 4; ++m) { bf16_t* rowp = O + (size_t)(row0 + ai * HALF + m * 16) * DFF + col0;
                float r[8];
#pragma unroll
                for (int n = 0; n < 2; ++n)
#pragma unroll
                    for (int e = 0; e < 4; ++e) { const float g = acc[ai][0][m][n][e], up = acc[ai][1][m][n][e]; r[4 * n + e] = g * up * __builtin_amdgcn_rcpf(1.f + __expf(-g)); }
                u32x4 w; w.x = cvt_pk_bf16(r[0], r[1]); w.y = cvt_pk_bf16(r[2], r[3]); w.z = cvt_pk_bf16(r[4], r[5]); w.w = cvt_pk_bf16(r[6], r[7]);
                *(u32x4*)rowp = w; }
        return false;
    }
};
struct EpiGate {
    static constexpr bool PERM = true;
    const unsigned char* G8; bf16_t* Y;
    __device__ __forceinline__ bool operator()(f32x4 (&acc)[2][2][4][2], const Unit& u, int wr, int wc, int fr, int fq) const {
        const int row0 = u.pm * BM + wr * 64 + fr, col0 = u.pn * BM + wc * 32 + 8 * fq;
        const unsigned char* gp = G8 + (size_t)row0 * NG + u.br * D + col0;
        if (u.br < 2) {
#pragma unroll
            for (int ai = 0; ai < 2; ++ai)
#pragma unroll
                for (int m = 0; m < 4; ++m) { const unsigned char* rp = gp + (size_t)(ai * HALF + m * 16) * NG;
                    u32x2 ga[2], gb[2];
#pragma unroll
                    for (int bj = 0; bj < 2; ++bj) { ga[bj] = *(const u32x2*)(rp + bj * HALF); gb[bj] = *(const u32x2*)(rp + D + bj * HALF); }
#pragma unroll
                    for (int bj = 0; bj < 2; ++bj)
#pragma unroll
                        for (int n = 0; n < 2; ++n)
#pragma unroll
                            for (int e = 0; e < 4; ++e) { const float sa = (float)(((n ? ga[bj].y : ga[bj].x) >> (8 * e)) & 255u) + 0.5f, sb = (float)(((n ? gb[bj].y : gb[bj].x) >> (8 * e)) & 255u) + 0.5f;
                                acc[ai][bj][m][n][e] *= sa * __builtin_amdgcn_rcpf(sb); } }
            return true;
        }
#pragma unroll
        for (int ai = 0; ai < 2; ++ai)
#pragma unroll
            for (int m = 0; m < 4; ++m) { const size_t roff = (size_t)(ai * HALF + m * 16); const unsigned char* rp = gp + roff * NG;
                u32x2 ga[2];
#pragma unroll
                for (int bj = 0; bj < 2; ++bj) ga[bj] = *(const u32x2*)(rp + bj * HALF);
#pragma unroll
                for (int bj = 0; bj < 2; ++bj) { float r[8];
#pragma unroll
                    for (int n = 0; n < 2; ++n)
#pragma unroll
                        for (int e = 0; e < 4; ++e) r[4 * n + e] = acc[ai][bj][m][n][e] * (((float)(((n ? ga[bj].y : ga[bj].x) >> (8 * e)) & 255u) + 0.5f) * (1.f / 256.f));
                    u32x4 w; w.x = cvt_pk_bf16(r[0], r[1]); w.y = cvt_pk_bf16(r[2], r[3]); w.z = cvt_pk_bf16(r[4], r[5]); w.w = cvt_pk_bf16(r[6], r[7]);
                    *(u32x4*)(Y + ((size_t)row0 + roff) * D + col0 + bj * HALF) = w; } }
        return false;
    }
};

template <class Epi>
__device__ __forceinline__ void gemm_phase(LAS unsigned char* lds, const Gemm g, const Sched& S, const Epi& E, const int tid) {
    const int wid = __builtin_amdgcn_readfirstlane(tid >> 6), lane = tid & 63, wr = wid >> 2, wc = wid & 3, fr = lane & 15, fq = lane >> 4;
    const int K = g.K, nt = K / BK, lda = g.lda;
    unsigned voffA[2], voffB[2];
#pragma unroll
    for (int i = 0; i < 2; ++i) { int R, C; stage_rc(tid * 16 + i * 8192, R, C); const int Rb = Epi::PERM ? ((R & ~31) + perm32(R & 31)) : R;
        voffA[i] = (unsigned)(R * lda + C) * 2u; voffB[i] = (unsigned)(Rb * K + C) * 2u; }
    const size_t kstep = (size_t)(BK * 2);
    const size_t hstepA = (size_t)HALF * lda * 2, hstepB = (size_t)HALF * K * 2;
    const size_t tstepA = 2 * hstepA, tstepB = 2 * hstepB;
    const unsigned ldsw = (unsigned)wid * 1024u;
    const int aoff = lds_byte(wr * 64 + fr, fq * 8), boff = lds_byte(wc * 32 + fr, fq * 8);
#define PG8_UA(u) ((const char*)((u).br == 0 ? g.A0 : ((u).br == 1 ? g.A1 : g.A2)) + (size_t)(u).pm * tstepA + (size_t)((u).pn * g.apn))
#define PG8_UB(u) ((const char*)((u).br == 0 ? g.B0 : ((u).br == 1 ? g.B1 : g.B2)) + (size_t)(u).pn * tstepB)
#define PG8_SA(b, h) (((b) * 2 + (h)) * HTB)
#define PG8_SB(b, h) ((4 + (b) * 2 + (h)) * HTB)
#define PG8_STAGE(bufoff, gbase, voff) do { _Pragma("unroll") for (int _i = 0; _i < 2; ++_i) \
        __builtin_amdgcn_global_load_lds((const unsigned*)((const char*)(gbase) + (voff)[_i]), (LAS unsigned*)(lds + (bufoff) + ldsw + _i * 8192), 16, 0, 0); } while (0)
#define PG8_LDA(dst, b, h) do { _Pragma("unroll") for (int m = 0; m < 4; ++m) _Pragma("unroll") for (int k = 0; k < 2; ++k) dst[m][k] = *(const LAS bf16x8*)(lds + PG8_SA(b, h) + aoff + m * 2048 + k * 1024); } while (0)
#define PG8_LDB(dst, b, h) do { _Pragma("unroll") for (int n = 0; n < 2; ++n) _Pragma("unroll") for (int k = 0; k < 2; ++k) dst[n][k] = *(const LAS bf16x8*)(lds + PG8_SB(b, h) + boff + n * 2048 + k * 1024); } while (0)
#define PG8_MMA(ai, bj, At, Bt) do { __builtin_amdgcn_s_setprio(1); _Pragma("unroll") for (int m = 0; m < 4; ++m) _Pragma("unroll") for (int n = 0; n < 2; ++n) _Pragma("unroll") for (int k = 0; k < 2; ++k) \
        acc[ai][bj][m][n] = __builtin_amdgcn_mfma_f32_16x16x32_bf16(Bt[n][k], At[m][k], acc[ai][bj][m][n], 0, 0, 0); __builtin_amdgcn_s_setprio(0); } while (0)
#define PG8_WAIT_V(n) asm volatile("s_waitcnt vmcnt(" #n ")" ::: "memory")
#define PG8_WAIT_L(n) asm volatile("s_waitcnt lgkmcnt(" #n ")" ::: "memory")
#define PG8_BAR __builtin_amdgcn_s_barrier()
#define PG8_SCHED __builtin_amdgcn_sched_barrier(0)
    Unit cur, nxt; int ui = 0;
    if (!S.next(0, cur)) return;
    f32x4 acc[2][2][4][2];
#pragma unroll
    for (int a = 0; a < 2; ++a)
#pragma unroll
        for (int b = 0; b < 2; ++b)
#pragma unroll
            for (int m = 0; m < 4; ++m)
#pragma unroll
                for (int n = 0; n < 2; ++n) acc[a][b][m][n] = (f32x4){0.f, 0.f, 0.f, 0.f};
    bf16x8 At[4][2], B0[2][2], B1[2][2];
    const char* cA = PG8_UA(cur); const char* cB = PG8_UB(cur);
    PG8_STAGE(PG8_SB(0, 0), cB, voffB); PG8_STAGE(PG8_SB(0, 1), cB + hstepB, voffB); PG8_STAGE(PG8_SA(0, 0), cA, voffA); PG8_STAGE(PG8_SA(0, 1), cA + hstepA, voffA);
    if (wr == 1) PG8_BAR;
    PG8_WAIT_V(2); PG8_BAR;
    PG8_STAGE(PG8_SB(1, 0), cB + kstep, voffB); PG8_STAGE(PG8_SA(1, 0), cA + kstep, voffA); PG8_STAGE(PG8_SB(1, 1), cB + hstepB + kstep, voffB);
    PG8_WAIT_V(6); PG8_BAR;
    for (;;) {
        const bool has_next = S.next(ui + 1, nxt);
        const char* nA = has_next ? PG8_UA(nxt) : cA; const char* nB = has_next ? PG8_UB(nxt) : cB;
#pragma unroll 1
        for (int t = 0; t < nt; t += 2) {
            const bool last = (t == nt - 2);
            const char* a1 = cA + (size_t)(t + 1) * kstep;
            const char* a2 = last ? nA : cA + (size_t)(t + 2) * kstep; const char* b2 = last ? nB : cB + (size_t)(t + 2) * kstep;
            const char* a3 = a2 + kstep; const char* b3 = b2 + kstep;
            PG8_LDB(B0, 0, 0); PG8_LDB(B1, 0, 1); PG8_SCHED; PG8_LDA(At, 0, 0); PG8_STAGE(PG8_SA(1, 1), a1 + hstepA, voffA);
            PG8_WAIT_V(8); PG8_WAIT_L(0); PG8_BAR; PG8_MMA(0, 0, At, B0); PG8_MMA(0, 1, At, B1); PG8_BAR; PG8_SCHED;
            PG8_LDA(At, 0, 1); PG8_STAGE(PG8_SB(0, 0), b2, voffB); PG8_STAGE(PG8_SB(0, 1), b2 + hstepB, voffB); PG8_STAGE(PG8_SA(0, 0), a2, voffA);
            PG8_WAIT_V(8); PG8_WAIT_L(0); PG8_BAR; PG8_MMA(1, 0, At, B0); PG8_MMA(1, 1, At, B1); PG8_BAR; PG8_SCHED;
            PG8_LDB(B0, 1, 0); PG8_LDB(B1, 1, 1); PG8_SCHED; PG8_LDA(At, 1, 0); PG8_STAGE(PG8_SA(0, 1), a2 + hstepA, voffA);
            PG8_WAIT_V(8); PG8_WAIT_L(0); PG8_BAR; PG8_MMA(0, 0, At, B0); PG8_MMA(0, 1, At, B1); PG8_BAR; PG8_SCHED;
            PG8_LDA(At, 1, 1); PG8_STAGE(PG8_SB(1, 0), b3, voffB); PG8_STAGE(PG8_SB(1, 1), b3 + hstepB, voffB); PG8_STAGE(PG8_SA(1, 0), a3, voffA);
            PG8_WAIT_V(8); PG8_WAIT_L(0); PG8_BAR; PG8_MMA(1, 0, At, B0); PG8_MMA(1, 1, At, B1); PG8_BAR; PG8_SCHED;
        }
        if (wr == 0) PG8_BAR;
        const bool keep = E(acc, cur, wr, wc, fr, fq);
        if (!has_next) break;
        if (!keep) {
#pragma unroll
            for (int a = 0; a < 2; ++a)
#pragma unroll
                for (int b = 0; b < 2; ++b)
#pragma unroll
                    for (int m = 0; m < 4; ++m)
#pragma unroll
                        for (int n = 0; n < 2; ++n) acc[a][b][m][n] = (f32x4){0.f, 0.f, 0.f, 0.f};
        }
        cur = nxt; cA = nA; cB = nB; ++ui;
        if (wr == 1) PG8_BAR;
    }
    PG8_WAIT_V(0);
    PG8_BAR;
#undef PG8_UA
#undef PG8_UB
#undef PG8_SA
#undef PG8_SB
#undef PG8_STAGE
#undef PG8_LDA
#undef PG8_LDB
#undef PG8_MMA
#undef PG8_WAIT_V
#undef PG8_WAIT_L
#undef PG8_BAR
#undef PG8_SCHED
}
}

namespace att {
constexpr int NW = 8, QBLK = 32, KVBLK = 64;
constexpr float SCALE = 0.088388347648318440f;
constexpr float THR = 8.f;
constexpr size_t SHM_V = KVBLK * 128 * 2, SHM_K = KVBLK * 128 * 2, SHM_ATTN = 2 * SHM_V + 2 * SHM_K + NW * 64 * 4;
#define KSWZ(row, colB) ((row) * 256 + ((colB) ^ (((row) & 7) << 4)))
#define SBAR() __builtin_amdgcn_sched_barrier(0)
__device__ __forceinline__ int crow(int r, int hi) { return (r & 3) + 8 * (r >> 2) + 4 * hi; }
__device__ __forceinline__ unsigned cvtpk(float lo, float hi) { unsigned r; asm volatile("v_cvt_pk_bf16_f32 %0, %1, %2" : "=v"(r) : "v"(lo), "v"(hi)); return r; }
__device__ __forceinline__ void partialSM(f32x16& p0, f32x16& p1, float& m_reg, float& mn, float& alpha) {
  constexpr float C = SCALE * 1.4426950408889634f;
  float pmax = p0[0];
#pragma unroll
  for (int r = 1; r < 16; ++r) pmax = fmaxf(pmax, p0[r]);
#pragma unroll
  for (int r = 0; r < 16; ++r) pmax = fmaxf(pmax, p1[r]);
  { auto rr = __builtin_amdgcn_permlane32_swap(__float_as_uint(pmax), __float_as_uint(pmax), false, false);
    pmax = fmaxf(__uint_as_float(rr[0]), __uint_as_float(rr[1])); }
  if (__builtin_expect(__all(pmax - m_reg <= THR / SCALE), 1)) { mn = m_reg; alpha = 1.f; }
  else { mn = fmaxf(m_reg, pmax); alpha = __builtin_amdgcn_exp2f((m_reg - mn) * C); m_reg = mn; }
  float mnC = -mn * C;
#pragma unroll
  for (int r = 0; r < 16; ++r) p0[r] = fmaf(p0[r], C, mnC);
#pragma unroll
  for (int r = 0; r < 16; ++r) p1[r] = fmaf(p1[r], C, mnC);
#pragma unroll
  for (int r = 0; r < 16; ++r) p0[r] = __builtin_amdgcn_exp2f(p0[r]);
}
__device__ __forceinline__ void finishSM(f32x16& p0, f32x16& p1, float alpha, float& l_reg, bf16x8& pa0, bf16x8& pa1, bf16x8& pa2, bf16x8& pa3) {
#pragma unroll
  for (int r = 0; r < 16; ++r) p1[r] = __builtin_amdgcn_exp2f(p1[r]);
  float ps = 0;
#pragma unroll
  for (int r = 0; r < 16; ++r) ps += p0[r];
#pragma unroll
  for (int r = 0; r < 16; ++r) ps += p1[r];
  { auto rr = __builtin_amdgcn_permlane32_swap(__float_as_uint(ps), __float_as_uint(ps), false, false);
    ps = __uint_as_float(rr[0]) + __uint_as_float(rr[1]); }
  l_reg = l_reg * alpha + ps;
#define PK4(P, BASE, OUT) do { unsigned a0 = cvtpk(P[BASE + 0], P[BASE + 1]), a1 = cvtpk(P[BASE + 2], P[BASE + 3]);   \
    unsigned b0 = cvtpk(P[BASE + 4], P[BASE + 5]), b1 = cvtpk(P[BASE + 6], P[BASE + 7]);                              \
    auto r0 = __builtin_amdgcn_permlane32_swap(a0, b0, false, false); auto r1 = __builtin_amdgcn_permlane32_swap(a1, b1, false, false); \
    u32x4 w = {r0[0], r1[0], r0[1], r1[1]}; OUT = *reinterpret_cast<bf16x8*>(&w); } while (0)
  PK4(p0, 0, pa0); PK4(p0, 8, pa1); PK4(p1, 0, pa2); PK4(p1, 8, pa3);
#undef PK4
}
__device__ __forceinline__ void qkt(f32x16& p0, f32x16& p1, const bf16_t* Ks, const bf16x8* qr, int r32, int hi) {
  p0 = f32x16{}; p1 = f32x16{};
#pragma unroll
  for (int d0 = 0; d0 < 8; ++d0) { int cb = (d0 * 16 + hi * 8) * 2;
    bf16x8 b0 = *reinterpret_cast<const bf16x8*>((const char*)Ks + KSWZ(r32, cb));
    bf16x8 b1 = *reinterpret_cast<const bf16x8*>((const char*)Ks + KSWZ(32 + r32, cb));
    p0 = __builtin_amdgcn_mfma_f32_32x32x16_bf16(b0, qr[d0], p0, 0, 0, 0);
    p1 = __builtin_amdgcn_mfma_f32_32x32x16_bf16(b1, qr[d0], p1, 0, 0, 0); }
}
__device__ __forceinline__ int v_st(int k, int c) { const int kk = (k & ~0xC) | ((k & 4) << 1) | ((k & 8) >> 1); return ((kk >> 3) * 4 + (c >> 5)) * 512 + ((kk & 7) * 32 + (c & 31)) * 2; }
__device__ __forceinline__ int v_rd_base(int lane) { return ((lane & 3) << 3) | (((lane >> 2) & 3) << 6) | (((lane >> 4) & 1) << 5) | (((lane >> 5) & 1) << 8); }
constexpr int v_rd_off(int d0, int ks, int half) { return d0 * 512 + ks * 4096 + half * 2048; }
template <int OFF> __device__ __forceinline__ s16x4 tr_read(int vb) {
  s16x4 r; asm volatile("ds_read_b64_tr_b16 %0, %1 offset:%2" : "=&v"(r) : "v"(vb), "i"(OFF) : "memory"); return r;
}
template <int D0> __device__ __forceinline__ void pv_one(f32x16& od, int vb, bf16x8 pa0, bf16x8 pa1, bf16x8 pa2, bf16x8 pa3) {
  const s16x4 l0 = tr_read<v_rd_off(D0, 0, 0)>(vb), h0 = tr_read<v_rd_off(D0, 0, 1)>(vb), l1 = tr_read<v_rd_off(D0, 1, 0)>(vb), h1 = tr_read<v_rd_off(D0, 1, 1)>(vb);
  const s16x4 l2 = tr_read<v_rd_off(D0, 2, 0)>(vb), h2 = tr_read<v_rd_off(D0, 2, 1)>(vb), l3 = tr_read<v_rd_off(D0, 3, 0)>(vb), h3 = tr_read<v_rd_off(D0, 3, 1)>(vb);
  asm volatile("s_waitcnt lgkmcnt(0)" ::: "memory"); SBAR();
#define PK(L, H) (bf16x8){L[0], L[1], L[2], L[3], H[0], H[1], H[2], H[3]}
  od = __builtin_amdgcn_mfma_f32_32x32x16_bf16(pa0, PK(l0, h0), od, 0, 0, 0);
  od = __builtin_amdgcn_mfma_f32_32x32x16_bf16(pa1, PK(l1, h1), od, 0, 0, 0);
  od = __builtin_amdgcn_mfma_f32_32x32x16_bf16(pa2, PK(l2, h2), od, 0, 0, 0);
  od = __builtin_amdgcn_mfma_f32_32x32x16_bf16(pa3, PK(l3, h3), od, 0, 0, 0);
#undef PK
}
__device__ __forceinline__ void pv_d0(f32x16* o, int vb, bf16x8 pa0, bf16x8 pa1, bf16x8 pa2, bf16x8 pa3) {
  pv_one<0>(o[0], vb, pa0, pa1, pa2, pa3); pv_one<1>(o[1], vb, pa0, pa1, pa2, pa3); pv_one<2>(o[2], vb, pa0, pa1, pa2, pa3); pv_one<3>(o[3], vb, pa0, pa1, pa2, pa3);
}
__device__ __forceinline__ void attn_dense_body(const bf16_t* Qb, const bf16_t* __restrict__ KL, const bf16_t* __restrict__ KC,
                                                int ntl, bf16_t* Ob, int NT, char* lds, const int tid, const bool dost = true) {
  constexpr int LDQ = NP, LDK = NP, LDO = NP;
  const int wid = tid >> 6, lane = tid & 63, r32 = lane & 31, hi = lane >> 5;
  bf16_t* V_lds = (bf16_t*)lds; bf16_t* K_lds = (bf16_t*)(lds + 2 * SHM_V);
  float* ws = (float*)(lds + 2 * SHM_V + 2 * SHM_K) + wid * 64; float* li_l = ws; float* al_l = ws + 32;
  float m_reg = -1e30f, l_reg = 0; f32x16 o[4] = {}; bf16x8 qr[8];
  const bf16_t* Qw = Qb + (long)(wid * QBLK + r32) * LDQ + hi * 8;
#pragma unroll
  for (int d0 = 0; d0 < 8; ++d0) qr[d0] = *reinterpret_cast<const bf16x8*>(Qw + d0 * 16);
  const int sr = tid >> 4, sc = (tid & 15) * 8, vst0 = v_st(sr, sc), vst1 = v_st(32 + sr, sc);
  const int vb0 = (int)(uintptr_t)V_lds + v_rd_base(lane);
  struct { bf16x8 vs0, vs1, ks0, ks1; } sr_[1];
  const int loff0 = sr * LDK + sc, loff1 = (32 + sr) * LDK + sc;
  const bf16_t* knext = (ntl > 0) ? KL : KC; int tl_ = 0;
#define SLOAD(i, t) do { const bf16_t* kt_ = knext; ++tl_; knext = (tl_ == ntl) ? KC : knext + (long)KVBLK * LDK; \
    sr_[i].vs0 = *reinterpret_cast<const bf16x8*>(kt_ + loff0 + (C_AV - C_AK)); sr_[i].vs1 = *reinterpret_cast<const bf16x8*>(kt_ + loff1 + (C_AV - C_AK)); \
    sr_[i].ks0 = *reinterpret_cast<const bf16x8*>(kt_ + loff0); sr_[i].ks1 = *reinterpret_cast<const bf16x8*>(kt_ + loff1); } while (0)
#define SWRITE(b, i) do { *(bf16x8*)((char*)V_lds + (b) * SHM_V + vst0) = sr_[i].vs0;          \
    *(bf16x8*)((char*)V_lds + (b) * SHM_V + vst1) = sr_[i].vs1; int kc = sc * 2;               \
    *(bf16x8*)((char*)K_lds + (b) * SHM_K + KSWZ(sr, kc)) = sr_[i].ks0;                       \
    *(bf16x8*)((char*)K_lds + (b) * SHM_K + KSWZ(32 + sr, kc)) = sr_[i].ks1; } while (0)
#define SWAIT() asm volatile("s_waitcnt vmcnt(0)" ::: "memory")
#define RESC(a) do { if (__any((a) < 1.f)) { if (hi == 0) al_l[r32] = (a); asm volatile("s_waitcnt lgkmcnt(0)" ::: "memory"); \
    _Pragma("unroll") for (int d = 0; d < 4; ++d) _Pragma("unroll") for (int r = 0; r < 16; ++r) o[d][r] *= al_l[crow(r, hi)]; } } while (0)
  f32x16 pA0, pA1, pB0, pB1; float mnA, mnB, alA, alB; bf16x8 pa0, pa1, pa2, pa3;
  constexpr int SE = 0, SO = 0;
  SLOAD(SE, 0); asm volatile("s_waitcnt vmcnt(0)" ::: "memory"); SWRITE(0, SE); __syncthreads();
  qkt(pA0, pA1, K_lds, qr, r32, hi); partialSM(pA0, pA1, m_reg, mnA, alA);
  SLOAD(SO, 1);
  SWAIT(); SWRITE(1, SO); __syncthreads();
  for (int j = 1; j + 1 < NT; j += 2) {
    SBAR(); qkt(pB0, pB1, (bf16_t*)((char*)K_lds + SHM_K), qr, r32, hi);
    finishSM(pA0, pA1, alA, l_reg, pa0, pa1, pa2, pa3); SBAR();
    SLOAD(SO, j + 1); SBAR();
    pv_d0(o, vb0, pa0, pa1, pa2, pa3); partialSM(pB0, pB1, m_reg, mnB, alB);
    __syncthreads(); SWAIT(); SWRITE(0, SE);
    RESC(alB); __syncthreads();
    SBAR(); qkt(pA0, pA1, K_lds, qr, r32, hi);
    finishSM(pB0, pB1, alB, l_reg, pa0, pa1, pa2, pa3); SBAR();
    SLOAD(SE, j + 2); SBAR();
    pv_d0(o, vb0 + (int)SHM_V, pa0, pa1, pa2, pa3); partialSM(pA0, pA1, m_reg, mnA, alA);
    __syncthreads(); SWAIT(); SWRITE(1, SO);
    RESC(alA); __syncthreads();
  }
  SBAR(); qkt(pB0, pB1, (bf16_t*)((char*)K_lds + SHM_K), qr, r32, hi);
  finishSM(pA0, pA1, alA, l_reg, pa0, pa1, pa2, pa3); SBAR();
  pv_d0(o, vb0, pa0, pa1, pa2, pa3); partialSM(pB0, pB1, m_reg, mnB, alB);
  __syncthreads(); RESC(alB);
  finishSM(pB0, pB1, alB, l_reg, pa0, pa1, pa2, pa3); SBAR();
  pv_d0(o, vb0 + (int)SHM_V, pa0, pa1, pa2, pa3);
  if (hi == 0) li_l[r32] = l_reg; asm volatile("s_waitcnt lgkmcnt(0)" ::: "memory");
  float rli[16];
#pragma unroll
  for (int r = 0; r < 16; ++r) rli[r] = __builtin_amdgcn_rcpf(li_l[crow(r, hi)]);
  bf16_t* Ow = Ob + (long)(wid * QBLK) * LDO;
#pragma unroll
  for (int r = 0; r < 16; ++r) { int orow = crow(r, hi);
#pragma unroll
    for (int d0 = 0; d0 < 4; ++d0) if (dost) Ow[(long)orow * LDO + d0 * 32 + r32] = (bf16_t)f2bf(o[d0][r] * rli[r]); }
  __syncthreads();
#undef SLOAD
#undef SWRITE
#undef SWAIT
#undef RESC
}
#undef KSWZ
#undef SBAR
}


#define XB_TMO      128
#define XB_XCNT(j)  (256  + 64 * (j))
#define XB_XSUB(j)  (1280 + 64 * (j))
#define XB_XGEN(j)  (2304 + 64 * (j))
#define XB_TOP      3328
#define XB_TOPGEN   3392
#define XCD_BAR_WORDS 3456
#define XB_SPIN_CAP (1u << 18)
__device__ __forceinline__ unsigned xb_ld(unsigned* p)              { return __hip_atomic_load(p, __ATOMIC_RELAXED, __HIP_MEMORY_SCOPE_AGENT); }
__device__ __forceinline__ unsigned xb_add(unsigned* p, unsigned v) { return __hip_atomic_fetch_add(p, v, __ATOMIC_RELAXED, __HIP_MEMORY_SCOPE_AGENT); }
__device__ __forceinline__ unsigned xb_xcc_id() { return (unsigned)__builtin_amdgcn_s_getreg((3 << 11) | 20) & 0xFu; }
#define XB_SPIN(cond, bar) do { unsigned _sp = 0; while (cond) { __builtin_amdgcn_s_sleep(1); \
    if ((++_sp & 255u) == 0u) { if (xb_ld(&(bar)[XB_TMO])) break; if (_sp > XB_SPIN_CAP) { atomicAdd(&(bar)[XB_TMO], 1u); break; } } } } while (0)
struct XcdBarrier { unsigned* bar; unsigned x; volatile LAS unsigned* st; };
__device__ __forceinline__ XcdBarrier xcd_barrier_post(unsigned* bar, volatile LAS unsigned* st) {
    XcdBarrier b; b.bar = bar; b.x = xb_xcc_id(); b.st = st;
    if (threadIdx.x == 0) (void)xb_add(&bar[XB_XCNT(b.x)], 1u);
    return b;
}
__device__ __forceinline__ void xcd_barrier_complete(unsigned* bar, unsigned x, unsigned& nloc, unsigned& nx) {
    const unsigned G = gridDim.x * gridDim.y * gridDim.z;
    unsigned sum, cnt, mine, sp = 0u;
    for (;;) {
        sum = 0u; cnt = 0u; mine = 0u;
#pragma unroll
        for (unsigned j = 0; j < 16; ++j) { const unsigned c = xb_ld(&bar[XB_XCNT(j)]); sum += c; cnt += (c > 0u) ? 1u : 0u; mine = (j == x) ? c : mine; }
        if (sum == G) break;
        __builtin_amdgcn_s_sleep(1);
        if ((++sp & 255u) == 0u) { if (xb_ld(&bar[XB_TMO])) break; if (sp > XB_SPIN_CAP) { atomicAdd(&bar[XB_TMO], 1u); break; } }
    }
    nloc = mine > 0u ? mine : 1u; nx = cnt > 0u ? cnt : 1u;
}
__device__ __forceinline__ void xcd_barrier(const XcdBarrier& b) {
    asm volatile("s_waitcnt vmcnt(0)" ::: "memory");
    __syncthreads();
    if (threadIdx.x == 0) {
        unsigned* bar = b.bar;
        __builtin_amdgcn_s_waitcnt(0);
        unsigned nloc = b.st[0], nx = b.st[1];
        if (nloc == 0u) { xcd_barrier_complete(bar, b.x, nloc, nx); b.st[0] = nloc; b.st[1] = nx; }
        const unsigned old = xb_add(&bar[XB_XSUB(b.x)], 1u);
        const unsigned gen = old / nloc;
        if (old + 1u == (gen + 1u) * nloc) {
            __builtin_amdgcn_fence(__ATOMIC_RELEASE, "agent");
            asm volatile("s_waitcnt vmcnt(0)" ::: "memory");
            const unsigned og = xb_add(&bar[XB_TOP], 1u);
            const unsigned tg = og / nx;
            if (og + 1u == (tg + 1u) * nx) xb_add(&bar[XB_TOPGEN], 1u);
            else XB_SPIN(xb_ld(&bar[XB_TOPGEN]) == tg, bar);
            __builtin_amdgcn_fence(__ATOMIC_ACQUIRE, "agent");
            xb_add(&bar[XB_XGEN(b.x)], 1u);
            asm volatile("s_waitcnt vmcnt(0)" ::: "memory");
        } else {
            XB_SPIN(xb_ld(&bar[XB_XGEN(b.x)]) == gen, bar);
            __builtin_amdgcn_fence(__ATOMIC_ACQUIRE, "agent");
            asm volatile("s_waitcnt vmcnt(0)" ::: "memory");
        }
    }
    __syncthreads();
}

typedef const __attribute__((address_space(4))) Args* ArgsP;
struct Fr {
    char* lds; LAS unsigned char* lds3; int tid, lane, wave, G, vcu, gw, NGW, bx;
    ArgsP ap;
};
#define WSB (F.ap->ws)
#define F_P ((bf16_t*)(WSB + WS_P))
#define F_H ((bf16_t*)(WSB + WS_H))
#define F_MIX ((bf16_t*)(WSB + WS_MIX))
#define F_CST ((bf16_t*)(WSB + WS_CST))
#define F_MOD ((float*)(WSB + WS_MOD))
#define F_LI ((float*)(WSB + WS_LI))
#define F_LF ((float*)(WSB + WS_LF))
#define F_GT ((float*)(WSB + WS_GT))
#define F_MLOC ((float*)(WSB + WS_GT) + 2048)
#define F_MIN ((float*)(WSB + WS_GT) + 4096)
#define F_NST ((float*)(WSB + WS_NST))
#define F_XC ((float*)(WSB + WS_XC))


__device__ __forceinline__ void tr_item(const float* W, int N, int k0, int n0, bf16_t* WT, int ldt, int drow0, const float* rscale, float* scr, int lane, int split = 1 << 30, int shift = 0) {
    const int cq = lane & 15, rq = lane >> 4, dn = n0 + 4 * cq, nn = dn < split ? dn : dn - shift; const bool ok = (nn < N) && (dn < split || dn >= split + shift);
    f32x4 v[16];
#pragma unroll
    for (int i = 0; i < 16; ++i) v[i] = ok ? __builtin_nontemporal_load((const f32x4*)(W + (size_t)(k0 + 4 * i + rq) * N + nn)) : (f32x4){0.f, 0.f, 0.f, 0.f};
#pragma unroll
    for (int i = 0; i < 16; ++i) { float* d = scr + (4 * i + rq) * 65 + 4 * cq; d[0] = v[i][0]; d[1] = v[i][1]; d[2] = v[i][2]; d[3] = v[i][3]; }
    asm volatile("s_waitcnt lgkmcnt(0)" ::: "memory");
    const int c = lane & 7;
#pragma unroll
    for (int j = 0; j < 8; ++j) { const int n = (lane >> 3) + 8 * j; const float* sp = scr + (8 * c) * 65 + n;
        const float sc = rscale ? rscale[n0 + n] : 1.f;
        u32x4 o; o.x = pk2(sp[0 * 65] * sc, sp[1 * 65] * sc); o.y = pk2(sp[2 * 65] * sc, sp[3 * 65] * sc); o.z = pk2(sp[4 * 65] * sc, sp[5 * 65] * sc); o.w = pk2(sp[6 * 65] * sc, sp[7 * 65] * sc);
        *(u32x4*)(WT + (size_t)(drow0 + n) * ldt + k0 + 8 * c) = o; }
    asm volatile("s_waitcnt lgkmcnt(0)" ::: "memory");
}
__device__ __forceinline__ void convert_weights(Fr& F, int l) {
    float* scr = (float*)(F.lds + F.wave * 16640);
    constexpr int I_IN = 32 * 188, I_FI = 32 * 176, I_FO = 88 * 32, I_UP = 16 * 32, I_OUT = 32 * 32, I_PL = 64;
    constexpr int NIT = I_IN + I_FI + I_FO + 3 * I_UP + I_OUT + I_PL;
    for (int it = F.gw; it < NIT; it += F.NGW) {
        int r = it;
        if (r < I_IN) { const int kb = r / 188, nb = r % 188; tr_item(F.ap->in[I_WIN] + (size_t)l * D * DIN, DIN, kb * 64, nb * 64, (bf16_t*)(WSB + WS_WIN), D, nb * 64, nullptr, scr, F.lane, C_GRAW, NP - C_GRAW); continue; } r -= I_IN;
        if (r < I_FI) { const int kb = r / 176, nb = r % 176, n0 = nb * 64, bj = n0 / DFF, jj0 = n0 % DFF;
            tr_item(F.ap->in[I_FFI] + (size_t)l * D * 2 * DFF, 2 * DFF, kb * 64, n0, (bf16_t*)(WSB + WS_WFI), D, (jj0 / 128) * 256 + bj * 128 + (jj0 % 128), nullptr, scr, F.lane); continue; } r -= I_FI;
        if (r < I_FO) { const int kb = r / 32, nb = r % 32; tr_item(F.ap->in[I_FFO] + (size_t)l * DFF * D, D, kb * 64, nb * 64, (bf16_t*)(WSB + WS_WFO), DFF, nb * 64, nullptr, scr, F.lane); continue; } r -= I_FO;
#define UPCASE(BR, IDX) if (r < I_UP) { const int kb = r / 32, nb = r % 32; \
            tr_item(F.ap->in[IDX] + (size_t)l * 1024 * D, D, kb * 64, nb * 64, (bf16_t*)(WSB + WS_WUP) + (size_t)(BR) * D * 1024, 1024, nb * 64, nullptr, scr, F.lane); continue; } r -= I_UP;
        UPCASE(0, I_UPA) UPCASE(1, I_UPM) UPCASE(2, I_UPP)
#undef UPCASE
        if (r < I_OUT) { const int kb = r / 32, nb = r % 32; tr_item(F.ap->in[I_WOUT] + (size_t)l * D * D, D, kb * 64, nb * 64, (bf16_t*)(WSB + WS_WOUT), D, nb * 64, nullptr, scr, F.lane); continue; } r -= I_OUT;
        { const int g = r / 16, q = r % 16, kb = q / 4, nb = q % 4;
          tr_item(F.ap->in[I_POOLW] + ((size_t)l * 4 + g) * 65536, 256, kb * 64, nb * 64, (bf16_t*)(WSB + WS_WPL) + (size_t)g * 65536, 256, nb * 64, F.ap->in[I_POOLS] + l * 1024 + g * 256, scr, F.lane); }
    }
}

__device__ __forceinline__ void mod_gemv(Fr& F) {
    float* sc = (float*)F.lds;
    float* red = (float*)(F.lds + 5 * 2048 * 4);
    for (int i = F.tid; i < 5 * 2048; i += 512) { const int m = i >> 11, k = i & 2047; const float v = m < 4 ? F.ap->in[I_C][m * 2048 + k] : F.ap->in[I_CCTX][k]; sc[i] = v / (1.f + __expf(-v)); }
    __syncthreads();
    const int kpar = F.lane >> 5, cl = F.lane & 31;
    for (int it = F.bx; it < 768; it += F.G) {
        const int l = it / 384, col = (it % 384) * 32 + cl;
        const float* w = F.ap->in[I_WMOD] + (size_t)l * D * 12288 + col;
        float a0 = 0, a1 = 0, a2 = 0, a3 = 0, a4 = 0;
        const int kbase = F.wave * 256 + kpar;
#pragma unroll 32
        for (int kk = 0; kk < 128; ++kk) { const int k = kbase + 2 * kk; const float wv = __builtin_nontemporal_load(w + (size_t)k * 12288);
            a0 += sc[k] * wv; a1 += sc[2048 + k] * wv; a2 += sc[4096 + k] * wv; a3 += sc[6144 + k] * wv; a4 += sc[8192 + k] * wv; }
        a0 += __shfl_xor(a0, 32); a1 += __shfl_xor(a1, 32); a2 += __shfl_xor(a2, 32); a3 += __shfl_xor(a3, 32); a4 += __shfl_xor(a4, 32);
        if (kpar == 0) { float* rp = red + F.wave * 160 + cl; rp[0] = a0; rp[32] = a1; rp[64] = a2; rp[96] = a3; rp[128] = a4; }
        __syncthreads();
        if (F.tid < 160) { float s = 0;
#pragma unroll
            for (int w8 = 0; w8 < 8; ++w8) s += red[w8 * 160 + F.tid];
            const int m = F.tid >> 5, c = (it % 384) * 32 + (F.tid & 31);
            F_MOD[((size_t)l * 5 + m) * 12288 + c] = s + F.ap->in[I_BMOD][l * 12288 + c]; }
        __syncthreads();
    }
}

__device__ __forceinline__ void ld_row(const float* p, int lane, f32x4 (&v)[8]) {
#pragma unroll
    for (int j = 0; j < 8; ++j) v[j] = __builtin_nontemporal_load((const f32x4*)p + lane + 64 * j);
}
__device__ __forceinline__ float row_rinv(const f32x4 (&v)[8]) {
    float s = 0.f;
#pragma unroll
    for (int j = 0; j < 8; ++j) s += (v[j].x * v[j].x + v[j].y * v[j].y) + (v[j].z * v[j].z + v[j].w * v[j].w);
    return 1.f / sqrtf(wave_sum(s) * (1.f / D) + EPS);
}
__device__ __forceinline__ void norm_mod_store(const f32x4 (&x)[8], const float* g, const float* sh, const float* sc, bf16_t* orow, int lane) {
    const float rinv = row_rinv(x);
#pragma unroll
    for (int j = 0; j < 8; ++j) { const int i = lane + 64 * j; const f32x4 gg = ((const f32x4*)g)[i], s1 = ((const f32x4*)sc)[i], s0 = ((const f32x4*)sh)[i];
        const f32x4 h = (x[j] * rinv * gg) * (1.f + s1) + s0;
        u32x2 w; w.x = pk2(h.x, h.y); w.y = pk2(h.z, h.w); ((u32x2*)orow)[i] = w; }
}
__device__ __forceinline__ int mod_row(int r) { return r < ML ? (r >> 12) : 4; }
__device__ __forceinline__ void phase_norm1(Fr& F, int l, const float* xlat, const float* xctx) {
    const float* g = F.ap->in[I_NORMG] + (size_t)l * 4 * D;
    for (int r = F.gw; r < MT; r += F.NGW) {
        const float* src = r < ML ? xlat + (size_t)r * D : xctx + (size_t)(r - ML) * D;
        const float* mod = F_MOD + ((size_t)l * 5 + mod_row(r)) * 12288;
        f32x4 x[8]; ld_row(src, F.lane, x);
        norm_mod_store(x, g, mod, mod + D, F_H + (size_t)r * D, F.lane);
    }
}
__device__ __forceinline__ void phase_resid(Fr& F, int l, int which, int nrows, const float* xlat_src, const float* xctx_src, bool nextnorm, const bool srcbf, const bool dstbf, const bool dost = true) {
    const float* ng = F.ap->in[I_NORMG] + (size_t)l * 4 * D;
    const bf16_t* Y = (const bf16_t*)(WSB + WS_YO);
    for (int r = F.gw; r < nrows; r += F.NGW) {
        const float* src = r < ML ? xlat_src + (size_t)r * D : xctx_src + (size_t)(r - ML) * D;
        float* dst = r < ML ? F.ap->out + (size_t)r * D : F_XC + (size_t)(r - ML) * D;
        const float* mod = F_MOD + ((size_t)l * 5 + mod_row(r)) * 12288;
        const float* gate = mod + (which == 0 ? 2 : 5) * D; const float* gy = ng + (which == 0 ? 1 : 3) * D;
        f32x4 y[8], x[8];
#pragma unroll
        for (int j = 0; j < 8; ++j) { const u32x2 w = __builtin_nontemporal_load((const u32x2*)(Y + (size_t)r * D) + F.lane + 64 * j);
            y[j] = (f32x4){__uint_as_float(w.x << 16), __uint_as_float(w.x & 0xffff0000u), __uint_as_float(w.y << 16), __uint_as_float(w.y & 0xffff0000u)}; }
        bf16_t* xb = (bf16_t*)(WSB + WS_XB) + (size_t)(r < ML ? r : 0) * D;
        if (r < ML && srcbf) {
#pragma unroll
            for (int j = 0; j < 8; ++j) { const u32x2 w = __builtin_nontemporal_load((const u32x2*)xb + F.lane + 64 * j);
                x[j] = (f32x4){__uint_as_float(w.x << 16), __uint_as_float(w.x & 0xffff0000u), __uint_as_float(w.y << 16), __uint_as_float(w.y & 0xffff0000u)}; }
        } else ld_row(src, F.lane, x);
        const float ry = row_rinv(y);
#pragma unroll
        for (int j = 0; j < 8; ++j) { const int i = F.lane + 64 * j; const f32x4 gt = ((const f32x4*)gate)[i], gg = ((const f32x4*)gy)[i];
            x[j] = x[j] + gt * (y[j] * ry * gg);
            if (dost) { if (r < ML && dstbf) { u32x2 w; w.x = pk2(x[j].x, x[j].y); w.y = pk2(x[j].z, x[j].w); ((u32x2*)xb)[i] = w; } else ((f32x4*)dst)[i] = x[j]; } }
        if (which == 0) norm_mod_store(x, ng + 2 * D, mod + 3 * D, mod + 4 * D, F_H + (size_t)r * D, F.lane);
        else if (nextnorm) { const float* mod2 = F_MOD + ((size_t)(l + 1) * 5 + mod_row(r)) * 12288;
            norm_mod_store(x, F.ap->in[I_NORMG] + (size_t)(l + 1) * 4 * D, mod2, mod2 + D, F_H + (size_t)r * D, F.lane); }
    }
}

__device__ __forceinline__ void phase_prep(Fr& F, int l, const bool dost = true) {
    const float* qkg = F.ap->in[I_QKG] + l * 256;
    const float* gb = F.ap->in[I_GATEB] + l * 16;
    const int lane = F.lane, i32 = lane & 31, sub = lane >> 5;
    float gq[4], gk[4];
#pragma unroll
    for (int e = 0; e < 4; ++e) { gq[e] = qkg[32 * e + i32]; gk[e] = qkg[128 + 32 * e + i32]; }
    const float inv = __builtin_amdgcn_exp2f(-(float)i32 * (13.287712379549449f / 32.f));
    for (int rp = F.gw; rp < MT / 2; rp += F.NGW) {
        const int r = 2 * rp + sub;
        bf16_t* prow = F_P + (size_t)r * NP;
        const bool lat = r < ML;
        const int nh = (lat || l == 0) ? 10 : 2;
        float cs0 = 1.f, sn0 = 0.f, cs1 = 1.f, sn1 = 0.f;
        if (lat) { const int t = r & 4095;
            float rev0 = (float)(t >> 6) * inv * 0.15915494309189535f, rev1 = (float)(t & 63) * inv * 0.15915494309189535f;
            rev0 -= rintf(rev0); rev1 -= rintf(rev1);
            sn0 = __builtin_amdgcn_sinf(rev0); cs0 = __builtin_amdgcn_cosf(rev0); sn1 = __builtin_amdgcn_sinf(rev1); cs1 = __builtin_amdgcn_cosf(rev1); }
#define PREP_LOAD(h) { const int c0 = (h) < 2 ? C_AK + (h) * 128 : C_AQ + ((h) - 2) * 128; \
            _Pragma("unroll") for (int e = 0; e < 4; ++e) x[h][e] = bf2f(prow[c0 + 32 * e + i32]); }
#define PREP_HEAD(h) { const int c0 = (h) < 2 ? C_AK + (h) * 128 : C_AQ + ((h) - 2) * 128; \
            float ss = (x[h][0] * x[h][0] + x[h][1] * x[h][1]) + (x[h][2] * x[h][2] + x[h][3] * x[h][3]); \
            _Pragma("unroll") for (int o = 1; o < 32; o <<= 1) ss += __shfl_xor(ss, o); \
            const float rinv = __builtin_amdgcn_rsqf(ss * (1.f / 128.f) + EPS); \
            const float a0 = x[h][0] * rinv * ((h) < 2 ? gk[0] : gq[0]), b0 = x[h][1] * rinv * ((h) < 2 ? gk[1] : gq[1]); \
            const float a1 = x[h][2] * rinv * ((h) < 2 ? gk[2] : gq[2]), b1 = x[h][3] * rinv * ((h) < 2 ? gk[3] : gq[3]); \
            if (dost) { prow[c0 + i32] = (bf16_t)f2bf(a0 * cs0 - b0 * sn0); prow[c0 + 32 + i32] = (bf16_t)f2bf(b0 * cs0 + a0 * sn0); \
                        prow[c0 + 64 + i32] = (bf16_t)f2bf(a1 * cs1 - b1 * sn1); prow[c0 + 96 + i32] = (bf16_t)f2bf(b1 * cs1 + a1 * sn1); } }
        float x[10][4];
        if (nh == 10) {
#pragma unroll
            for (int h = 0; h < 10; ++h) PREP_LOAD(h)
#pragma unroll
            for (int h = 0; h < 10; ++h) PREP_HEAD(h)
        } else {
#pragma unroll
            for (int h = 0; h < 2; ++h) PREP_LOAD(h)
#pragma unroll
            for (int h = 0; h < 2; ++h) PREP_HEAD(h)
        }
#undef PREP_LOAD
#undef PREP_HEAD
        if (i32 < 16) { const int q = i32 & 7, d = q >> 2, hh = q & 3;
            const float raw = bf2f(prow[(i32 < 8 ? C_GI : C_GF) + q]);
            if (i32 < 8) F_LI[(size_t)r * 8 + q] = raw + gb[d * 8 + hh];
            else { const float xx = raw + gb[d * 8 + 4 + hh]; F_LF[(size_t)r * 8 + q] = fminf(xx, 0.f) - __logf(1.f + __expf(-fabsf(xx))); } }
    }
    const int nrows = (l == 0) ? MT : ML;
    const long total = (long)nrows * 128, nth = (long)F.G * 512;
    for (long it = (long)F.bx * 512 + F.tid; it < total; it += nth) {
        const int gi = (int)((it >> 6) & 3), c8 = (int)(it & 31) | (gi << 5), r = (int)((it >> 8) << 1) | (int)((it >> 5) & 1);
        const int T = r < ML ? SEQ : CTXL, t = r < ML ? (r & 4095) : ((r - ML) & 255);
        const bf16_t* base = F_P + (size_t)(r - t) * NP + C_PL + c8 * 8;
        float s[8] = {0, 0, 0, 0, 0, 0, 0, 0}; int cnt = 0, nwin = 0;
#define POOLW(HW) { bf16x8 v[2 * HW]; \
            _Pragma("unroll") for (int k = 0; k < 2 * HW; ++k) { const int u = t - HW + k; const bool ok = (u >= 0) && (u < T); const int uc = ok ? u : t; v[k] = *(const bf16x8*)(base + (size_t)uc * NP); cnt += ok ? 1 : 0; } \
            _Pragma("unroll") for (int k = 0; k < 2 * HW; ++k) { \
                _Pragma("unroll") for (int i = 0; i < 8; ++i) s[i] += bfs2f(v[k][i]); } nwin = 2 * HW; }
        if (gi == 0) POOLW(1) else if (gi == 1) POOLW(2) else if (gi == 2) POOLW(4) else POOLW(8)
#undef POOLW
        const bf16x8 self = *(const bf16x8*)(base + (size_t)t * NP); const float rc = __builtin_amdgcn_rcpf((float)cnt); const float ninv = (float)(nwin - cnt);
#pragma unroll
        for (int i = 0; i < 8; ++i) s[i] -= ninv * bfs2f(self[i]);
        u32x4 w; w.x = pk2(s[0] * rc - bfs2f(self[0]), s[1] * rc - bfs2f(self[1])); w.y = pk2(s[2] * rc - bfs2f(self[2]), s[3] * rc - bfs2f(self[3]));
        w.z = pk2(s[4] * rc - bfs2f(self[4]), s[5] * rc - bfs2f(self[5])); w.w = pk2(s[6] * rc - bfs2f(self[6]), s[7] * rc - bfs2f(self[7]));
        *(u32x4*)(F_MIX + (size_t)r * 1024 + c8 * 8) = w;
    }
}

__device__ __forceinline__ void chunk_bs(int cidx, int& b, int& slot) { if (cidx < 128) { b = cidx >> 5; slot = 2 + (cidx & 31); } else { b = (cidx - 128) >> 1; slot = (cidx - 128) & 1; } }
__device__ __forceinline__ int unit_idx(int b, int hh, int d, int slot) { return ((b * 4 + hh) * 2 + d) * NSLOT + slot; }
constexpr int VS = 136;
constexpr int LDS_VT = 0, LDS_KT = 256 * VS * 2, LDS_FS = LDS_KT + 128 * VS * 2, LDS_CH = LDS_FS + 5120;

__device__ __forceinline__ void stage_vt(Fr& F, bf16_t* VT, size_t R0, int hh) {
    for (int idx = F.tid; idx < 1024; idx += 512) { const int l4 = idx & 31, c8 = idx >> 5;
        const bf16_t* src = F_P + (R0 + 4 * l4) * NP + C_MV + hh * 256 + c8 * 8;
        const bf16x8 r0 = *(const bf16x8*)(src), r1 = *(const bf16x8*)(src + NP), r2 = *(const bf16x8*)(src + 2 * NP), r3 = *(const bf16x8*)(src + 3 * NP);
#pragma unroll
        for (int i = 0; i < 8; ++i) { u32x2 w; w.x = (unsigned)(unsigned short)r0[i] | ((unsigned)(unsigned short)r1[i] << 16); w.y = (unsigned)(unsigned short)r2[i] | ((unsigned)(unsigned short)r3[i] << 16);
            *(u32x2*)(VT + (c8 * 8 + i) * VS + 4 * l4) = w; } }
}
__device__ __forceinline__ void mls_cloc_unit(Fr& F, int cidx, int hh, int d, int l) {
    bf16_t* VT = (bf16_t*)(F.lds + LDS_VT); bf16_t* KT = (bf16_t*)(F.lds + LDS_KT); float* fs = (float*)(F.lds + LDS_FS);
    const int tid = F.tid, lane = F.lane, w = F.wave, fr = lane & 15, fq = lane >> 4;
    const size_t R0 = (size_t)cidx * 128; int b, slot; chunk_bs(cidx, b, slot); const int uidx = unit_idx(b, hh, d, slot);
    if (tid < 128) { const float* gb = F.ap->in[I_GATEB] + l * 16; const bf16_t* prow = F_P + (R0 + tid) * NP;
        const float xx = bf2f(prow[C_GF + d * 4 + hh]) + gb[d * 8 + 4 + hh];
        fs[tid] = fminf(xx, 0.f) - __logf(1.f + __expf(-fabsf(xx))); fs[128 + tid] = bf2f(prow[C_GI + d * 4 + hh]) + gb[d * 8 + hh]; }
    __syncthreads();
    float wend = 0.f, gtot = 0.f;
    {
        float lfv = tid < 128 ? fs[tid] : 0.f, p = lfv;
#pragma unroll
        for (int o = 1; o < 64; o <<= 1) { const float t = __shfl_up(p, o); if (lane >= o) p += t; }
        if (tid < 128 && lane == 63) fs[512 + w] = p;
        __syncthreads();
        const float tot0 = fs[512], tot1 = fs[513]; gtot = tot0 + tot1;
        const float bf_ = p + (w == 1 ? tot0 : 0.f);
        const float bsum = d == 0 ? bf_ : gtot - bf_ + lfv;
        wend = tid < 128 ? gtot - bsum + fs[128 + tid] : -3.0e38f;
        float mx = wend;
#pragma unroll
        for (int o = 1; o < 64; o <<= 1) mx = fmaxf(mx, __shfl_xor(mx, o));
        if (tid < 128 && lane == 0) fs[514 + w] = mx;
        __syncthreads();
        const float m = fmaxf(fs[514], fs[515]);
        if (tid < 128) { fs[384 + tid] = __expf(wend - m) * QK_SCALE;
            if (tid == 0) { F_GT[uidx] = gtot; F_MLOC[uidx] = m; } }
    }
    stage_vt(F, VT, R0, hh);
    __syncthreads();
    { const int l4 = tid & 31, c8 = tid >> 5;
        const bf16_t* src = F_P + (R0 + 4 * l4) * NP + C_MK + hh * 128 + c8 * 8;
        const bf16x8 r0 = *(const bf16x8*)(src), r1 = *(const bf16x8*)(src + NP), r2 = *(const bf16x8*)(src + 2 * NP), r3 = *(const bf16x8*)(src + 3 * NP);
        const float e0 = fs[384 + 4 * l4], e1 = fs[385 + 4 * l4], e2 = fs[386 + 4 * l4], e3 = fs[387 + 4 * l4];
#pragma unroll
        for (int i = 0; i < 8; ++i) { u32x2 w; w.x = pk2(bfs2f(r0[i]) * e0, bfs2f(r1[i]) * e1); w.y = pk2(bfs2f(r2[i]) * e2, bfs2f(r3[i]) * e3);
            *(u32x2*)(KT + (c8 * 8 + i) * VS + 4 * l4) = w; } }
    __syncthreads();
    f32x4 acc[2][8];
#pragma unroll
    for (int vi = 0; vi < 2; ++vi)
#pragma unroll
        for (int kb = 0; kb < 8; ++kb) acc[vi][kb] = (f32x4){0.f, 0.f, 0.f, 0.f};
#pragma unroll
    for (int lb = 0; lb < 4; ++lb) {
        bf16x8 xf[2];
#pragma unroll
        for (int vi = 0; vi < 2; ++vi) xf[vi] = *(const bf16x8*)(VT + (32 * w + 16 * vi + fr) * VS + lb * 32 + 8 * fq);
#pragma unroll
        for (int kb = 0; kb < 8; ++kb) { const bf16x8 yf = *(const bf16x8*)(KT + (16 * kb + fr) * VS + lb * 32 + 8 * fq);
#pragma unroll
            for (int vi = 0; vi < 2; ++vi) acc[vi][kb] = __builtin_amdgcn_mfma_f32_16x16x32_bf16(yf, xf[vi], acc[vi][kb], 0, 0, 0); }
    }
    bf16_t* Cst = F_CST + (size_t)uidx * 32768;
    __syncthreads();
#pragma unroll
    for (int vi = 0; vi < 2; ++vi)
#pragma unroll
        for (int kb = 0; kb < 8; ++kb)
        { u32x2 pk; pk.x = pk2(acc[vi][kb][0], acc[vi][kb][1]); pk.y = pk2(acc[vi][kb][2], acc[vi][kb][3]); *(u32x2*)(VT + (32 * w + 16 * vi + fr) * VS + 16 * kb + 4 * fq) = pk; }
    __syncthreads();
#pragma unroll
    for (int i = 0; i < 8; ++i) { const int idx = tid + 512 * i; *(u32x4*)(Cst + (idx >> 4) * 128 + (idx & 15) * 8) = *(const u32x4*)(VT + (idx >> 4) * VS + (idx & 15) * 8); }
    { const int k = tid >> 2, part = tid & 3; float sacc = 0.f;
#pragma unroll
        for (int q = 0; q < 4; ++q) { const bf16x8 t8 = *(const bf16x8*)(KT + k * VS + part * 32 + q * 8);
#pragma unroll
            for (int i = 0; i < 8; ++i) sacc += bfs2f(t8[i]); }
        sacc += __shfl_xor(sacc, 1); sacc += __shfl_xor(sacc, 2);
        if (part == 0) F_NST[(size_t)uidx * 128 + k] = sacc; }
    __syncthreads();
}
__device__ __forceinline__ int scan_slot(int d, int step) { return d == 0 ? step : (step == 0 ? 1 : (step == 1 ? 0 : 35 - step)); }
__device__ __forceinline__ void phase_scan(Fr& F, const bool dost = true) {
    const long nth = (long)F.G * 512;
    for (long gid = (long)F.bx * 512 + F.tid; gid < 32 * 4096; gid += nth) {
        const int seq = (int)(gid >> 12), vec = (int)(gid & 4095), d = seq & 1;
        bf16_t* base = F_CST + (size_t)seq * NSLOT * 32768 + vec * 8;
        float* nbase = F_NST + (size_t)seq * NSLOT * 128 + (vec & 15) * 8;
        const bool hasn = vec < 16;
        float z0 = 0.f; asm volatile("" : "+v"(z0));
        float st[8] = {z0, z0, z0, z0, z0, z0, z0, z0}, sn[8] = {z0, z0, z0, z0, z0, z0, z0, z0}; float m = 0.f;
        int slot = scan_slot(d, 0), slot1 = scan_slot(d, 1);
        bf16x8 cl = *(const bf16x8*)(base + (size_t)slot * 32768), cl1 = *(const bf16x8*)(base + (size_t)slot1 * 32768);
        f32x4 n0 = {0.f, 0.f, 0.f, 0.f}, n1 = {0.f, 0.f, 0.f, 0.f}, p0 = n0, p1 = n0;
        if (hasn) { n0 = *(const f32x4*)(nbase + slot * 128); n1 = *(const f32x4*)(nbase + slot * 128 + 4); p0 = *(const f32x4*)(nbase + slot1 * 128); p1 = *(const f32x4*)(nbase + slot1 * 128 + 4); }
        float g = F_GT[seq * NSLOT + slot], mc = F_MLOC[seq * NSLOT + slot], g1 = F_GT[seq * NSLOT + slot1], mc1 = F_MLOC[seq * NSLOT + slot1];
#pragma unroll 1
        for (int step = 0; step < NSLOT; ++step) {
            const int slot2 = scan_slot(d, step + 2 < NSLOT ? step + 2 : NSLOT - 1);
            const bool ld2 = step + 2 < NSLOT;
            bf16x8 cl2 = cl1; f32x4 q0 = p0, q1 = p1; float g2 = g1, mc2 = mc1;
            if (ld2) { cl2 = *(const bf16x8*)(base + (size_t)slot2 * 32768);
                if (hasn) { q0 = *(const f32x4*)(nbase + slot2 * 128); q1 = *(const f32x4*)(nbase + slot2 * 128 + 4); }
                g2 = F_GT[seq * NSLOT + slot2]; mc2 = F_MLOC[seq * NSLOT + slot2]; }
            asm volatile("" ::: "memory");
            if (dost) { u32x4 o; o.x = pk2(st[0], st[1]); o.y = pk2(st[2], st[3]); o.z = pk2(st[4], st[5]); o.w = pk2(st[6], st[7]);
                *(u32x4*)(base + (size_t)slot * 32768) = o;
                if (hasn) { *(f32x4*)(nbase + slot * 128) = (f32x4){sn[0], sn[1], sn[2], sn[3]}; *(f32x4*)(nbase + slot * 128 + 4) = (f32x4){sn[4], sn[5], sn[6], sn[7]}; } }
            if (vec == 0) F_MIN[seq * NSLOT + slot] = m;
            const float mn = fmaxf(g + m, mc), a = __expf(g + m - mn), s = __expf(mc - mn);
#pragma unroll
            for (int i = 0; i < 8; ++i) st[i] = a * st[i] + s * bfs2f(cl[i]);
#pragma unroll
            for (int i = 0; i < 4; ++i) { sn[i] = a * sn[i] + s * n0[i]; sn[4 + i] = a * sn[4 + i] + s * n1[i]; }
            m = mn; cl = cl1; n0 = p0; n1 = p1; g = g1; mc = mc1; slot = slot1;
            cl1 = cl2; p0 = q0; p1 = q1; g1 = g2; mc1 = mc2; slot1 = slot2; }
    }
}
__device__ __forceinline__ void mls_out_unit(Fr& F, int cidx, int hh, int l, const bool dost = true) {
    bf16_t* VT = (bf16_t*)(F.lds + LDS_VT); bf16_t* Kc = (bf16_t*)(F.lds + LDS_KT); float* fs = (float*)(F.lds + LDS_FS);
    float* lf_s = fs; float* li_s = fs + 256; float* csrc = fs + 512; float* mm = fs + 768; float* bj = fs + 1024;
    bf16_t* Ch = (bf16_t*)(F.lds + LDS_CH);
    const int tid = F.tid, lane = F.lane, w = F.wave, fr = lane & 15, fq = lane >> 4;
    const size_t R0 = (size_t)cidx * 128; int b, slot; chunk_bs(cidx, b, slot);
    if (tid < 256) { const int dd = tid >> 7, t = tid & 127; lf_s[tid] = F_LF[(R0 + t) * 8 + dd * 4 + hh]; li_s[tid] = F_LI[(R0 + t) * 8 + dd * 4 + hh]; }
    stage_vt(F, VT, R0, hh);
    for (int idx = tid; idx < 2048; idx += 512) { const int l2 = idx >> 4, c8 = idx & 15;
        *(bf16x8*)(Kc + l2 * VS + c8 * 8) = *(const bf16x8*)(F_P + (R0 + l2) * NP + C_MK + hh * 128 + c8 * 8); }
    __syncthreads();
    {
        float* tmp = (float*)(F.lds + LDS_CH);
        const bool act = tid < 256; const int dd = (tid >> 7) & 1, wp = w & 1;
        const float lfv = act ? lf_s[tid] : 0.f; float p = lfv;
#pragma unroll
        for (int o = 1; o < 64; o <<= 1) { const float t = __shfl_up(p, o); if (lane >= o) p += t; }
        if (act && lane == 63) tmp[w] = p;
        __syncthreads();
        const float t0 = tmp[2 * dd], t1 = tmp[2 * dd + 1], gt_ = t0 + t1;
        const float bfwd = p + (wp ? t0 : 0.f);
        const float bsum = dd == 0 ? bfwd : gt_ - bfwd + lfv;
        const float cs = act ? li_s[tid] - bsum : -3.0e38f;
        float pmx = cs, smx = cs;
#pragma unroll
        for (int o = 1; o < 64; o <<= 1) { const float a = __shfl_up(pmx, o), c = __shfl_down(smx, o); if (lane >= o) pmx = fmaxf(pmx, a); if (lane + o < 64) smx = fmaxf(smx, c); }
        if (act && lane == 63) tmp[4 + w] = pmx;
        __syncthreads();
        if (act) { const float other = tmp[4 + (w ^ 1)];
            float cm = dd == 0 ? (wp ? fmaxf(pmx, other) : pmx) : (wp ? smx : fmaxf(smx, other));
            cm = fmaxf(cm, F_MIN[unit_idx(b, hh, dd, slot)]);
            bj[tid] = bsum; csrc[tid] = cs; mm[tid] = cm; }
    }
    __syncthreads();
    const int j = 16 * w + fr;
    const bf16_t* prow = F_P + (R0 + j) * NP;
    f32x4 acc[16];
#pragma unroll
    for (int vb = 0; vb < 16; ++vb) acc[vb] = (f32x4){0.f, 0.f, 0.f, 0.f};
#pragma unroll 1
    for (int dd = 0; dd < 2; ++dd) {
        int jj = j; asm volatile("" : "+v"(jj));
        bf16x8 Yq[4];
#pragma unroll
        for (int kb = 0; kb < 4; ++kb) Yq[kb] = *(const bf16x8*)(F_P + (R0 + jj) * NP + C_MQ + hh * 128 + kb * 32 + 8 * fq);
        const int sgn = dd == 0 ? 1 : -1; const int bs = (4 * fq - jj) * sgn;
        const int uidx = unit_idx(b, hh, dd, slot);
        const bf16_t* Cin = F_CST + (size_t)uidx * 32768;
        const float m_in = F_MIN[uidx], mmj = mm[dd * 128 + j], bjj = bj[dd * 128 + j];
        f32x4 Sa[8];
#pragma unroll
        for (int sb = 0; sb < 8; ++sb) { Sa[sb] = (f32x4){0.f, 0.f, 0.f, 0.f};
#pragma unroll
            for (int kb = 0; kb < 4; ++kb) { const bf16x8 kf = *(const bf16x8*)(Kc + (16 * sb + fr) * VS + kb * 32 + 8 * fq);
                Sa[sb] = __builtin_amdgcn_mfma_f32_16x16x32_bf16(kf, Yq[kb], Sa[sb], 0, 0, 0); }
            __builtin_amdgcn_sched_barrier(0); }
        float dsum = 0.f;
#pragma unroll
        for (int sb = 0; sb < 8; ++sb)
#pragma unroll
            for (int e = 0; e < 4; ++e) { const int s = 16 * sb + 4 * fq + e; const bool valid = (bs + sgn * (16 * sb + e)) <= 0;
                const float wv = valid ? __expf(csrc[dd * 128 + s] - mmj) * Sa[sb][e] * QK_SCALE : 0.f; Sa[sb][e] = wv; dsum += wv; }
        dsum += __shfl_xor(dsum, 16); dsum += __shfl_xor(dsum, 32);
        float nq = 0.f; const float* nst = F_NST + (size_t)uidx * 128;
#pragma unroll
        for (int kb = 0; kb < 4; ++kb) { const f32x4 n0 = *(const f32x4*)(nst + kb * 32 + 8 * fq), n1 = *(const f32x4*)(nst + kb * 32 + 8 * fq + 4);
            nq += bfs2f(Yq[kb][0]) * n0[0] + bfs2f(Yq[kb][1]) * n0[1] + bfs2f(Yq[kb][2]) * n0[2] + bfs2f(Yq[kb][3]) * n0[3]
                + bfs2f(Yq[kb][4]) * n1[0] + bfs2f(Yq[kb][5]) * n1[1] + bfs2f(Yq[kb][6]) * n1[2] + bfs2f(Yq[kb][7]) * n1[3]; }
        nq += __shfl_xor(nq, 16); nq += __shfl_xor(nq, 32);
        const float inter = __expf(m_in - mmj);
        const float den = dsum + inter * nq;
        const float rden = 1.f / fmaxf(fabsf(den), __expf(-(bjj + mmj)));
        bf16x8 Wf[4], Yqs[4]; const float qsc = inter * rden;
#pragma unroll
        for (int kb = 0; kb < 4; ++kb) {
            u32x4 t; t.x = pk2(Sa[2 * kb][0] * rden, Sa[2 * kb][1] * rden); t.y = pk2(Sa[2 * kb][2] * rden, Sa[2 * kb][3] * rden);
            t.z = pk2(Sa[2 * kb + 1][0] * rden, Sa[2 * kb + 1][1] * rden); t.w = pk2(Sa[2 * kb + 1][2] * rden, Sa[2 * kb + 1][3] * rden);
            Wf[kb] = *reinterpret_cast<bf16x8*>(&t);
            u32x4 q; q.x = pk2(bfs2f(Yq[kb][0]) * qsc, bfs2f(Yq[kb][1]) * qsc); q.y = pk2(bfs2f(Yq[kb][2]) * qsc, bfs2f(Yq[kb][3]) * qsc);
            q.z = pk2(bfs2f(Yq[kb][4]) * qsc, bfs2f(Yq[kb][5]) * qsc); q.w = pk2(bfs2f(Yq[kb][6]) * qsc, bfs2f(Yq[kb][7]) * qsc);
            Yqs[kb] = *reinterpret_cast<bf16x8*>(&q); }
        bf16x8 pr[4];
#pragma unroll
        for (int i = 0; i < 4; ++i) { const int idx = tid + 512 * i; pr[i] = *(const bf16x8*)(Cin + (idx >> 4) * 128 + (idx & 15) * 8); }
#pragma unroll
        for (int h = 0; h < 2; ++h) {
            __syncthreads();
#pragma unroll
            for (int i = 0; i < 4; ++i) { const int idx = tid + 512 * i; *(bf16x8*)(Ch + (idx >> 4) * VS + (idx & 15) * 8) = pr[i]; }
            if (h == 0) {
#pragma unroll
                for (int i = 0; i < 4; ++i) { const int idx = tid + 512 * i; pr[i] = *(const bf16x8*)(Cin + (128 + (idx >> 4)) * 128 + (idx & 15) * 8); } }
            __syncthreads();
#pragma unroll
            for (int v8 = 0; v8 < 8; ++v8) { const int vb = 8 * h + v8;
#pragma unroll
                for (int kb = 0; kb < 4; ++kb) { const bf16x8 cf = *(const bf16x8*)(Ch + (16 * v8 + fr) * VS + kb * 32 + 8 * fq);
                    acc[vb] = __builtin_amdgcn_mfma_f32_16x16x32_bf16(cf, Yqs[kb], acc[vb], 0, 0, 0); }
#pragma unroll
                for (int kb = 0; kb < 4; ++kb) {
                    const u32x2 lo = *(const u32x2*)(VT + (16 * vb + fr) * VS + 32 * kb + 4 * fq), hi2 = *(const u32x2*)(VT + (16 * vb + fr) * VS + 32 * kb + 16 + 4 * fq);
                    u32x4 t; t.x = lo.x; t.y = lo.y; t.z = hi2.x; t.w = hi2.y;
                    acc[vb] = __builtin_amdgcn_mfma_f32_16x16x32_bf16(*reinterpret_cast<bf16x8*>(&t), Wf[kb], acc[vb], 0, 0, 0); }
                __builtin_amdgcn_sched_barrier(0);
            }
        }
    }
    float ss = 0.f;
#pragma unroll
    for (int vb = 0; vb < 16; ++vb) ss += (acc[vb][0] * acc[vb][0] + acc[vb][1] * acc[vb][1]) + (acc[vb][2] * acc[vb][2] + acc[vb][3] * acc[vb][3]);
    ss += __shfl_xor(ss, 16); ss += __shfl_xor(ss, 32);
    const float rinv = 1.f / sqrtf(ss * (1.f / 256.f) + EPS);
    const float* hg = F.ap->in[I_MLHG] + l * 1024 + hh * 256;
    bf16_t* orow = F_P + (R0 + j) * NP + C_O + hh * 256;
#pragma unroll
    for (int vb = 0; vb < 16; ++vb) { const int v0 = 16 * vb + 4 * fq;
        const u32x2 oraw = *(const u32x2*)(orow + v0); const f32x4 g4 = *(const f32x4*)(hg + v0);
        const float o0 = __uint_as_float(oraw.x << 16), o1 = __uint_as_float(oraw.x & 0xffff0000u), o2 = __uint_as_float(oraw.y << 16), o3 = __uint_as_float(oraw.y & 0xffff0000u);
        u32x2 wv; wv.x = pk2(acc[vb][0] * rinv * g4[0] * sigmoidf_(o0), acc[vb][1] * rinv * g4[1] * sigmoidf_(o1));
        wv.y = pk2(acc[vb][2] * rinv * g4[2] * sigmoidf_(o2), acc[vb][3] * rinv * g4[3] * sigmoidf_(o3));
        if (dost) *(u32x2*)(orow + v0) = wv; }
    __syncthreads();
}

#ifndef PHM
#define PHM 0xFFFF
#endif
#ifndef DUPM
#define DUPM 0
#endif
#define DOST (rep_ == ((DUPM >> RB_) & 1))
#define REP(bit) for (int rep_ = 0, RB_ = (bit); rep_ < ((DUPM >> (bit)) & 1) + 1; ++rep_)
#define GSYNC() do { ArgsP sa_ = (ArgsP)__builtin_amdgcn_kernarg_segment_ptr(); asm volatile("" : "+s"(sa_)); \
    XcdBarrier xb_; xb_.bar = (unsigned*)sa_->ws; xb_.x = xb_xcc_id(); xb_.st = misc; xcd_barrier(xb_); if (DUPM & 0x8000) xcd_barrier(xb_); } while (0)
__global__ void __launch_bounds__(512, 2) fwd_megakernel(Args args) {
    extern __shared__ __attribute__((aligned(16))) unsigned char lds_raw[];
    cg::grid_group grid = cg::this_grid();
    Fr F;
    F.lds = (char*)lds_raw; F.tid = threadIdx.x; F.lane = F.tid & 63; F.wave = __builtin_amdgcn_readfirstlane(F.tid >> 6);
    F.G = gridDim.x; F.bx = blockIdx.x; { const int bx = blockIdx.x; F.vcu = (F.G % 8 == 0) ? (bx % 8) * (F.G / 8) + bx / 8 : bx; }
    F.gw = F.bx * 8 + F.wave; F.NGW = F.G * 8;
    F.ap = (ArgsP)__builtin_amdgcn_kernarg_segment_ptr();
    LAS unsigned char* lds3 = (LAS unsigned char*)lds_raw;
#define PHB() do { int t_ = threadIdx.x; asm volatile("" : "+v"(t_)); F.tid = t_; F.lane = t_ & 63; F.wave = __builtin_amdgcn_readfirstlane(t_ >> 6); \
    ArgsP a_ = (ArgsP)__builtin_amdgcn_kernarg_segment_ptr(); asm volatile("" : "+s"(a_)); F.ap = a_; \
    unsigned lo_ = 0u; asm volatile("" : "+s"(lo_)); F.lds3 = lds3 + lo_; F.lds = (char*)F.lds3; \
    int bx_ = blockIdx.x, g_ = gridDim.x; asm volatile("" : "+s"(bx_), "+s"(g_)); F.bx = bx_; F.G = g_; F.vcu = (g_ % 8 == 0) ? (bx_ % 8) * (g_ / 8) + bx_ / 8 : bx_; F.gw = bx_ * 8 + F.wave; F.NGW = g_ * 8; } while (0)

#if PHM & (1<<0)
    volatile LAS unsigned* misc = (volatile LAS unsigned*)(lds3 + LDS_BYTES - 256);
    if (threadIdx.x < 2) misc[threadIdx.x] = 0u;
    if (blockIdx.x == 0) { unsigned* bw = (unsigned*)WSB; for (int i = threadIdx.x; i < XCD_BAR_WORDS; i += 512) __hip_atomic_store(bw + i, 0u, __ATOMIC_RELAXED, __HIP_MEMORY_SCOPE_AGENT); }
    __syncthreads();
    REP(0) { PHB();
    mod_gemv(F);
    convert_weights(F, 0); }
#endif
    __threadfence(); grid.sync();
    (void)xcd_barrier_post((unsigned*)WSB, misc);
#if PHM & (1<<1)
    REP(1) { PHB();
    phase_norm1(F, 0, F.ap->in[I_X], F.ap->in[I_CTX]); }
#endif
    GSYNC();

    for (int l = 0; l < 2; ++l) {
        const bool last = (l == 1);
        const int nMall = last ? 64 : 68;
#if PHM & (1<<2)
        PHB();
        REP(2)
        { PHB(); pg8::Gemm g{F_H, F_H, F_H, (const bf16_t*)(WSB + WS_WIN), (const bf16_t*)(WSB + WS_WIN), (const bf16_t*)(WSB + WS_WIN), D, D, 0};
          pg8::Sched S; if (!last) S.init(68, 47, 1, F.G, F.bx); else S.init(64, 47, 1, F.G, F.bx, 64, 4, 9);
          pg8::EpiWin E{F_P, (unsigned char*)(WSB + WS_G8)};
          pg8::gemm_phase<pg8::EpiWin>(F.lds3, g, S, E, F.tid); }
#endif
        GSYNC();
#if PHM & (1<<3)
        REP(3) { PHB();
        phase_prep(F, l, DOST); }
#endif
        __syncthreads();
#if PHM & (1<<5)
        REP(5) { PHB();
        for (int u = F.G - 1 - F.bx; u < 136 * 8; u += F.G) { const int cidx = u >> 3, hh = (u >> 1) & 3, d = u & 1; mls_cloc_unit(F, cidx, hh, d, l); } }
#endif
        GSYNC();
#if PHM & (1<<4)
        REP(4)
        { PHB(); const bf16_t* wp = (const bf16_t*)(WSB + WS_WPL);
          pg8::Gemm g{F_MIX, F_MIX, F_MIX, wp, wp, wp, 1024, 256, 512};
          pg8::Sched S; S.init(nMall, 4, 1, F.G, F.G - 1 - F.bx);
          pg8::EpiBf16 E{F_P + C_PL, NP};
          pg8::gemm_phase<pg8::EpiBf16>(F.lds3, g, S, E, F.tid); }
#endif
        __syncthreads();
#if PHM & (1<<6)
        REP(6) { PHB();
        phase_scan(F, DOST); }
#endif
        GSYNC();
        { const int nchunk = last ? 128 : 136;
#if PHM & (1<<7)
          REP(7) { PHB();
          for (int u = F.bx; u < nchunk * 4; u += F.G) mls_out_unit(F, u >> 2, u & 3, l, DOST); }
#endif
#if PHM & (1<<8)
          REP(8) { PHB();
          const int nun = last ? 512 : 544;
          for (int u = F.vcu; u < nun; u += F.G) {
              if (u < 512) { const int qb = u & 15, hq = (u >> 4) & 3, kvh = (u >> 6) & 1, b = u >> 7, h = kvh * 4 + hq;
                  const size_t rq = (size_t)b * SEQ + qb * 256, rk = (size_t)b * SEQ, rc = (size_t)ML + b * CTXL;
                  att::attn_dense_body(F_P + rq * NP + C_AQ + h * 128, F_P + rk * NP + C_AK + kvh * 128,
                                       F_P + rc * NP + C_AK + kvh * 128, 64, F_P + rq * NP + C_AQ + h * 128, 68, F.lds, F.tid, DOST);
              } else { const int v = u - 512, b = v >> 3, h = v & 7, kvh = h >> 2; const size_t rc = (size_t)ML + b * CTXL;
                  att::attn_dense_body(F_P + rc * NP + C_AQ + h * 128, F_P + rc * NP + C_AK + kvh * 128,
                                       F_P + rc * NP + C_AK + kvh * 128, 4, F_P + rc * NP + C_AQ + h * 128, 4, F.lds, F.tid, DOST); }
          } }
#endif
        }
        GSYNC();
#if PHM & (1<<9)
        PHB();
        REP(9)
        { PHB(); const bf16_t* wu = (const bf16_t*)(WSB + WS_WUP);
          pg8::Gemm g{F_P + C_AQ, F_P + C_O, F_P + C_PL, wu, wu + (size_t)D * 1024, wu + (size_t)2 * D * 1024, NP, 1024, 0};
          pg8::Sched S; S.init(nMall, 8, 3, F.G, F.bx);
          pg8::EpiGate E{(const unsigned char*)(WSB + WS_G8), F_H};
          pg8::gemm_phase<pg8::EpiGate>(F.lds3, g, S, E, F.tid); }
#endif
        GSYNC();
#if PHM & (1<<10)
        PHB();
        REP(10)
        { PHB(); const bf16_t* wo = (const bf16_t*)(WSB + WS_WOUT);
          pg8::Gemm g{F_H, F_H, F_H, wo, wo, wo, D, D, 0};
          pg8::Sched S; S.init(nMall, 8, 1, F.G, F.bx);
          pg8::EpiBf16 E{(bf16_t*)(WSB + WS_YO), D};
          pg8::gemm_phase<pg8::EpiBf16>(F.lds3, g, S, E, F.tid); }
#endif
        GSYNC();
#if PHM & (1<<11)
        REP(11) { PHB();
        phase_resid(F, l, 0, nMall * 256, F.ap->in[I_X], l == 0 ? F.ap->in[I_CTX] : F_XC, false, l != 0, true, DOST); }
#endif
        GSYNC();
#if PHM & (1<<12)
        PHB();
        REP(12)
        { PHB(); const bf16_t* wf = (const bf16_t*)(WSB + WS_WFI);
          pg8::Gemm g{F_H, F_H, F_H, wf, wf, wf, D, D, 0};
          pg8::Sched S; S.init(nMall, 44, 1, F.G, F.bx);
          pg8::EpiSwiglu E{(bf16_t*)(WSB + WS_HID)};
          pg8::gemm_phase<pg8::EpiSwiglu>(F.lds3, g, S, E, F.tid); }
#endif
        GSYNC();
#if PHM & (1<<13)
        PHB();
        REP(13)
        { PHB(); const bf16_t* wf = (const bf16_t*)(WSB + WS_WFO); const bf16_t* hid = (const bf16_t*)(WSB + WS_HID);
          pg8::Gemm g{hid, hid, hid, wf, wf, wf, DFF, DFF, 0};
          pg8::Sched S; S.init(nMall, 8, 1, F.G, F.bx);
          pg8::EpiBf16 E{(bf16_t*)(WSB + WS_YO), D};
          pg8::gemm_phase<pg8::EpiBf16>(F.lds3, g, S, E, F.tid); }
#endif
        GSYNC();
#if PHM & (1<<14)
        REP(14) { PHB();
        phase_resid(F, l, 1, nMall * 256, F.ap->in[I_X], F_XC, !last, true, !last, DOST);
        if (!last) { __syncthreads(); convert_weights(F, 1); } }
#endif
        GSYNC();
    }
}

extern "C" void kernel_launch(void* const* d_in, const int* in_sizes, int n_in, void* d_out, int out_size, void* d_ws, size_t ws_size, hipStream_t stream) {
    static int grid = 0;
    if (grid == 0) {
        if (n_in != 19 || out_size != ML * D || ws_size < WS_END) { fprintf(stderr, "kernel_launch: unexpected shapes n_in %d out %d ws %zu (need %zu)\n", n_in, out_size, ws_size, (size_t)WS_END); grid = -1; return; }
        int dev = 0, cus = 0, per_cu = 0;
        hipGetDevice(&dev); hipDeviceGetAttribute(&cus, hipDeviceAttributeMultiprocessorCount, dev);
        if (hipFuncSetAttribute((const void*)fwd_megakernel, hipFuncAttributeMaxDynamicSharedMemorySize, LDS_BYTES) != hipSuccess) { fprintf(stderr, "kernel_launch: hipFuncSetAttribute failed\n"); grid = -1; return; }
        if (hipOccupancyMaxActiveBlocksPerMultiprocessor(&per_cu, (const void*)fwd_megakernel, 512, LDS_BYTES) != hipSuccess || per_cu < 1) { fprintf(stderr, "kernel_launch: occupancy query gave %d\n", per_cu); per_cu = 1; }
        (void)hipGetLastError();
        grid = cus * 1;
        fprintf(stderr, "kernel_launch: cus %d per_cu %d grid %d\n", cus, per_cu, grid);
    }
    if (grid < 0) return;
    Args a{};
    for (int i = 0; i < 19; ++i) a.in[i] = (const float*)d_in[i];
    a.out = (float*)d_out; a.ws = (unsigned char*)d_ws;
    void* kargs[] = {&a};
    hipError_t e = hipLaunchCooperativeKernel((const void*)fwd_megakernel, dim3(grid), dim3(512), kargs, LDS_BYTES, stream);
    if (e != hipSuccess) fprintf(stderr, "cooperative launch failed: %s (grid %d)\n", hipGetErrorString(e), grid);
}
```

```cpp
#include <hip/hip_runtime.h>
#include <hip/hip_cooperative_groups.h>
#include <cstdio>
#include <cstdint>
namespace cg = cooperative_groups;

#define LAS __attribute__((address_space(3)))
typedef unsigned short bf16_t;
typedef short bf16x8 __attribute__((ext_vector_type(8)));
typedef short s16x4 __attribute__((ext_vector_type(4)));
typedef float f32x4 __attribute__((ext_vector_type(4)));
typedef float f32x16 __attribute__((ext_vector_type(16)));
typedef unsigned u32x4 __attribute__((ext_vector_type(4)));
typedef unsigned u32x2 __attribute__((ext_vector_type(2)));

constexpr int D = 2048, NB = 4, SEQ = 4096, CTXL = 256;
constexpr int ML = NB * SEQ, MC = NB * CTXL, MT = ML + MC;
constexpr int DIN = 11792, NP = 5888, NWIN = 12032, NG = 6144, DFF = 5632;
constexpr int C_AK = 0, C_AV = 256, C_MK = 512, C_MV = 1024, C_GI = 2048, C_GF = 2056, C_AQ = 2064, C_MQ = 3088, C_O = 3600, C_PL = 4624, C_GRAW = 5648;
constexpr float EPS = 1e-6f;
constexpr int NSLOT = 34, NUNIT = NB * 4 * 2 * NSLOT;
constexpr float QK_SCALE = 0.08838834764831845f;

constexpr size_t MiB = 1u << 20;
constexpr size_t WS_MOD = 1 * MiB;
constexpr size_t WS_LI = 2 * MiB;
constexpr size_t WS_LF = 3 * MiB;
constexpr size_t WS_GT = 4 * MiB;
constexpr size_t WS_NST = 5 * MiB;
constexpr size_t WS_WIN = 6 * MiB;
constexpr size_t WS_WFI = 54 * MiB;
constexpr size_t WS_WFO = 98 * MiB;
constexpr size_t WS_WUP = 120 * MiB;
constexpr size_t WS_WOUT = 132 * MiB;
constexpr size_t WS_WPL = 140 * MiB;
constexpr size_t WS_XC = 141 * MiB;
constexpr size_t WS_H = 149 * MiB;
constexpr size_t WS_P = 217 * MiB;
constexpr size_t WS_MIX = 617 * MiB;
constexpr size_t WS_CST = 651 * MiB;
constexpr size_t WS_XB = 719 * MiB;
constexpr size_t WS_END = 783 * MiB;
constexpr size_t WS_YO = WS_P;
constexpr size_t WS_G8 = WS_P + 196 * MiB;
constexpr size_t WS_HID = WS_P + 160 * MiB;

constexpr int LDS_BYTES = 147456;

__device__ __forceinline__ float bf2f(bf16_t v) { return __uint_as_float((unsigned)v << 16); }
__device__ __forceinline__ float bfs2f(short v) { return __uint_as_float(((unsigned)(unsigned short)v) << 16); }
typedef float f32x2_t __attribute__((ext_vector_type(2))); typedef __bf16 bf16x2_t __attribute__((ext_vector_type(2)));
__device__ __forceinline__ unsigned pk2(float lo, float hi) { const f32x2_t v = {lo, hi}; const bf16x2_t b = __builtin_convertvector(v, bf16x2_t); return __builtin_bit_cast(unsigned, b); }
__device__ __forceinline__ unsigned f2bf(float f) { return pk2(f, 0.f) & 0xffffu; }
__device__ __forceinline__ float wave_sum(float v) {
#pragma unroll
    for (int o = 1; o < 64; o <<= 1) v += __shfl_xor(v, o);
    return v;
}
__device__ __forceinline__ float sigmoidf_(float x) { return __builtin_amdgcn_rcpf(1.f + __expf(-x)); }

struct Args { const float* in[19]; float* out; unsigned char* ws; };
enum { I_X = 0, I_C, I_CTX, I_CCTX, I_WMOD, I_BMOD, I_NORMG, I_WIN, I_GATEB, I_QKG, I_MLHG, I_POOLW, I_POOLS, I_UPA, I_UPM, I_UPP, I_WOUT, I_FFI, I_FFO };

namespace pg8 {
constexpr int BM = 256, BK = 64, HALF = 128, HTB = HALF * BK * 2, STAGE_BYTES = 8 * HTB, NXCD = 8, WGM = 8;
__host__ __device__ __forceinline__ int lds_byte(int r, int c) { const int st = (r >> 4) * 2 + (c >> 5), rr = r & 15, cc = c & 31, ob = rr * 64 + cc * 2; return st * 1024 + (ob ^ (((ob >> 9) & 1) << 5)); }
__host__ __device__ __forceinline__ void stage_rc(int b, int& R, int& C) { const int st = b / 1024, sb = b % 1024, swz = sb ^ (((sb >> 9) & 1) << 5); R = (st >> 1) * 16 + swz / 64; C = (st & 1) * 32 + (swz % 64) / 2; }
__host__ __device__ __forceinline__ int perm32(int rho) { const int n = rho >> 4, i = rho & 15; return 8 * (i >> 2) + 4 * n + (i & 3); }

struct Unit { int pm, pn, br; };
struct Gemm { const bf16_t* A0; const bf16_t* A1; const bf16_t* A2; const bf16_t* B0; const bf16_t* B1; const bf16_t* B2; int lda; int K; int apn; };

struct Sched {
    int nM, nN, nBr, G, c, nT1, pm2, nM2, nT;
    __device__ void init(int nM_, int nN_, int nBr_, int G_, int c_, int pm2_ = 0, int nM2_ = 0, int nN2_ = 0) {
        nM = nM_; nN = nN_; nBr = nBr_; G = G_; c = c_; nT1 = nM * nN; pm2 = pm2_; nM2 = nM2_; nT = nT1 + nM2_ * nN2_; }
    __device__ bool next(int i, Unit& u) const {
        const int it = i / nBr; u.br = i - it * nBr;
        const long L = (long)it * G + c; if (L >= nT) return false;
        if (L < nT1) {
            int wgid = (int)L; { const int q = nT1 / NXCD, r = nT1 % NXCD, xcd = wgid % NXCD, off = wgid / NXCD; wgid = (xcd < r ? xcd * (q + 1) : r * (q + 1) + (xcd - r) * q) + off; }
            const int nig = WGM * nN, gid = wgid / nig, fm = gid * WGM, gsz = (nM - fm) < WGM ? (nM - fm) : WGM;
            u.pm = fm + ((wgid % nig) % gsz); u.pn = (wgid % nig) / gsz;
        } else { const int r = (int)L - nT1; u.pm = pm2 + r % nM2; u.pn = r / nM2; }
        return true;
    }
};

__device__ __forceinline__ unsigned cvt_pk_bf16(float lo, float hi) { return pk2(lo, hi); }

struct EpiBf16 {
    static constexpr bool PERM = true;
    bf16_t* O; int ldc;
    __device__ __forceinline__ bool operator()(f32x4 (&acc)[2][2][4][2], const Unit& u, int wr, int wc, int fr, int fq) const {
        const int row0 = u.pm * BM + wr * 64 + fr, col0 = u.pn * BM + wc * 32 + 8 * fq;
#pragma unroll
        for (int ai = 0; ai < 2; ++ai)
#pragma unroll
            for (int m = 0; m < 4; ++m) { bf16_t* rowp = O + (size_t)(row0 + ai * HALF + m * 16) * ldc + col0;
#pragma unroll
                for (int bj = 0; bj < 2; ++bj) { const f32x4 v0 = acc[ai][bj][m][0], v1 = acc[ai][bj][m][1];
                    u32x4 w; w.x = cvt_pk_bf16(v0[0], v0[1]); w.y = cvt_pk_bf16(v0[2], v0[3]); w.z = cvt_pk_bf16(v1[0], v1[1]); w.w = cvt_pk_bf16(v1[2], v1[3]);
                    *(u32x4*)(rowp + bj * HALF) = w; } }
        return false;
    }
};
struct EpiWin {
    static constexpr bool PERM = true;
    bf16_t* O; unsigned char* G8;
    __device__ __forceinline__ bool operator()(f32x4 (&acc)[2][2][4][2], const Unit& u, int wr, int wc, int fr, int fq) const {
        const int row0 = u.pm * BM + wr * 64 + fr;
        if (u.pn < 23) {
            const int col0 = u.pn * BM + wc * 32 + 8 * fq;
#pragma unroll
            for (int ai = 0; ai < 2; ++ai)
#pragma unroll
                for (int m = 0; m < 4; ++m) { bf16_t* rowp = O + (size_t)(row0 + ai * HALF + m * 16) * NP + col0;
#pragma unroll
                    for (int bj = 0; bj < 2; ++bj) { const f32x4 v0 = acc[ai][bj][m][0], v1 = acc[ai][bj][m][1];
                        u32x4 w; w.x = cvt_pk_bf16(v0[0], v0[1]); w.y = cvt_pk_bf16(v0[2], v0[3]); w.z = cvt_pk_bf16(v1[0], v1[1]); w.w = cvt_pk_bf16(v1[2], v1[3]);
                        *(u32x4*)(rowp + bj * HALF) = w; } }
        } else {
            const int col0 = (u.pn - 23) * BM + wc * 32 + 8 * fq;
#pragma unroll
            for (int ai = 0; ai < 2; ++ai)
#pragma unroll
                for (int m = 0; m < 4; ++m) { unsigned char* rowp = G8 + (size_t)(row0 + ai * HALF + m * 16) * NG + col0;
#pragma unroll
                    for (int bj = 0; bj < 2; ++bj) { unsigned q[8];
#pragma unroll
                        for (int n = 0; n < 2; ++n)
#pragma unroll
                            for (int e = 0; e < 4; ++e) { const float sg = 256.f * __builtin_amdgcn_rcpf(1.f + __expf(-acc[ai][bj][m][n][e])); q[4 * n + e] = (unsigned)fminf(sg, 255.f); }
                        u32x2 w; w.x = q[0] | (q[1] << 8) | (q[2] << 16) | (q[3] << 24); w.y = q[4] | (q[5] << 8) | (q[6] << 16) | (q[7] << 24);
                        *(u32x2*)(rowp + bj * HALF) = w; } }
        }
        return false;
    }
};
struct EpiF32 {
    static constexpr bool PERM = false;
    float* C; int ldc;
    __device__ __forceinline__ bool operator()(f32x4 (&acc)[2][2][4][2], const Unit& u, int wr, int wc, int fr, int fq) const {
        const int row0 = u.pm * BM + wr * 64 + fr, col0 = u.pn * BM + wc * 32 + 4 * fq;
#pragma unroll
        for (int ai = 0; ai < 2; ++ai)
#pragma unroll
            for (int m = 0; m < 4; ++m) { float* rowp = C + (size_t)(row0 + ai * HALF + m * 16) * ldc + col0;
#pragma unroll
                for (int bj = 0; bj < 2; ++bj)
#pragma unroll
                    for (int n = 0; n < 2; ++n) *(f32x4*)(rowp + bj * HALF + n * 16) = acc[ai][bj][m][n]; }
        return false;
    }
};
struct EpiSwiglu {
    static constexpr bool PERM = true;
    bf16_t* O;
    __device__ __forceinline__ bool operator()(f32x4 (&acc)[2][2][4][2], const Unit& u, int wr, int wc, int fr, int fq) const {
        const int row0 = u.pm * BM + wr * 64 + fr, col0 = u.pn * HALF + wc * 32 + 8 * fq;
#pragma unroll
        for (int ai = 0; ai < 2; ++ai)
#pragma unroll
            for (int m = 0; m < 4; ++m) { bf16_t* rowp = O + (size_t)(row0 + ai * HALF + m * 16) * DFF + col0;
                float r[8];
#pragma unroll
                for (int n = 0; n < 2; ++n)
#pragma unroll
                    for (int e = 0; e < 4; ++e) { const float g = acc[ai][0][m][n][e], up = acc[ai][1][m][n][e]; r[4 * n + e] = g * up * __builtin_amdgcn_rcpf(1.f + __expf(-g)); }
                u32x4 w; w.x = cvt_pk_bf16(r[0], r[1]); w.y = cvt_pk_bf16(r[2], r[3]); w.z = cvt_pk_bf16(r[4], r[5]); w.w = cvt_pk_bf16(r[6], r[7]);
                *(u32x4*)rowp = w; }
        return false;
    }
};
struct EpiGate {
    static constexpr bool PERM = true;
    const unsigned char* G8; bf16_t* Y;
    __device__ __forceinline__ bool operator()(f32x4 (&acc)[2][2][4][2], const Unit& u, int wr, int wc, int fr, int fq) const {
        const int row0 = u.pm * BM + wr * 64 + fr, col0 = u.pn * BM + wc * 32 + 8 * fq;
        const unsigned char* gp = G8 + (size_t)row0 * NG + u.br * D + col0;
        if (u.br < 2) {
#pragma unroll
            for (int ai = 0; ai < 2; ++ai)
#pragma unroll
                for (int m = 0; m < 4; ++m) { const unsigned char* rp = gp + (size_t)(ai * HALF + m * 16) * NG;
                    u32x2 ga[2], gb[2];
#pragma unroll
                    for (int bj = 0; bj < 2; ++bj) { ga[bj] = *(const u32x2*)(rp + bj * HALF); gb[bj] = *(const u32x2*)(rp + D + bj * HALF); }
#pragma unroll
                    for (int bj = 0; bj < 2; ++bj)
#pragma unroll
                        for (int n = 0; n < 2; ++n)
#pragma unroll
                            for (int e = 0; e < 4; ++e) { const float sa = (float)(((n ? ga[bj].y : ga[bj].x) >> (8 * e)) & 255u) + 0.5f, sb = (float)(((n ? gb[bj].y : gb[bj].x) >> (8 * e)) & 255u) + 0.5f;
                                acc[ai][bj][m][n][e] *= sa * __builtin_amdgcn_rcpf(sb); } }
            return true;
        }
#pragma unroll
        for (int ai = 0; ai < 2; ++ai)
#pragma unroll
            for (int m = 0; m < 4; ++m) { const size_t roff = (size_t)(ai * HALF + m * 16); const unsigned char* rp = gp + roff * NG;
                u32x2 ga[2];
#pragma unroll
                for (int bj = 0; bj < 2; ++bj) ga[bj] = *(const u32x2*)(rp + bj * HALF);
#pragma unroll
                for (int bj = 0; bj < 2; ++bj) { float r[8];
#pragma unroll
                    for (int n = 0; n < 2; ++n)
#pragma unroll
                        for (int e = 0; e < 4; ++e) r[4 * n + e] = acc[ai][bj][m][n][e] * (((float)(((n ? ga[bj].y : ga[bj].x) >> (8 * e)) & 255u) + 0.5f) * (1.f / 256.f));
                    u32x4 w; w.x = cvt_pk_bf16(r[0], r[1]); w.y = cvt_pk_bf16(r[2], r[3]); w.z = cvt_pk_bf16(r[4], r[5]); w.w = cvt_pk_bf16(r[6], r[7]);
                    *(u32x4*)(Y + ((size_t)row0 + roff) * D + col0 + bj * HALF) = w; } }
        return false;
    }
};

template <class Epi>
__device__ __forceinline__ void gemm_phase(LAS unsigned char* lds, const Gemm g, const Sched& S, const Epi& E, const int tid) {
    const int wid = __builtin_amdgcn_readfirstlane(tid >> 6), lane = tid & 63, wr = wid >> 2, wc = wid & 3, fr = lane & 15, fq = lane >> 4;
    const int K = g.K, nt = K / BK, lda = g.lda;
    unsigned voffA[2], voffB[2];
#pragma unroll
    for (int i = 0; i < 2; ++i) { int R, C; stage_rc(tid * 16 + i * 8192, R, C); const int Rb = Epi::PERM ? ((R & ~31) + perm32(R & 31)) : R;
        voffA[i] = (unsigned)(R * lda + C) * 2u; voffB[i] = (unsigned)(Rb * K + C) * 2u; }
    const size_t kstep = (size_t)(BK * 2);
    const size_t hstepA = (size_t)HALF * lda * 2, hstepB = (size_t)HALF * K * 2;
    const size_t tstepA = 2 * hstepA, tstepB = 2 * hstepB;
    const unsigned ldsw = (unsigned)wid * 1024u;
    const int aoff = lds_byte(wr * 64 + fr, fq * 8), boff = lds_byte(wc * 32 + fr, fq * 8);
#define PG8_UA(u) ((const char*)((u).br == 0 ? g.A0 : ((u).br == 1 ? g.A1 : g.A2)) + (size_t)(u).pm * tstepA + (size_t)((u).pn * g.apn))
#define PG8_UB(u) ((const char*)((u).br == 0 ? g.B0 : ((u).br == 1 ? g.B1 : g.B2)) + (size_t)(u).pn * tstepB)
#define PG8_SA(b, h) (((b) * 2 + (h)) * HTB)
#define PG8_SB(b, h) ((4 + (b) * 2 + (h)) * HTB)
#define PG8_STAGE(bufoff, gbase, voff) do { _Pragma("unroll") for (int _i = 0; _i < 2; ++_i) \
        __builtin_amdgcn_global_load_lds((const unsigned*)((const char*)(gbase) + (voff)[_i]), (LAS unsigned*)(lds + (bufoff) + ldsw + _i * 8192), 16, 0, 0); } while (0)
#define PG8_LDA(dst, b, h) do { _Pragma("unroll") for (int m = 0; m < 4; ++m) _Pragma("unroll") for (int k = 0; k < 2; ++k) dst[m][k] = *(const LAS bf16x8*)(lds + PG8_SA(b, h) + aoff + m * 2048 + k * 1024); } while (0)
#define PG8_LDB(dst, b, h) do { _Pragma("unroll") for (int n = 0; n < 2; ++n) _Pragma("unroll") for (int k = 0; k < 2; ++k) dst[n][k] = *(const LAS bf16x8*)(lds + PG8_SB(b, h) + boff + n * 2048 + k * 1024); } while (0)
#define PG8_MMA(ai, bj, At, Bt) do { __builtin_amdgcn_s_setprio(1); _Pragma("unroll") for (int m = 0; m < 4; ++m) _Pragma("unroll") for (int n = 0; n < 2; ++n) _Pragma("unroll") for (int k = 0; k < 2; ++k) \
        acc[ai][bj][m][n] = __builtin_amdgcn_mfma_f32_16x16x32_bf16(Bt[n][k], At[m][k], acc[ai][bj][m][n], 0, 0, 0); __builtin_amdgcn_s_setprio(0); } while (0)
#define PG8_WAIT_V(n) asm volatile("s_waitcnt vmcnt(" #n ")" ::: "memory")
#define PG8_WAIT_L(n) asm volatile("s_waitcnt lgkmcnt(" #n ")" ::: "memory")
#define PG8_BAR __builtin_amdgcn_s_barrier()
#define PG8_SCHED __builtin_amdgcn_sched_barrier(0)
    Unit cur, nxt; int ui = 0;
    if (!S.next(0, cur)) return;
    f32x4 acc[2][2][4][2];
#pragma unroll
    for (int a = 0; a < 2; ++a)
#pragma unroll
        for (int b = 0; b < 2; ++b)
#pragma unroll
            for (int m = 0; m < 4; ++m)
#pragma unroll
                for (int n = 0; n < 2; ++n) acc[a][b][m][n] = (f32x4){0.f, 0.f, 0.f, 0.f};
    bf16x8 At[4][2], B0[2][2], B1[2][2];
    const char* cA = PG8_UA(cur); const char* cB = PG8_UB(cur);
    PG8_STAGE(PG8_SB(0, 0), cB, voffB); PG8_STAGE(PG8_SB(0, 1), cB + hstepB, voffB); PG8_STAGE(PG8_SA(0, 0), cA, voffA); PG8_STAGE(PG8_SA(0, 1), cA + hstepA, voffA);
    if (wr == 1) PG8_BAR;
    PG8_WAIT_V(2); PG8_BAR;
    PG8_STAGE(PG8_SB(1, 0), cB + kstep, voffB); PG8_STAGE(PG8_SA(1, 0), cA + kstep, voffA); PG8_STAGE(PG8_SB(1, 1), cB + hstepB + kstep, voffB);
    PG8_WAIT_V(6); PG8_BAR;
    for (;;) {
        const bool has_next = S.next(ui + 1, nxt);
        const char* nA = has_next ? PG8_UA(nxt) : cA; const char* nB = has_next ? PG8_UB(nxt) : cB;
#pragma unroll 1
        for (int t = 0; t < nt; t += 2) {
            const bool last = (t == nt - 2);
            const char* a1 = cA + (size_t)(t + 1) * kstep;
            const char* a2 = last ? nA : cA + (size_t)(t + 2) * kstep; const char* b2 = last ? nB : cB + (size_t)(t + 2) * kstep;
            const char* a3 = a2 + kstep; const char* b3 = b2 + kstep;
            PG8_LDB(B0, 0, 0); PG8_LDB(B1, 0, 1); PG8_SCHED; PG8_LDA(At, 0, 0); PG8_STAGE(PG8_SA(1, 1), a1 + hstepA, voffA);
            PG8_WAIT_V(8); PG8_WAIT_L(0); PG8_BAR; PG8_MMA(0, 0, At, B0); PG8_MMA(0, 1, At, B1); PG8_BAR; PG8_SCHED;
            PG8_LDA(At, 0, 1); PG8_STAGE(PG8_SB(0, 0), b2, voffB); PG8_STAGE(PG8_SB(0, 1), b2 + hstepB, voffB); PG8_STAGE(PG8_SA(0, 0), a2, voffA);
            PG8_WAIT_V(8); PG8_WAIT_L(0); PG8_BAR; PG8_MMA(1, 0, At, B0); PG8_MMA(1, 1, At, B1); PG8_BAR; PG8_SCHED;
            PG8_LDB(B0, 1, 0); PG8_LDB(B1, 1, 1); PG8_SCHED; PG8_LDA(At, 1, 0); PG8_STAGE(PG8_SA(0, 1), a2 + hstepA, voffA);
            PG8_WAIT_V(8); PG8_WAIT_L(0); PG8_BAR; PG8_MMA(0, 0, At, B0); PG8_MMA(0, 1, At, B1); PG8_BAR; PG8_SCHED;
            PG8_LDA(At, 1, 1); PG8_STAGE(PG8_SB(1, 0), b3, voffB); PG8_STAGE(PG8_SB(1, 1), b3 + hstepB, voffB); PG8_STAGE(PG8_SA(1, 0), a3, voffA);
            PG8_WAIT_V(8); PG8_WAIT_L(0); PG8_BAR; PG8_MMA(1, 0, At, B0); PG8_MMA(1, 1, At, B1); PG8_BAR; PG8_SCHED;
        }
        if (wr == 0) PG8_BAR;
        const bool keep = E(acc, cur, wr, wc, fr, fq);
        if (!has_next) break;
        if (!keep) {
#pragma unroll
            for (int a = 0; a < 2; ++a)
#pragma unroll
                for (int b = 0; b < 2; ++b)
#pragma unroll
                    for (int m = 0; m < 4; ++m)
#pragma unroll
                        for (int n = 0; n < 2; ++n) acc[a][b][m][n] = (f32x4){0.f, 0.f, 0.f, 0.f};
        }
        cur = nxt; cA = nA; cB = nB; ++ui;
        if (wr == 1) PG8_BAR;
    }
    PG8_WAIT_V(0);
    PG8_BAR;
#undef PG8_UA
#undef PG8_UB
#undef PG8_SA
#undef PG8_SB
#undef PG8_STAGE
#undef PG8_LDA
#undef PG8_LDB
#undef PG8_MMA
#undef PG8_WAIT_V
#undef PG8_WAIT_L
#undef PG8_BAR
#undef PG8_SCHED
}
}

namespace att {
constexpr int NW = 8, QBLK = 32, KVBLK = 64;
constexpr float SCALE = 0.088388347648318440f;
constexpr float THR = 8.f;
constexpr size_t SHM_V = KVBLK * 128 * 2, SHM_K = KVBLK * 128 * 2, SHM_ATTN = 2 * SHM_V + 2 * SHM_K + NW * 64 * 4;
#define KSWZ(row, colB) ((row) * 256 + ((colB) ^ (((row) & 7) << 4)))
#define SBAR() __builtin_amdgcn_sched_barrier(0)
__device__ __forceinline__ int crow(int r, int hi) { return (r & 3) + 8 * (r >> 2) + 4 * hi; }
__device__ __forceinline__ unsigned cvtpk(float lo, float hi) { unsigned r; asm volatile("v_cvt_pk_bf16_f32 %0, %1, %2" : "=v"(r) : "v"(lo), "v"(hi)); return r; }
__device__ __forceinline__ void partialSM(f32x16& p0, f32x16& p1, float& m_reg, float& mn, float& alpha) {
  constexpr float C = SCALE * 1.4426950408889634f;
  float pmax = p0[0];
#pragma unroll
  for (int r = 1; r < 16; ++r) pmax = fmaxf(pmax, p0[r]);
#pragma unroll
  for (int r = 0; r < 16; ++r) pmax = fmaxf(pmax, p1[r]);
  { auto rr = __builtin_amdgcn_permlane32_swap(__float_as_uint(pmax), __float_as_uint(pmax), false, false);
    pmax = fmaxf(__uint_as_float(rr[0]), __uint_as_float(rr[1])); }
  if (__builtin_expect(__all(pmax - m_reg <= THR / SCALE), 1)) { mn = m_reg; alpha = 1.f; }
  else { mn = fmaxf(m_reg, pmax); alpha = __builtin_amdgcn_exp2f((m_reg - mn) * C); m_reg = mn; }
  float mnC = -mn * C;
#pragma unroll
  for (int r = 0; r < 16; ++r) p0[r] = fmaf(p0[r], C, mnC);
#pragma unroll
  for (int r = 0; r < 16; ++r) p1[r] = fmaf(p1[r], C, mnC);
#pragma unroll
  for (int r = 0; r < 16; ++r) p0[r] = __builtin_amdgcn_exp2f(p0[r]);
}
__device__ __forceinline__ void finishSM(f32x16& p0, f32x16& p1, float alpha, float& l_reg, bf16x8& pa0, bf16x8& pa1, bf16x8& pa2, bf16x8& pa3) {
#pragma unroll
  for (int r = 0; r < 16; ++r) p1[r] = __builtin_amdgcn_exp2f(p1[r]);
  float ps = 0;
#pragma unroll
  for (int r = 0; r < 16; ++r) ps += p0[r];
#pragma unroll
  for (int r = 0; r < 16; ++r) ps += p1[r];
  { auto rr = __builtin_amdgcn_permlane32_swap(__float_as_uint(ps), __float_as_uint(ps), false, false);
    ps = __uint_as_float(rr[0]) + __uint_as_float(rr[1]); }
  l_reg = l_reg * alpha + ps;
#define PK4(P, BASE, OUT) do { unsigned a0 = cvtpk(P[BASE + 0], P[BASE + 1]), a1 = cvtpk(P[BASE + 2], P[BASE + 3]);   \
    unsigned b0 = cvtpk(P[BASE + 4], P[BASE + 5]), b1 = cvtpk(P[BASE + 6], P[BASE + 7]);                              \
    auto r0 = __builtin_amdgcn_permlane32_swap(a0, b0, false, false); auto r1 = __builtin_amdgcn_permlane32_swap(a1, b1, false, false); \
    u32x4 w = {r0[0], r1[0], r0[1], r1[1]}; OUT = *reinterpret_cast<bf16x8*>(&w); } while (0)
  PK4(p0, 0, pa0); PK4(p0, 8, pa1); PK4(p1, 0, pa2); PK4(p1, 8, pa3);
#undef PK4
}
__device__ __forceinline__ void qkt(f32x16& p0, f32x16& p1, const bf16_t* Ks, const bf16x8* qr, int r32, int hi) {
  p0 = f32x16{}; p1 = f32x16{};
#pragma unroll
  for (int d0 = 0; d0 < 8; ++d0) { int cb = (d0 * 16 + hi * 8) * 2;
    bf16x8 b0 = *reinterpret_cast<const bf16x8*>((const char*)Ks + KSWZ(r32, cb));
    bf16x8 b1 = *reinterpret_cast<const bf16x8*>((const char*)Ks + KSWZ(32 + r32, cb));
    p0 = __builtin_amdgcn_mfma_f32_32x32x16_bf16(b0, qr[d0], p0, 0, 0, 0);
    p1 = __builtin_amdgcn_mfma_f32_32x32x16_bf16(b1, qr[d0], p1, 0, 0, 0); }
}
__device__ __forceinline__ int v_st(int k, int c) { const int kk = (k & ~0xC) | ((k & 4) << 1) | ((k & 8) >> 1); return ((kk >> 3) * 4 + (c >> 5)) * 512 + ((kk & 7) * 32 + (c & 31)) * 2; }
__device__ __forceinline__ int v_rd_base(int lane) { return ((lane & 3) << 3) | (((lane >> 2) & 3) << 6) | (((lane >> 4) & 1) << 5) | (((lane >> 5) & 1) << 8); }
constexpr int v_rd_off(int d0, int ks, int half) { return d0 * 512 + ks * 4096 + half * 2048; }
template <int OFF> __device__ __forceinline__ s16x4 tr_read(int vb) {
  s16x4 r; asm volatile("ds_read_b64_tr_b16 %0, %1 offset:%2" : "=&v"(r) : "v"(vb), "i"(OFF) : "memory"); return r;
}
template <int D0> __device__ __forceinline__ void pv_one(f32x16& od, int vb, bf16x8 pa0, bf16x8 pa1, bf16x8 pa2, bf16x8 pa3) {
  const s16x4 l0 = tr_read<v_rd_off(D0, 0, 0)>(vb), h0 = tr_read<v_rd_off(D0, 0, 1)>(vb), l1 = tr_read<v_rd_off(D0, 1, 0)>(vb), h1 = tr_read<v_rd_off(D0, 1, 1)>(vb);
  const s16x4 l2 = tr_read<v_rd_off(D0, 2, 0)>(vb), h2 = tr_read<v_rd_off(D0, 2, 1)>(vb), l3 = tr_read<v_rd_off(D0, 3, 0)>(vb), h3 = tr_read<v_rd_off(D0, 3, 1)>(vb);
  asm volatile("s_waitcnt lgkmcnt(0)" ::: "memory"); SBAR();
#define PK(L, H) (bf16x8){L[0], L[1], L[2], L[3], H[0], H[1], H[2], H[3]}
  od = __builtin_amdgcn_mfma_f32_32x32x16_bf16(pa0, PK(l0, h0), od, 0, 0, 0);
  od = __builtin_amdgcn_mfma_f32_32x32x16_bf16(pa1, PK(l1, h1), od, 0, 0, 0);
  od = __builtin_amdgcn_mfma_f32_32x32x16_bf16(pa2, PK(l2, h2), od, 0, 0, 0);
  od = __builtin_amdgcn_mfma_f32_32x32x16_bf16(pa3, PK(l3, h3), od, 0, 0, 0);
#undef PK
}
__device__ __forceinline__ void pv_d0(f32x16* o, int vb, bf16x8 pa0, bf16x8 pa1, bf16x8 pa2, bf16x8 pa3) {
  pv_one<0>(o[0], vb, pa0, pa1, pa2, pa3); pv_one<1>(o[1], vb, pa0, pa1, pa2, pa3); pv_one<2>(o[2], vb, pa0, pa1, pa2, pa3); pv_one<3>(o[3], vb, pa0, pa1, pa2, pa3);
}
__device__ __forceinline__ void attn_dense_body(const bf16_t* Qb, const bf16_t* __restrict__ KL, const bf16_t* __restrict__ KC,
                                                int ntl, bf16_t* Ob, int NT, char* lds, const int tid, const bool dost = true) {
  constexpr int LDQ = NP, LDK = NP, LDO = NP;
  const int wid = tid >> 6, lane = tid & 63, r32 = lane & 31, hi = lane >> 5;
  bf16_t* V_lds = (bf16_t*)lds; bf16_t* K_lds = (bf16_t*)(lds + 2 * SHM_V);
  float* ws = (float*)(lds + 2 * SHM_V + 2 * SHM_K) + wid * 64; float* li_l = ws; float* al_l = ws + 32;
  float m_reg = -1e30f, l_reg = 0; f32x16 o[4] = {}; bf16x8 qr[8];
  const bf16_t* Qw = Qb + (long)(wid * QBLK + r32) * LDQ + hi * 8;
#pragma unroll
  for (int d0 = 0; d0 < 8; ++d0) qr[d0] = *reinterpret_cast<const bf16x8*>(Qw + d0 * 16);
  const int sr = tid >> 4, sc = (tid & 15) * 8, vst0 = v_st(sr, sc), vst1 = v_st(32 + sr, sc);
  const int vb0 = (int)(uintptr_t)V_lds + v_rd_base(lane);
  struct { bf16x8 vs0, vs1, ks0, ks1; } sr_[1];
  const int loff0 = sr * LDK + sc, loff1 = (32 + sr) * LDK + sc;
  const bf16_t* knext = (ntl > 0) ? KL : KC; int tl_ = 0;
#define SLOAD(i, t) do { const bf16_t* kt_ = knext; ++tl_; knext = (tl_ == ntl) ? KC : knext + (long)KVBLK * LDK; \
    sr_[i].vs0 = *reinterpret_cast<const bf16x8*>(kt_ + loff0 + (C_AV - C_AK)); sr_[i].vs1 = *reinterpret_cast<const bf16x8*>(kt_ + loff1 + (C_AV - C_AK)); \
    sr_[i].ks0 = *reinterpret_cast<const bf16x8*>(kt_ + loff0); sr_[i].ks1 = *reinterpret_cast<const bf16x8*>(kt_ + loff1); } while (0)
#define SWRITE(b, i) do { *(bf16x8*)((char*)V_lds + (b) * SHM_V + vst0) = sr_[i].vs0;          \
    *(bf16x8*)((char*)V_lds + (b) * SHM_V + vst1) = sr_[i].vs1; int kc = sc * 2;               \
    *(bf16x8*)((char*)K_lds + (b) * SHM_K + KSWZ(sr, kc)) = sr_[i].ks0;                       \
    *(bf16x8*)((char*)K_lds + (b) * SHM_K + KSWZ(32 + sr, kc)) = sr_[i].ks1; } while (0)
#define SWAIT() asm volatile("s_waitcnt vmcnt(0)" ::: "memory")
#define RESC(a) do { if (__any((a) < 1.f)) { if (hi == 0) al_l[r32] = (a); asm volatile("s_waitcnt lgkmcnt(0)" ::: "memory"); \
    _Pragma("unroll") for (int d = 0; d < 4; ++d) _Pragma("unroll") for (int r = 0; r < 16; ++r) o[d][r] *= al_l[crow(r, hi)]; } } while (0)
  f32x16 pA0, pA1, pB0, pB1; float mnA, mnB, alA, alB; bf16x8 pa0, pa1, pa2, pa3;
  constexpr int SE = 0, SO = 0;
  SLOAD(SE, 0); asm volatile("s_waitcnt vmcnt(0)" ::: "memory"); SWRITE(0, SE); __syncthreads();
  qkt(pA0, pA1, K_lds, qr, r32, hi); partialSM(pA0, pA1, m_reg, mnA, alA);
  SLOAD(SO, 1);
  SWAIT(); SWRITE(1, SO); __syncthreads();
  for (int j = 1; j + 1 < NT; j += 2) {
    SBAR(); qkt(pB0, pB1, (bf16_t*)((char*)K_lds + SHM_K), qr, r32, hi);
    finishSM(pA0, pA1, alA, l_reg, pa0, pa1, pa2, pa3); SBAR();
    SLOAD(SO, j + 1); SBAR();
    pv_d0(o, vb0, pa0, pa1, pa2, pa3); partialSM(pB0, pB1, m_reg, mnB, alB);
    __syncthreads(); SWAIT(); SWRITE(0, SE);
    RESC(alB); __syncthreads();
    SBAR(); qkt(pA0, pA1, K_lds, qr, r32, hi);
    finishSM(pB0, pB1, alB, l_reg, pa0, pa1, pa2, pa3); SBAR();
    SLOAD(SE, j + 2); SBAR();
    pv_d0(o, vb0 + (int)SHM_V, pa0, pa1, pa2, pa3); partialSM(pA0, pA1, m_reg, mnA, alA);
    __syncthreads(); SWAIT(); SWRITE(1, SO);
    RESC(alA); __syncthreads();
  }
  SBAR(); qkt(pB0, pB1, (bf16_t*)((char*)K_lds + SHM_K), qr, r32, hi);
  finishSM(pA0, pA1, alA, l_reg, pa0, pa1, pa2, pa3); SBAR();
  pv_d0(o, vb0, pa0, pa1, pa2, pa3); partialSM(pB0, pB1, m_reg, mnB, alB);
  __syncthreads(); RESC(alB);
  finishSM(pB0, pB1, alB, l_reg, pa0, pa1, pa2, pa3); SBAR();
  pv_d0(o, vb0 + (int)SHM_V, pa0, pa1, pa2, pa3);
  if (hi == 0) li_l[r32] = l_reg; asm volatile("s_waitcnt lgkmcnt(0)" ::: "memory");
  float rli[16];
#pragma unroll
  for (int r = 0; r < 16; ++r) rli[r] = __builtin_amdgcn_rcpf(li_l[crow(r, hi)]);
  bf16_t* Ow = Ob + (long)(wid * QBLK) * LDO;
#pragma unroll
  for (int r = 0; r < 16; ++r) { int orow = crow(r, hi);
#pragma unroll
    for (int d0 = 0; d0 < 4; ++d0) if (dost) Ow[(long)orow * LDO + d0 * 32 + r32] = (bf16_t)f2bf(o[d0][r] * rli[r]); }
  __syncthreads();
#undef SLOAD
#undef SWRITE
#undef SWAIT
#undef RESC
}
#undef KSWZ
#undef SBAR
}


#define XB_TMO      128
#define XB_XCNT(j)  (256  + 64 * (j))
#define XB_XSUB(j)  (1280 + 64 * (j))
#define XB_XGEN(j)  (2304 + 64 * (j))
#define XB_TOP      3328
#define XB_TOPGEN   3392
#define XCD_BAR_WORDS 3456
#define XB_SPIN_CAP (1u << 18)
__device__ __forceinline__ unsigned xb_ld(unsigned* p)              { return __hip_atomic_load(p, __ATOMIC_RELAXED, __HIP_MEMORY_SCOPE_AGENT); }
__device__ __forceinline__ unsigned xb_add(unsigned* p, unsigned v) { return __hip_atomic_fetch_add(p, v, __ATOMIC_RELAXED, __HIP_MEMORY_SCOPE_AGENT); }
__device__ __forceinline__ unsigned xb_xcc_id() { return (unsigned)__builtin_amdgcn_s_getreg((3 << 11) | 20) & 0xFu; }
#define XB_SPIN(cond, bar) do { unsigned _sp = 0; while (cond) { __builtin_amdgcn_s_sleep(1); \
    if ((++_sp & 255u) == 0u) { if (xb_ld(&(bar)[XB_TMO])) break; if (_sp > XB_SPIN_CAP) { atomicAdd(&(bar)[XB_TMO], 1u); break; } } } } while (0)
struct XcdBarrier { unsigned* bar; unsigned x; volatile LAS unsigned* st; };
__device__ __forceinline__ XcdBarrier xcd_barrier_post(unsigned* bar, volatile LAS unsigned* st) {
    XcdBarrier b; b.bar = bar; b.x = xb_xcc_id(); b.st = st;
    if (threadIdx.x == 0) (void)xb_add(&bar[XB_XCNT(b.x)], 1u);
    return b;
}
__device__ __forceinline__ void xcd_barrier_complete(unsigned* bar, unsigned x, unsigned& nloc, unsigned& nx) {
    const unsigned G = gridDim.x * gridDim.y * gridDim.z;
    unsigned sum, cnt, mine, sp = 0u;
    for (;;) {
        sum = 0u; cnt = 0u; mine = 0u;
#pragma unroll
        for (unsigned j = 0; j < 16; ++j) { const unsigned c = xb_ld(&bar[XB_XCNT(j)]); sum += c; cnt += (c > 0u) ? 1u : 0u; mine = (j == x) ? c : mine; }
        if (sum == G) break;
        __builtin_amdgcn_s_sleep(1);
        if ((++sp & 255u) == 0u) { if (xb_ld(&bar[XB_TMO])) break; if (sp > XB_SPIN_CAP) { atomicAdd(&bar[XB_TMO], 1u); break; } }
    }
    nloc = mine > 0u ? mine : 1u; nx = cnt > 0u ? cnt : 1u;
}
__device__ __forceinline__ void xcd_barrier(const XcdBarrier& b) {
    asm volatile("s_waitcnt vmcnt(0)" ::: "memory");
    __syncthreads();
    if (threadIdx.x == 0) {
        unsigned* bar = b.bar;
        __builtin_amdgcn_s_waitcnt(0);
        unsigned nloc = b.st[0], nx = b.st[1];
        if (nloc == 0u) { xcd_barrier_complete(bar, b.x, nloc, nx); b.st[0] = nloc; b.st[1] = nx; }
        const unsigned old = xb_add(&bar[XB_XSUB(b.x)], 1u);
        const unsigned gen = old / nloc;
        if (old + 1u == (gen + 1u) * nloc) {
            __builtin_amdgcn_fence(__ATOMIC_RELEASE, "agent");
            asm volatile("s_waitcnt vmcnt(0)" ::: "memory");
            const unsigned og = xb_add(&bar[XB_TOP], 1u);
            const unsigned tg = og / nx;
            if (og + 1u == (tg + 1u) * nx) xb_add(&bar[XB_TOPGEN], 1u);
            else XB_SPIN(xb_ld(&bar[XB_TOPGEN]) == tg, bar);
            __builtin_amdgcn_fence(__ATOMIC_ACQUIRE, "agent");
            xb_add(&bar[XB_XGEN(b.x)], 1u);
            asm volatile("s_waitcnt vmcnt(0)" ::: "memory");
        } else {
            XB_SPIN(xb_ld(&bar[XB_XGEN(b.x)]) == gen, bar);
            __builtin_amdgcn_fence(__ATOMIC_ACQUIRE, "agent");
            asm volatile("s_waitcnt vmcnt(0)" ::: "memory");
        }
    }
    __syncthreads();
}

typedef const __attribute__((address_space(4))) Args* ArgsP;
struct Fr {
    char* lds; LAS unsigned char* lds3; int tid, lane, wave, G, vcu, gw, NGW, bx;
    ArgsP ap;
};
#define WSB (F.ap->ws)
#define F_P ((bf16_t*)(WSB + WS_P))
#define F_H ((bf16_t*)(WSB + WS_H))
#define F_MIX ((bf16_t*)(WSB + WS_MIX))
#define F_CST ((bf16_t*)(WSB + WS_CST))
#define F_MOD ((float*)(WSB + WS_MOD))
#define F_LI ((float*)(WSB + WS_LI))
#define F_LF ((float*)(WSB + WS_LF))
#define F_GT ((float*)(WSB + WS_GT))
#define F_MLOC ((float*)(WSB + WS_GT) + 2048)
#define F_MIN ((float*)(WSB + WS_GT) + 4096)
#define F_NST ((float*)(WSB + WS_NST))
#define F_XC ((float*)(WSB + WS_XC))


__device__ __forceinline__ void tr_item(const float* W, int N, int k0, int n0, bf16_t* WT, int ldt, int drow0, const float* rscale, float* scr, int lane, int split = 1 << 30, int shift = 0) {
    const int cq = lane & 15, rq = lane >> 4, dn = n0 + 4 * cq, nn = dn < split ? dn : dn - shift; const bool ok = (nn < N) && (dn < split || dn >= split + shift);
    f32x4 v[16];
#pragma unroll
    for (int i = 0; i < 16; ++i) v[i] = ok ? __builtin_nontemporal_load((const f32x4*)(W + (size_t)(k0 + 4 * i + rq) * N + nn)) : (f32x4){0.f, 0.f, 0.f, 0.f};
#pragma unroll
    for (int i = 0; i < 16; ++i) { float* d = scr + (4 * i + rq) * 65 + 4 * cq; d[0] = v[i][0]; d[1] = v[i][1]; d[2] = v[i][2]; d[3] = v[i][3]; }
    asm volatile("s_waitcnt lgkmcnt(0)" ::: "memory");
    const int c = lane & 7;
#pragma unroll
    for (int j = 0; j < 8; ++j) { const int n = (lane >> 3) + 8 * j; const float* sp = scr + (8 * c) * 65 + n;
        const float sc = rscale ? rscale[n0 + n] : 1.f;
        u32x4 o; o.x = pk2(sp[0 * 65] * sc, sp[1 * 65] * sc); o.y = pk2(sp[2 * 65] * sc, sp[3 * 65] * sc); o.z = pk2(sp[4 * 65] * sc, sp[5 * 65] * sc); o.w = pk2(sp[6 * 65] * sc, sp[7 * 65] * sc);
        *(u32x4*)(WT + (size_t)(drow0 + n) * ldt + k0 + 8 * c) = o; }
    asm volatile("s_waitcnt lgkmcnt(0)" ::: "memory");
}
__device__ __forceinline__ void convert_weights(Fr& F, int l) {
    float* scr = (float*)(F.lds + F.wave * 16640);
    constexpr int I_IN = 32 * 188, I_FI = 32 * 176, I_FO = 88 * 32, I_UP = 16 * 32, I_OUT = 32 * 32, I_PL = 64;
    constexpr int NIT = I_IN + I_FI + I_FO + 3 * I_UP + I_OUT + I_PL;
    for (int it = F.gw; it < NIT; it += F.NGW) {
        int r = it;
        if (r < I_IN) { const int kb = r / 188, nb = r % 188; tr_item(F.ap->in[I_WIN] + (size_t)l * D * DIN, DIN, kb * 64, nb * 64, (bf16_t*)(WSB + WS_WIN), D, nb * 64, nullptr, scr, F.lane, C_GRAW, NP - C_GRAW); continue; } r -= I_IN;
        if (r < I_FI) { const int kb = r / 176, nb = r % 176, n0 = nb * 64, bj = n0 / DFF, jj0 = n0 % DFF;
            tr_item(F.ap->in[I_FFI] + (size_t)l * D * 2 * DFF, 2 * DFF, kb * 64, n0, (bf16_t*)(WSB + WS_WFI), D, (jj0 / 128) * 256 + bj * 128 + (jj0 % 128), nullptr, scr, F.lane); continue; } r -= I_FI;
        if (r < I_FO) { const int kb = r / 32, nb = r % 32; tr_item(F.ap->in[I_FFO] + (size_t)l * DFF * D, D, kb * 64, nb * 64, (bf16_t*)(WSB + WS_WFO), DFF, nb * 64, nullptr, scr, F.lane); continue; } r -= I_FO;
#define UPCASE(BR, IDX) if (r < I_UP) { const int kb = r / 32, nb = r % 32; \
            tr_item(F.ap->in[IDX] + (size_t)l * 1024 * D, D, kb * 64, nb * 64, (bf16_t*)(WSB + WS_WUP) + (size_t)(BR) * D * 1024, 1024, nb * 64, nullptr, scr, F.lane); continue; } r -= I_UP;
        UPCASE(0, I_UPA) UPCASE(1, I_UPM) UPCASE(2, I_UPP)
#undef UPCASE
        if (r < I_OUT) { const int kb = r / 32, nb = r % 32; tr_item(F.ap->in[I_WOUT] + (size_t)l * D * D, D, kb * 64, nb * 64, (bf16_t*)(WSB + WS_WOUT), D, nb * 64, nullptr, scr, F.lane); continue; } r -= I_OUT;
        { const int g = r / 16, q = r % 16, kb = q / 4, nb = q % 4;
          tr_item(F.ap->in[I_POOLW] + ((size_t)l * 4 + g) * 65536, 256, kb * 64, nb * 64, (bf16_t*)(WSB + WS_WPL) + (size_t)g * 65536, 256, nb * 64, F.ap->in[I_POOLS] + l * 1024 + g * 256, scr, F.lane); }
    }
}

__device__ __forceinline__ void mod_gemv(Fr& F) {
    float* sc = (float*)F.lds;
    float* red = (float*)(F.lds + 5 * 2048 * 4);
    for (int i = F.tid; i < 5 * 2048; i += 512) { const int m = i >> 11, k = i & 2047; const float v = m < 4 ? F.ap->in[I_C][m * 2048 + k] : F.ap->in[I_CCTX][k]; sc[i] = v / (1.f + __expf(-v)); }
    __syncthreads();
    const int kpar = F.lane >> 5, cl = F.lane & 31;
    for (int it = F.bx; it < 768; it += F.G) {
        const int l = it / 384, col = (it % 384) * 32 + cl;
        const float* w = F.ap->in[I_WMOD] + (size_t)l * D * 12288 + col;
        float a0 = 0, a1 = 0, a2 = 0, a3 = 0, a4 = 0;
        const int kbase = F.wave * 256 + kpar;
#pragma unroll 32
        for (int kk = 0; kk < 128; ++kk) { const int k = kbase + 2 * kk; const float wv = __builtin_nontemporal_load(w + (size_t)k * 12288);
            a0 += sc[k] * wv; a1 += sc[2048 + k] * wv; a2 += sc[4096 + k] * wv; a3 += sc[6144 + k] * wv; a4 += sc[8192 + k] * wv; }
        a0 += __shfl_xor(a0, 32); a1 += __shfl_xor(a1, 32); a2 += __shfl_xor(a2, 32); a3 += __shfl_xor(a3, 32); a4 += __shfl_xor(a4, 32);
        if (kpar == 0) { float* rp = red + F.wave * 160 + cl; rp[0] = a0; rp[32] = a1; rp[64] = a2; rp[96] = a3; rp[128] = a4; }
        __syncthreads();
        if (F.tid < 160) { float s = 0;
#pragma unroll
            for (int w8 = 0; w8 < 8; ++w8) s += red[w8 * 160 + F.tid];
            const int m = F.tid >> 5, c = (it % 384) * 32 + (F.tid & 31);
            F_MOD[((size_t)l * 5 + m) * 12288 + c] = s + F.ap->in[I_BMOD][l * 12288 + c]; }
        __syncthreads();
    }
}

__device__ __forceinline__ void ld_row(const float* p, int lane, f32x4 (&v)[8]) {
#pragma unroll
    for (int j = 0; j < 8; ++j) v[j] = __builtin_nontemporal_load((const f32x4*)p + lane + 64 * j);
}
__device__ __forceinline__ float row_rinv(const f32x4 (&v)[8]) {
    float s = 0.f;
#pragma unroll
    for (int j = 0; j < 8; ++j) s += (v[j].x * v[j].x + v[j].y * v[j].y) + (v[j].z * v[j].z + v[j].w * v[j].w);
    return 1.f / sqrtf(wave_sum(s) * (1.f / D) + EPS);
}
__device__ __forceinline__ void norm_mod_store(const f32x4 (&x)[8], const float* g, const float* sh, const float* sc, bf16_t* orow, int lane) {
    const float rinv = row_rinv(x);
#pragma unroll
    for (int j = 0; j < 8; ++j) { const int i = lane + 64 * j; const f32x4 gg = ((const f32x4*)g)[i], s1 = ((const f32x4*)sc)[i], s0 = ((const f32x4*)sh)[i];
        const f32x4 h = (x[j] * rinv * gg) * (1.f + s1) + s0;
        u32x2 w; w.x = pk2(h.x, h.y); w.y = pk2(h.z, h.w); ((u32x2*)orow)[i] = w; }
}
__device__ __forceinline__ int mod_row(int r) { return r < ML ? (r >> 12) : 4; }
__device__ __forceinline__ void phase_norm1(Fr& F, int l, const float* xlat, const float* xctx) {
    const float* g = F.ap->in[I_NORMG] + (size_t)l * 4 * D;
    for (int r = F.gw; r < MT; r += F.NGW) {
        const float* src = r < ML ? xlat + (size_t)r * D : xctx + (size_t)(r - ML) * D;
        const float* mod = F_MOD + ((size_t)l * 5 + mod_row(r)) * 12288;
        f32x4 x[8]; ld_row(src, F.lane, x);
        norm_mod_store(x, g, mod, mod + D, F_H + (size_t)r * D, F.lane);
    }
}
__device__ __forceinline__ void phase_resid(Fr& F, int l, int which, int nrows, const float* xlat_src, const float* xctx_src, bool nextnorm, const bool srcbf, const bool dstbf, const bool dost = true) {
    const float* ng = F.ap->in[I_NORMG] + (size_t)l * 4 * D;
    const bf16_t* Y = (const bf16_t*)(WSB + WS_YO);
    for (int r = F.gw; r < nrows; r += F.NGW) {
        const float* src = r < ML ? xlat_src + (size_t)r * D : xctx_src + (size_t)(r - ML) * D;
        float* dst = r < ML ? F.ap->out + (size_t)r * D : F_XC + (size_t)(r - ML) * D;
        const float* mod = F_MOD + ((size_t)l * 5 + mod_row(r)) * 12288;
        const float* gate = mod + (which == 0 ? 2 : 5) * D; const float* gy = ng + (which == 0 ? 1 : 3) * D;
        f32x4 y[8], x[8];
#pragma unroll
        for (int j = 0; j < 8; ++j) { const u32x2 w = __builtin_nontemporal_load((const u32x2*)(Y + (size_t)r * D) + F.lane + 64 * j);
            y[j] = (f32x4){__uint_as_float(w.x << 16), __uint_as_float(w.x & 0xffff0000u), __uint_as_float(w.y << 16), __uint_as_float(w.y & 0xffff0000u)}; }
        bf16_t* xb = (bf16_t*)(WSB + WS_XB) + (size_t)(r < ML ? r : 0) * D;
        if (r < ML && srcbf) {
#pragma unroll
            for (int j = 0; j < 8; ++j) { const u32x2 w = __builtin_nontemporal_load((const u32x2*)xb + F.lane + 64 * j);
                x[j] = (f32x4){__uint_as_float(w.x << 16), __uint_as_float(w.x & 0xffff0000u), __uint_as_float(w.y << 16), __uint_as_float(w.y & 0xffff0000u)}; }
        } else ld_row(src, F.lane, x);
        const float ry = row_rinv(y);
#pragma unroll
        for (int j = 0; j < 8; ++j) { const int i = F.lane + 64 * j; const f32x4 gt = ((const f32x4*)gate)[i], gg = ((const f32x4*)gy)[i];
            x[j] = x[j] + gt * (y[j] * ry * gg); }
        if (dost) {
            if (r < ML && dstbf) {
#pragma unroll
                for (int j = 0; j < 8; ++j) { u32x2 w; w.x = pk2(x[j].x, x[j].y); w.y = pk2(x[j].z, x[j].w); ((u32x2*)xb)[F.lane + 64 * j] = w; }
            } else {
#pragma unroll
                for (int j = 0; j < 8; ++j) ((f32x4*)dst)[F.lane + 64 * j] = x[j];
            } }
        if (which == 0) norm_mod_store(x, ng + 2 * D, mod + 3 * D, mod + 4 * D, F_H + (size_t)r * D, F.lane);
        else if (nextnorm) { const float* mod2 = F_MOD + ((size_t)(l + 1) * 5 + mod_row(r)) * 12288;
            norm_mod_store(x, F.ap->in[I_NORMG] + (size_t)(l + 1) * 4 * D, mod2, mod2 + D, F_H + (size_t)r * D, F.lane); }
    }
}

__device__ __forceinline__ void phase_prep(Fr& F, int l, const bool dost = true) {
    const float* qkg = F.ap->in[I_QKG] + l * 256;
    const float* gb = F.ap->in[I_GATEB] + l * 16;
    const int lane = F.lane, i32 = lane & 31, sub = lane >> 5;
    float gq[4], gk[4];
#pragma unroll
    for (int e = 0; e < 4; ++e) { gq[e] = qkg[32 * e + i32]; gk[e] = qkg[128 + 32 * e + i32]; }
    const float inv = __builtin_amdgcn_exp2f(-(float)i32 * (13.287712379549449f / 32.f));
    for (int rp = F.gw; rp < MT / 2; rp += F.NGW) {
        const int r = 2 * rp + sub;
        bf16_t* prow = F_P + (size_t)r * NP;
        const bool lat = r < ML;
        const int nh = (lat || l == 0) ? 10 : 2;
        float cs0 = 1.f, sn0 = 0.f, cs1 = 1.f, sn1 = 0.f;
        if (lat) { const int t = r & 4095;
            float rev0 = (float)(t >> 6) * inv * 0.15915494309189535f, rev1 = (float)(t & 63) * inv * 0.15915494309189535f;
            rev0 -= rintf(rev0); rev1 -= rintf(rev1);
            sn0 = __builtin_amdgcn_sinf(rev0); cs0 = __builtin_amdgcn_cosf(rev0); sn1 = __builtin_amdgcn_sinf(rev1); cs1 = __builtin_amdgcn_cosf(rev1); }
#define PREP_LOAD(h) { const int c0 = (h) < 2 ? C_AK + (h) * 128 : C_AQ + ((h) - 2) * 128; \
            _Pragma("unroll") for (int e = 0; e < 4; ++e) x[h][e] = bf2f(prow[c0 + 32 * e + i32]); }
#define PREP_HEAD(h) { const int c0 = (h) < 2 ? C_AK + (h) * 128 : C_AQ + ((h) - 2) * 128; \
            float ss = (x[h][0] * x[h][0] + x[h][1] * x[h][1]) + (x[h][2] * x[h][2] + x[h][3] * x[h][3]); \
            _Pragma("unroll") for (int o = 1; o < 32; o <<= 1) ss += __shfl_xor(ss, o); \
            const float rinv = __builtin_amdgcn_rsqf(ss * (1.f / 128.f) + EPS); \
            const float a0 = x[h][0] * rinv * ((h) < 2 ? gk[0] : gq[0]), b0 = x[h][1] * rinv * ((h) < 2 ? gk[1] : gq[1]); \
            const float a1 = x[h][2] * rinv * ((h) < 2 ? gk[2] : gq[2]), b1 = x[h][3] * rinv * ((h) < 2 ? gk[3] : gq[3]); \
            if (dost) { prow[c0 + i32] = (bf16_t)f2bf(a0 * cs0 - b0 * sn0); prow[c0 + 32 + i32] = (bf16_t)f2bf(b0 * cs0 + a0 * sn0); \
                        prow[c0 + 64 + i32] = (bf16_t)f2bf(a1 * cs1 - b1 * sn1); prow[c0 + 96 + i32] = (bf16_t)f2bf(b1 * cs1 + a1 * sn1); } }
        float x[10][4];
        if (nh == 10) {
#pragma unroll
            for (int h = 0; h < 10; ++h) PREP_LOAD(h)
#pragma unroll
            for (int h = 0; h < 10; ++h) PREP_HEAD(h)
        } else {
#pragma unroll
            for (int h = 0; h < 2; ++h) PREP_LOAD(h)
#pragma unroll
            for (int h = 0; h < 2; ++h) PREP_HEAD(h)
        }
#undef PREP_LOAD
#undef PREP_HEAD
        if (i32 < 16) { const int q = i32 & 7, d = q >> 2, hh = q & 3;
            const float raw = bf2f(prow[(i32 < 8 ? C_GI : C_GF) + q]);
            if (i32 < 8) F_LI[(size_t)r * 8 + q] = raw + gb[d * 8 + hh];
            else { const float xx = raw + gb[d * 8 + 4 + hh]; F_LF[(size_t)r * 8 + q] = fminf(xx, 0.f) - __logf(1.f + __expf(-fabsf(xx))); } }
    }
    const int nrows = (l == 0) ? MT : ML;
    const long total = (long)nrows * 128, nth = (long)F.G * 512;
    for (long it = (long)F.bx * 512 + F.tid; it < total; it += nth) {
        const int gi = (int)((it >> 6) & 3), c8 = (int)(it & 31) | (gi << 5), r = (int)((it >> 8) << 1) | (int)((it >> 5) & 1);
        const int T = r < ML ? SEQ : CTXL, t = r < ML ? (r & 4095) : ((r - ML) & 255);
        const bf16_t* base = F_P + (size_t)(r - t) * NP + C_PL + c8 * 8;
        float s[8] = {0, 0, 0, 0, 0, 0, 0, 0}; int cnt = 0, nwin = 0;
#define POOLW(HW) { bf16x8 v[2 * HW]; \
            _Pragma("unroll") for (int k = 0; k < 2 * HW; ++k) { const int u = t - HW + k; const bool ok = (u >= 0) && (u < T); const int uc = ok ? u : t; v[k] = *(const bf16x8*)(base + (size_t)uc * NP); cnt += ok ? 1 : 0; } \
            _Pragma("unroll") for (int k = 0; k < 2 * HW; ++k) { \
                _Pragma("unroll") for (int i = 0; i < 8; ++i) s[i] += bfs2f(v[k][i]); } nwin = 2 * HW; }
        if (gi == 0) POOLW(1) else if (gi == 1) POOLW(2) else if (gi == 2) POOLW(4) else POOLW(8)
#undef POOLW
        const bf16x8 self = *(const bf16x8*)(base + (size_t)t * NP); const float rc = __builtin_amdgcn_rcpf((float)cnt); const float ninv = (float)(nwin - cnt);
#pragma unroll
        for (int i = 0; i < 8; ++i) s[i] -= ninv * bfs2f(self[i]);
        u32x4 w; w.x = pk2(s[0] * rc - bfs2f(self[0]), s[1] * rc - bfs2f(self[1])); w.y = pk2(s[2] * rc - bfs2f(self[2]), s[3] * rc - bfs2f(self[3]));
        w.z = pk2(s[4] * rc - bfs2f(self[4]), s[5] * rc - bfs2f(self[5])); w.w = pk2(s[6] * rc - bfs2f(self[6]), s[7] * rc - bfs2f(self[7]));
        *(u32x4*)(F_MIX + (size_t)r * 1024 + c8 * 8) = w;
    }
}

__device__ __forceinline__ void chunk_bs(int cidx, int& b, int& slot) { if (cidx < 128) { b = cidx >> 5; slot = 2 + (cidx & 31); } else { b = (cidx - 128) >> 1; slot = (cidx - 128) & 1; } }
__device__ __forceinline__ int unit_idx(int b, int hh, int d, int slot) { return ((b * 4 + hh) * 2 + d) * NSLOT + slot; }
constexpr int VS = 136;
constexpr int LDS_VT = 0, LDS_KT = 256 * VS * 2, LDS_FS = LDS_KT + 128 * VS * 2, LDS_CH = LDS_FS + 5120;

__device__ __forceinline__ void stage_vt(Fr& F, bf16_t* VT, size_t R0, int hh) {
    for (int idx = F.tid; idx < 1024; idx += 512) { const int l4 = idx & 31, c8 = idx >> 5;
        const bf16_t* src = F_P + (R0 + 4 * l4) * NP + C_MV + hh * 256 + c8 * 8;
        const bf16x8 r0 = *(const bf16x8*)(src), r1 = *(const bf16x8*)(src + NP), r2 = *(const bf16x8*)(src + 2 * NP), r3 = *(const bf16x8*)(src + 3 * NP);
#pragma unroll
        for (int i = 0; i < 8; ++i) { u32x2 w; w.x = (unsigned)(unsigned short)r0[i] | ((unsigned)(unsigned short)r1[i] << 16); w.y = (unsigned)(unsigned short)r2[i] | ((unsigned)(unsigned short)r3[i] << 16);
            *(u32x2*)(VT + (c8 * 8 + i) * VS + 4 * l4) = w; } }
}
__device__ __forceinline__ void mls_cloc_unit(Fr& F, int cidx, int hh, int d, int l) {
    bf16_t* VT = (bf16_t*)(F.lds + LDS_VT); bf16_t* KT = (bf16_t*)(F.lds + LDS_KT); float* fs = (float*)(F.lds + LDS_FS);
    const int tid = F.tid, lane = F.lane, w = F.wave, fr = lane & 15, fq = lane >> 4;
    const size_t R0 = (size_t)cidx * 128; int b, slot; chunk_bs(cidx, b, slot); const int uidx = unit_idx(b, hh, d, slot);
    if (tid < 128) { const float* gb = F.ap->in[I_GATEB] + l * 16; const bf16_t* prow = F_P + (R0 + tid) * NP;
        const float xx = bf2f(prow[C_GF + d * 4 + hh]) + gb[d * 8 + 4 + hh];
        fs[tid] = fminf(xx, 0.f) - __logf(1.f + __expf(-fabsf(xx))); fs[128 + tid] = bf2f(prow[C_GI + d * 4 + hh]) + gb[d * 8 + hh]; }
    __syncthreads();
    float wend = 0.f, gtot = 0.f;
    {
        float lfv = tid < 128 ? fs[tid] : 0.f, p = lfv;
#pragma unroll
        for (int o = 1; o < 64; o <<= 1) { const float t = __shfl_up(p, o); if (lane >= o) p += t; }
        if (tid < 128 && lane == 63) fs[512 + w] = p;
        __syncthreads();
        const float tot0 = fs[512], tot1 = fs[513]; gtot = tot0 + tot1;
        const float bf_ = p + (w == 1 ? tot0 : 0.f);
        const float bsum = d == 0 ? bf_ : gtot - bf_ + lfv;
        wend = tid < 128 ? gtot - bsum + fs[128 + tid] : -3.0e38f;
        float mx = wend;
#pragma unroll
        for (int o = 1; o < 64; o <<= 1) mx = fmaxf(mx, __shfl_xor(mx, o));
        if (tid < 128 && lane == 0) fs[514 + w] = mx;
        __syncthreads();
        const float m = fmaxf(fs[514], fs[515]);
        if (tid < 128) { fs[384 + tid] = __expf(wend - m) * QK_SCALE;
            if (tid == 0) { F_GT[uidx] = gtot; F_MLOC[uidx] = m; } }
    }
    stage_vt(F, VT, R0, hh);
    __syncthreads();
    { const int l4 = tid & 31, c8 = tid >> 5;
        const bf16_t* src = F_P + (R0 + 4 * l4) * NP + C_MK + hh * 128 + c8 * 8;
        const bf16x8 r0 = *(const bf16x8*)(src), r1 = *(const bf16x8*)(src + NP), r2 = *(const bf16x8*)(src + 2 * NP), r3 = *(const bf16x8*)(src + 3 * NP);
        const float e0 = fs[384 + 4 * l4], e1 = fs[385 + 4 * l4], e2 = fs[386 + 4 * l4], e3 = fs[387 + 4 * l4];
#pragma unroll
        for (int i = 0; i < 8; ++i) { u32x2 w; w.x = pk2(bfs2f(r0[i]) * e0, bfs2f(r1[i]) * e1); w.y = pk2(bfs2f(r2[i]) * e2, bfs2f(r3[i]) * e3);
            *(u32x2*)(KT + (c8 * 8 + i) * VS + 4 * l4) = w; } }
    __syncthreads();
    f32x4 acc[2][8];
#pragma unroll
    for (int vi = 0; vi < 2; ++vi)
#pragma unroll
        for (int kb = 0; kb < 8; ++kb) acc[vi][kb] = (f32x4){0.f, 0.f, 0.f, 0.f};
#pragma unroll
    for (int lb = 0; lb < 4; ++lb) {
        bf16x8 xf[2];
#pragma unroll
        for (int vi = 0; vi < 2; ++vi) xf[vi] = *(const bf16x8*)(VT + (32 * w + 16 * vi + fr) * VS + lb * 32 + 8 * fq);
#pragma unroll
        for (int kb = 0; kb < 8; ++kb) { const bf16x8 yf = *(const bf16x8*)(KT + (16 * kb + fr) * VS + lb * 32 + 8 * fq);
#pragma unroll
            for (int vi = 0; vi < 2; ++vi) acc[vi][kb] = __builtin_amdgcn_mfma_f32_16x16x32_bf16(yf, xf[vi], acc[vi][kb], 0, 0, 0); }
    }
    bf16_t* Cst = F_CST + (size_t)uidx * 32768;
    __syncthreads();
#pragma unroll
    for (int vi = 0; vi < 2; ++vi)
#pragma unroll
        for (int kb = 0; kb < 8; ++kb)
        { u32x2 pk; pk.x = pk2(acc[vi][kb][0], acc[vi][kb][1]); pk.y = pk2(acc[vi][kb][2], acc[vi][kb][3]); *(u32x2*)(VT + (32 * w + 16 * vi + fr) * VS + 16 * kb + 4 * fq) = pk; }
    __syncthreads();
#pragma unroll
    for (int i = 0; i < 8; ++i) { const int idx = tid + 512 * i; *(u32x4*)(Cst + (idx >> 4) * 128 + (idx & 15) * 8) = *(const u32x4*)(VT + (idx >> 4) * VS + (idx & 15) * 8); }
    { const int k = tid >> 2, part = tid & 3; float sacc = 0.f;
#pragma unroll
        for (int q = 0; q < 4; ++q) { const bf16x8 t8 = *(const bf16x8*)(KT + k * VS + part * 32 + q * 8);
#pragma unroll
            for (int i = 0; i < 8; ++i) sacc += bfs2f(t8[i]); }
        sacc += __shfl_xor(sacc, 1); sacc += __shfl_xor(sacc, 2);
        if (part == 0) F_NST[(size_t)uidx * 128 + k] = sacc; }
    __syncthreads();
}
__device__ __forceinline__ int scan_slot(int d, int step) { return d == 0 ? step : (step == 0 ? 1 : (step == 1 ? 0 : 35 - step)); }
__device__ __forceinline__ void phase_scan(Fr& F, const bool dost = true) {
    const long nth = (long)F.G * 512;
    for (long gid = (long)F.bx * 512 + F.tid; gid < 32 * 4096; gid += nth) {
        const int seq = (int)(gid >> 12), vec = (int)(gid & 4095), d = seq & 1;
        bf16_t* base = F_CST + (size_t)seq * NSLOT * 32768 + vec * 8;
        float* nbase = F_NST + (size_t)seq * NSLOT * 128 + (vec & 15) * 8;
        const bool hasn = vec < 16;
        float z0 = 0.f; asm volatile("" : "+v"(z0));
        float st[8] = {z0, z0, z0, z0, z0, z0, z0, z0}, sn[8] = {z0, z0, z0, z0, z0, z0, z0, z0}; float m = 0.f;
        int slot = scan_slot(d, 0), slot1 = scan_slot(d, 1);
        bf16x8 cl = *(const bf16x8*)(base + (size_t)slot * 32768), cl1 = *(const bf16x8*)(base + (size_t)slot1 * 32768);
        f32x4 n0 = {0.f, 0.f, 0.f, 0.f}, n1 = {0.f, 0.f, 0.f, 0.f}, p0 = n0, p1 = n0;
        if (hasn) { n0 = *(const f32x4*)(nbase + slot * 128); n1 = *(const f32x4*)(nbase + slot * 128 + 4); p0 = *(const f32x4*)(nbase + slot1 * 128); p1 = *(const f32x4*)(nbase + slot1 * 128 + 4); }
        float g = F_GT[seq * NSLOT + slot], mc = F_MLOC[seq * NSLOT + slot], g1 = F_GT[seq * NSLOT + slot1], mc1 = F_MLOC[seq * NSLOT + slot1];
#pragma unroll 1
        for (int step = 0; step < NSLOT; ++step) {
            const int slot2 = scan_slot(d, step + 2 < NSLOT ? step + 2 : NSLOT - 1);
            const bool ld2 = step + 2 < NSLOT;
            bf16x8 cl2 = cl1; f32x4 q0 = p0, q1 = p1; float g2 = g1, mc2 = mc1;
            if (ld2) { cl2 = *(const bf16x8*)(base + (size_t)slot2 * 32768);
                if (hasn) { q0 = *(const f32x4*)(nbase + slot2 * 128); q1 = *(const f32x4*)(nbase + slot2 * 128 + 4); }
                g2 = F_GT[seq * NSLOT + slot2]; mc2 = F_MLOC[seq * NSLOT + slot2]; }
            asm volatile("" ::: "memory");
            if (dost) { u32x4 o; o.x = pk2(st[0], st[1]); o.y = pk2(st[2], st[3]); o.z = pk2(st[4], st[5]); o.w = pk2(st[6], st[7]);
                *(u32x4*)(base + (size_t)slot * 32768) = o;
                if (hasn) { *(f32x4*)(nbase + slot * 128) = (f32x4){sn[0], sn[1], sn[2], sn[3]}; *(f32x4*)(nbase + slot * 128 + 4) = (f32x4){sn[4], sn[5], sn[6], sn[7]}; } }
            if (vec == 0) F_MIN[seq * NSLOT + slot] = m;
            const float mn = fmaxf(g + m, mc), a = __expf(g + m - mn), s = __expf(mc - mn);
#pragma unroll
            for (int i = 0; i < 8; ++i) st[i] = a * st[i] + s * bfs2f(cl[i]);
#pragma unroll
            for (int i = 0; i < 4; ++i) { sn[i] = a * sn[i] + s * n0[i]; sn[4 + i] = a * sn[4 + i] + s * n1[i]; }
            m = mn; cl = cl1; n0 = p0; n1 = p1; g = g1; mc = mc1; slot = slot1;
            cl1 = cl2; p0 = q0; p1 = q1; g1 = g2; mc1 = mc2; slot1 = slot2; }
    }
}
__device__ __forceinline__ void mls_out_unit(Fr& F, int cidx, int hh, int l, const bool dost = true) {
    bf16_t* VT = (bf16_t*)(F.lds + LDS_VT); bf16_t* Kc = (bf16_t*)(F.lds + LDS_KT); float* fs = (float*)(F.lds + LDS_FS);
    float* lf_s = fs; float* li_s = fs + 256; float* csrc = fs + 512; float* mm = fs + 768; float* bj = fs + 1024;
    bf16_t* Ch = (bf16_t*)(F.lds + LDS_CH);
    const int tid = F.tid, lane = F.lane, w = F.wave, fr = lane & 15, fq = lane >> 4;
    const size_t R0 = (size_t)cidx * 128; int b, slot; chunk_bs(cidx, b, slot);
    if (tid < 256) { const int dd = tid >> 7, t = tid & 127; lf_s[tid] = F_LF[(R0 + t) * 8 + dd * 4 + hh]; li_s[tid] = F_LI[(R0 + t) * 8 + dd * 4 + hh]; }
    stage_vt(F, VT, R0, hh);
    for (int idx = tid; idx < 2048; idx += 512) { const int l2 = idx >> 4, c8 = idx & 15;
        *(bf16x8*)(Kc + l2 * VS + c8 * 8) = *(const bf16x8*)(F_P + (R0 + l2) * NP + C_MK + hh * 128 + c8 * 8); }
    __syncthreads();
    {
        float* tmp = (float*)(F.lds + LDS_CH);
        const bool act = tid < 256; const int dd = (tid >> 7) & 1, wp = w & 1;
        const float lfv = act ? lf_s[tid] : 0.f; float p = lfv;
#pragma unroll
        for (int o = 1; o < 64; o <<= 1) { const float t = __shfl_up(p, o); if (lane >= o) p += t; }
        if (act && lane == 63) tmp[w] = p;
        __syncthreads();
        const float t0 = tmp[2 * dd], t1 = tmp[2 * dd + 1], gt_ = t0 + t1;
        const float bfwd = p + (wp ? t0 : 0.f);
        const float bsum = dd == 0 ? bfwd : gt_ - bfwd + lfv;
        const float cs = act ? li_s[tid] - bsum : -3.0e38f;
        float pmx = cs, smx = cs;
#pragma unroll
        for (int o = 1; o < 64; o <<= 1) { const float a = __shfl_up(pmx, o), c = __shfl_down(smx, o); if (lane >= o) pmx = fmaxf(pmx, a); if (lane + o < 64) smx = fmaxf(smx, c); }
        if (act && lane == 63) tmp[4 + w] = pmx;
        __syncthreads();
        if (act) { const float other = tmp[4 + (w ^ 1)];
            float cm = dd == 0 ? (wp ? fmaxf(pmx, other) : pmx) : (wp ? smx : fmaxf(smx, other));
            cm = fmaxf(cm, F_MIN[unit_idx(b, hh, dd, slot)]);
            bj[tid] = bsum; csrc[tid] = cs; mm[tid] = cm; }
    }
    __syncthreads();
    const int j = 16 * w + fr;
    const bf16_t* prow = F_P + (R0 + j) * NP;
    f32x4 acc[16];
#pragma unroll
    for (int vb = 0; vb < 16; ++vb) acc[vb] = (f32x4){0.f, 0.f, 0.f, 0.f};
#pragma unroll 1
    for (int dd = 0; dd < 2; ++dd) {
        int jj = j; asm volatile("" : "+v"(jj));
        bf16x8 Yq[4];
#pragma unroll
        for (int kb = 0; kb < 4; ++kb) Yq[kb] = *(const bf16x8*)(F_P + (R0 + jj) * NP + C_MQ + hh * 128 + kb * 32 + 8 * fq);
        const int sgn = dd == 0 ? 1 : -1; const int bs = (4 * fq - jj) * sgn;
        const int uidx = unit_idx(b, hh, dd, slot);
        const bf16_t* Cin = F_CST + (size_t)uidx * 32768;
        const float m_in = F_MIN[uidx], mmj = mm[dd * 128 + j], bjj = bj[dd * 128 + j];
        f32x4 Sa[8];
#pragma unroll
        for (int sb = 0; sb < 8; ++sb) { Sa[sb] = (f32x4){0.f, 0.f, 0.f, 0.f};
#pragma unroll
            for (int kb = 0; kb < 4; ++kb) { const bf16x8 kf = *(const bf16x8*)(Kc + (16 * sb + fr) * VS + kb * 32 + 8 * fq);
                Sa[sb] = __builtin_amdgcn_mfma_f32_16x16x32_bf16(kf, Yq[kb], Sa[sb], 0, 0, 0); }
            __builtin_amdgcn_sched_barrier(0); }
        float dsum = 0.f;
#pragma unroll
        for (int sb = 0; sb < 8; ++sb)
#pragma unroll
            for (int e = 0; e < 4; ++e) { const int s = 16 * sb + 4 * fq + e; const bool valid = (bs + sgn * (16 * sb + e)) <= 0;
                const float wv = valid ? __expf(csrc[dd * 128 + s] - mmj) * Sa[sb][e] * QK_SCALE : 0.f; Sa[sb][e] = wv; dsum += wv; }
        dsum += __shfl_xor(dsum, 16); dsum += __shfl_xor(dsum, 32);
        float nq = 0.f; const float* nst = F_NST + (size_t)uidx * 128;
#pragma unroll
        for (int kb = 0; kb < 4; ++kb) { const f32x4 n0 = *(const f32x4*)(nst + kb * 32 + 8 * fq), n1 = *(const f32x4*)(nst + kb * 32 + 8 * fq + 4);
            nq += bfs2f(Yq[kb][0]) * n0[0] + bfs2f(Yq[kb][1]) * n0[1] + bfs2f(Yq[kb][2]) * n0[2] + bfs2f(Yq[kb][3]) * n0[3]
                + bfs2f(Yq[kb][4]) * n1[0] + bfs2f(Yq[kb][5]) * n1[1] + bfs2f(Yq[kb][6]) * n1[2] + bfs2f(Yq[kb][7]) * n1[3]; }
        nq += __shfl_xor(nq, 16); nq += __shfl_xor(nq, 32);
        const float inter = __expf(m_in - mmj);
        const float den = dsum + inter * nq;
        const float rden = 1.f / fmaxf(fabsf(den), __expf(-(bjj + mmj)));
        bf16x8 Wf[4], Yqs[4]; const float qsc = inter * rden;
#pragma unroll
        for (int kb = 0; kb < 4; ++kb) {
            u32x4 t; t.x = pk2(Sa[2 * kb][0] * rden, Sa[2 * kb][1] * rden); t.y = pk2(Sa[2 * kb][2] * rden, Sa[2 * kb][3] * rden);
            t.z = pk2(Sa[2 * kb + 1][0] * rden, Sa[2 * kb + 1][1] * rden); t.w = pk2(Sa[2 * kb + 1][2] * rden, Sa[2 * kb + 1][3] * rden);
            Wf[kb] = *reinterpret_cast<bf16x8*>(&t);
            u32x4 q; q.x = pk2(bfs2f(Yq[kb][0]) * qsc, bfs2f(Yq[kb][1]) * qsc); q.y = pk2(bfs2f(Yq[kb][2]) * qsc, bfs2f(Yq[kb][3]) * qsc);
            q.z = pk2(bfs2f(Yq[kb][4]) * qsc, bfs2f(Yq[kb][5]) * qsc); q.w = pk2(bfs2f(Yq[kb][6]) * qsc, bfs2f(Yq[kb][7]) * qsc);
            Yqs[kb] = *reinterpret_cast<bf16x8*>(&q); }
        bf16x8 pr[4];
#pragma unroll
        for (int i = 0; i < 4; ++i) { const int idx = tid + 512 * i; pr[i] = *(const bf16x8*)(Cin + (idx >> 4) * 128 + (idx & 15) * 8); }
#pragma unroll
        for (int h = 0; h < 2; ++h) {
            __syncthreads();
#pragma unroll
            for (int i = 0; i < 4; ++i) { const int idx = tid + 512 * i; *(bf16x8*)(Ch + (idx >> 4) * VS + (idx & 15) * 8) = pr[i]; }
            if (h == 0) {
#pragma unroll
                for (int i = 0; i < 4; ++i) { const int idx = tid + 512 * i; pr[i] = *(const bf16x8*)(Cin + (128 + (idx >> 4)) * 128 + (idx & 15) * 8); } }
            __syncthreads();
#pragma unroll
            for (int v8 = 0; v8 < 8; ++v8) { const int vb = 8 * h + v8;
#pragma unroll
                for (int kb = 0; kb < 4; ++kb) { const bf16x8 cf = *(const bf16x8*)(Ch + (16 * v8 + fr) * VS + kb * 32 + 8 * fq);
                    acc[vb] = __builtin_amdgcn_mfma_f32_16x16x32_bf16(cf, Yqs[kb], acc[vb], 0, 0, 0); }
#pragma unroll
                for (int kb = 0; kb < 4; ++kb) {
                    const u32x2 lo = *(const u32x2*)(VT + (16 * vb + fr) * VS + 32 * kb + 4 * fq), hi2 = *(const u32x2*)(VT + (16 * vb + fr) * VS + 32 * kb + 16 + 4 * fq);
                    u32x4 t; t.x = lo.x; t.y = lo.y; t.z = hi2.x; t.w = hi2.y;
                    acc[vb] = __builtin_amdgcn_mfma_f32_16x16x32_bf16(*reinterpret_cast<bf16x8*>(&t), Wf[kb], acc[vb], 0, 0, 0); }
                __builtin_amdgcn_sched_barrier(0);
            }
        }
    }
    float ss = 0.f;
#pragma unroll
    for (int vb = 0; vb < 16; ++vb) ss += (acc[vb][0] * acc[vb][0] + acc[vb][1] * acc[vb][1]) + (acc[vb][2] * acc[vb][2] + acc[vb][3] * acc[vb][3]);
    ss += __shfl_xor(ss, 16); ss += __shfl_xor(ss, 32);
    const float rinv = 1.f / sqrtf(ss * (1.f / 256.f) + EPS);
    const float* hg = F.ap->in[I_MLHG] + l * 1024 + hh * 256;
    bf16_t* orow = F_P + (R0 + j) * NP + C_O + hh * 256;
#pragma unroll
    for (int vb = 0; vb < 16; ++vb) { const int v0 = 16 * vb + 4 * fq;
        const u32x2 oraw = *(const u32x2*)(orow + v0); const f32x4 g4 = *(const f32x4*)(hg + v0);
        const float o0 = __uint_as_float(oraw.x << 16), o1 = __uint_as_float(oraw.x & 0xffff0000u), o2 = __uint_as_float(oraw.y << 16), o3 = __uint_as_float(oraw.y & 0xffff0000u);
        u32x2 wv; wv.x = pk2(acc[vb][0] * rinv * g4[0] * sigmoidf_(o0), acc[vb][1] * rinv * g4[1] * sigmoidf_(o1));
        wv.y = pk2(acc[vb][2] * rinv * g4[2] * sigmoidf_(o2), acc[vb][3] * rinv * g4[3] * sigmoidf_(o3));
        if (dost) *(u32x2*)(orow + v0) = wv; }
    __syncthreads();
}

#ifndef PHM
#define PHM 0xFFFF
#endif
#ifndef DUPM
#define DUPM 0
#endif
#if DUPM == 0
#define DOST true
#else
#define DOST (rep_ == ((DUPM >> RB_) & 1))
#endif
#define REP(bit) for (int rep_ = 0, RB_ = (bit); rep_ < ((DUPM >> (bit)) & 1) + 1; ++rep_)
#define GSYNC() do { ArgsP sa_ = (ArgsP)__builtin_amdgcn_kernarg_segment_ptr(); asm volatile("" : "+s"(sa_)); \
    XcdBarrier xb_; xb_.bar = (unsigned*)sa_->ws; xb_.x = xb_xcc_id(); xb_.st = misc; xcd_barrier(xb_); if (DUPM & 0x8000) xcd_barrier(xb_); } while (0)
__global__ void __launch_bounds__(512, 2) fwd_megakernel(Args args) {
    extern __shared__ __attribute__((aligned(16))) unsigned char lds_raw[];
    cg::grid_group grid = cg::this_grid();
    Fr F;
    F.lds = (char*)lds_raw; F.tid = threadIdx.x; F.lane = F.tid & 63; F.wave = __builtin_amdgcn_readfirstlane(F.tid >> 6);
    F.G = gridDim.x; F.bx = blockIdx.x; { const int bx = blockIdx.x; F.vcu = (F.G % 8 == 0) ? (bx % 8) * (F.G / 8) + bx / 8 : bx; }
    F.gw = F.bx * 8 + F.wave; F.NGW = F.G * 8;
    F.ap = (ArgsP)__builtin_amdgcn_kernarg_segment_ptr();
    LAS unsigned char* lds3 = (LAS unsigned char*)lds_raw;
#define PHB() do { int t_ = threadIdx.x; asm volatile("" : "+v"(t_)); F.tid = t_; F.lane = t_ & 63; F.wave = __builtin_amdgcn_readfirstlane(t_ >> 6); \
    ArgsP a_ = (ArgsP)__builtin_amdgcn_kernarg_segment_ptr(); asm volatile("" : "+s"(a_)); F.ap = a_; \
    unsigned lo_ = 0u; asm volatile("" : "+s"(lo_)); F.lds3 = lds3 + lo_; F.lds = (char*)F.lds3; \
    int bx_ = blockIdx.x, g_ = gridDim.x; asm volatile("" : "+s"(bx_), "+s"(g_)); F.bx = bx_; F.G = g_; F.vcu = (g_ % 8 == 0) ? (bx_ % 8) * (g_ / 8) + bx_ / 8 : bx_; F.gw = bx_ * 8 + F.wave; F.NGW = g_ * 8; } while (0)

#if PHM & (1<<0)
    volatile LAS unsigned* misc = (volatile LAS unsigned*)(lds3 + LDS_BYTES - 256);
    if (threadIdx.x < 2) misc[threadIdx.x] = 0u;
    if (blockIdx.x == 0) { unsigned* bw = (unsigned*)WSB; for (int i = threadIdx.x; i < XCD_BAR_WORDS; i += 512) __hip_atomic_store(bw + i, 0u, __ATOMIC_RELAXED, __HIP_MEMORY_SCOPE_AGENT); }
    __syncthreads();
    REP(0) { PHB();
    mod_gemv(F);
    convert_weights(F, 0); }
#endif
    __threadfence(); grid.sync();
    (void)xcd_barrier_post((unsigned*)WSB, misc);
#if PHM & (1<<1)
    REP(1) { PHB();
    phase_norm1(F, 0, F.ap->in[I_X], F.ap->in[I_CTX]); }
#endif
    GSYNC();

    for (int l = 0; l < 2; ++l) {
        const bool last = (l == 1);
        const int nMall = last ? 64 : 68;
#if PHM & (1<<2)
        PHB();
        REP(2)
        { PHB(); pg8::Gemm g{F_H, F_H, F_H, (const bf16_t*)(WSB + WS_WIN), (const bf16_t*)(WSB + WS_WIN), (const bf16_t*)(WSB + WS_WIN), D, D, 0};
          pg8::Sched S; if (!last) S.init(68, 47, 1, F.G, F.bx); else S.init(64, 47, 1, F.G, F.bx, 64, 4, 9);
          pg8::EpiWin E{F_P, (unsigned char*)(WSB + WS_G8)};
          pg8::gemm_phase<pg8::EpiWin>(F.lds3, g, S, E, F.tid); }
#endif
        GSYNC();
#if PHM & (1<<3)
        REP(3) { PHB();
        phase_prep(F, l, DOST); }
#endif
        __syncthreads();
#if PHM & (1<<5)
        REP(5) { PHB();
        for (int u = F.G - 1 - F.bx; u < 136 * 8; u += F.G) { const int cidx = u >> 3, hh = (u >> 1) & 3, d = u & 1; mls_cloc_unit(F, cidx, hh, d, l); } }
#endif
        GSYNC();
#if PHM & (1<<4)
        REP(4)
        { PHB(); const bf16_t* wp = (const bf16_t*)(WSB + WS_WPL);
          pg8::Gemm g{F_MIX, F_MIX, F_MIX, wp, wp, wp, 1024, 256, 512};
          pg8::Sched S; S.init(nMall, 4, 1, F.G, F.G - 1 - F.bx);
          pg8::EpiBf16 E{F_P + C_PL, NP};
          pg8::gemm_phase<pg8::EpiBf16>(F.lds3, g, S, E, F.tid); }
#endif
        __syncthreads();
#if PHM & (1<<6)
        REP(6) { PHB();
        phase_scan(F, DOST); }
#endif
        GSYNC();
        { const int nchunk = last ? 128 : 136;
#if PHM & (1<<7)
          REP(7) { PHB();
          for (int u = F.bx; u < nchunk * 4; u += F.G) mls_out_unit(F, u >> 2, u & 3, l, DOST); }
#endif
#if PHM & (1<<8)
          REP(8) { PHB();
          const int nun = last ? 512 : 544;
          for (int u = F.vcu; u < nun; u += F.G) {
              if (u < 512) { const int qb = u & 15, hq = (u >> 4) & 3, kvh = (u >> 6) & 1, b = u >> 7, h = kvh * 4 + hq;
                  const size_t rq = (size_t)b * SEQ + qb * 256, rk = (size_t)b * SEQ, rc = (size_t)ML + b * CTXL;
                  att::attn_dense_body(F_P + rq * NP + C_AQ + h * 128, F_P + rk * NP + C_AK + kvh * 128,
                                       F_P + rc * NP + C_AK + kvh * 128, 64, F_P + rq * NP + C_AQ + h * 128, 68, F.lds, F.tid, DOST);
              } else { const int v = u - 512, b = v >> 3, h = v & 7, kvh = h >> 2; const size_t rc = (size_t)ML + b * CTXL;
                  att::attn_dense_body(F_P + rc * NP + C_AQ + h * 128, F_P + rc * NP + C_AK + kvh * 128,
                                       F_P + rc * NP + C_AK + kvh * 128, 4, F_P + rc * NP + C_AQ + h * 128, 4, F.lds, F.tid, DOST); }
          } }
#endif
        }
        GSYNC();
#if PHM & (1<<9)
        PHB();
        REP(9)
        { PHB(); const bf16_t* wu = (const bf16_t*)(WSB + WS_WUP);
          pg8::Gemm g{F_P + C_AQ, F_P + C_O, F_P + C_PL, wu, wu + (size_t)D * 1024, wu + (size_t)2 * D * 1024, NP, 1024, 0};
          pg8::Sched S; S.init(nMall, 8, 3, F.G, F.bx);
          pg8::EpiGate E{(const unsigned char*)(WSB + WS_G8), F_H};
          pg8::gemm_phase<pg8::EpiGate>(F.lds3, g, S, E, F.tid); }
#endif
        GSYNC();
#if PHM & (1<<10)
        PHB();
        REP(10)
        { PHB(); const bf16_t* wo = (const bf16_t*)(WSB + WS_WOUT);
          pg8::Gemm g{F_H, F_H, F_H, wo, wo, wo, D, D, 0};
          pg8::Sched S; S.init(nMall, 8, 1, F.G, F.bx);
          pg8::EpiBf16 E{(bf16_t*)(WSB + WS_YO), D};
          pg8::gemm_phase<pg8::EpiBf16>(F.lds3, g, S, E, F.tid); }
#endif
        GSYNC();
#if PHM & (1<<11)
        REP(11) { PHB();
        phase_resid(F, l, 0, nMall * 256, F.ap->in[I_X], l == 0 ? F.ap->in[I_CTX] : F_XC, false, l != 0, true, DOST); }
#endif
        GSYNC();
#if PHM & (1<<12)
        PHB();
        REP(12)
        { PHB(); const bf16_t* wf = (const bf16_t*)(WSB + WS_WFI);
          pg8::Gemm g{F_H, F_H, F_H, wf, wf, wf, D, D, 0};
          pg8::Sched S; S.init(nMall, 44, 1, F.G, F.bx);
          pg8::EpiSwiglu E{(bf16_t*)(WSB + WS_HID)};
          pg8::gemm_phase<pg8::EpiSwiglu>(F.lds3, g, S, E, F.tid); }
#endif
        GSYNC();
#if PHM & (1<<13)
        PHB();
        REP(13)
        { PHB(); const bf16_t* wf = (const bf16_t*)(WSB + WS_WFO); const bf16_t* hid = (const bf16_t*)(WSB + WS_HID);
          pg8::Gemm g{hid, hid, hid, wf, wf, wf, DFF, DFF, 0};
          pg8::Sched S; S.init(nMall, 8, 1, F.G, F.bx);
          pg8::EpiBf16 E{(bf16_t*)(WSB + WS_YO), D};
          pg8::gemm_phase<pg8::EpiBf16>(F.lds3, g, S, E, F.tid); }
#endif
        GSYNC();
#if PHM & (1<<14)
        REP(14) { PHB();
        phase_resid(F, l, 1, nMall * 256, F.ap->in[I_X], F_XC, !last, true, !last, DOST);
        if (!last) { __syncthreads(); convert_weights(F, 1); } }
#endif
        GSYNC();
    }
}

extern "C" void kernel_launch(void* const* d_in, const int* in_sizes, int n_in, void* d_out, int out_size, void* d_ws, size_t ws_size, hipStream_t stream) {
    static int grid = 0;
    if (grid == 0) {
        if (n_in != 19 || out_size != ML * D || ws_size < WS_END) { fprintf(stderr, "kernel_launch: unexpected shapes n_in %d out %d ws %zu (need %zu)\n", n_in, out_size, ws_size, (size_t)WS_END); grid = -1; return; }
        int dev = 0, cus = 0, per_cu = 0;
        hipGetDevice(&dev); hipDeviceGetAttribute(&cus, hipDeviceAttributeMultiprocessorCount, dev);
        if (hipFuncSetAttribute((const void*)fwd_megakernel, hipFuncAttributeMaxDynamicSharedMemorySize, LDS_BYTES) != hipSuccess) { fprintf(stderr, "kernel_launch: hipFuncSetAttribute failed\n"); grid = -1; return; }
        if (hipOccupancyMaxActiveBlocksPerMultiprocessor(&per_cu, (const void*)fwd_megakernel, 512, LDS_BYTES) != hipSuccess || per_cu < 1) { fprintf(stderr, "kernel_launch: occupancy query gave %d\n", per_cu); per_cu = 1; }
        (void)hipGetLastError();
        grid = cus * 1;
        fprintf(stderr, "kernel_launch: cus %d per_cu %d grid %d\n", cus, per_cu, grid);
    }
    if (grid < 0) return;
    Args a{};
    for (int i = 0; i < 19; ++i) a.in[i] = (const float*)d_in[i];
    a.out = (float*)d_out; a.ws = (unsigned char*)d_ws;
    void* kargs[] = {&a};
    hipError_t e = hipLaunchCooperativeKernel((const void*)fwd_megakernel, dim3(grid), dim3(512), kargs, LDS_BYTES, stream);
    if (e != hipSuccess) fprintf(stderr, "cooperative launch failed: %s (grid %d)\n", hipGetErrorString(e), grid);
}
```
